# Optimizing an MI355X kernel written in HIP

```python
import math
import jax, jax.numpy as jnp
from jax import lax
import numpy as np

D_MODEL = 2048
BATCH = 8
SEQ = 4096
DEPTH = 4

M_HEADS = 4
M_DQK = 128
M_DV = 256
M_CHUNK = 64
M_CONV = 4
M_QK_W = 2 * M_HEADS * M_DQK
M_V_W = M_HEADS * M_DV
A_HEADS = 8
A_DH = 128
A_DV = 2 * A_DH
A_Q_W = A_HEADS * 2 * A_DH
A_V_W = A_HEADS * A_DV
Q_BLOCK = 128
ROPE_THETA = 500000.0
ROPE_DIM = A_DH // 4
D_FF = -(-8 * D_MODEL // (3 * 256)) * 256
EPS = 1e-6
COL_SIZES = (M_QK_W, M_V_W, M_V_W, M_HEADS, M_HEADS, A_Q_W, A_Q_W, A_V_W, D_MODEL, D_MODEL)
D_IN = sum(COL_SIZES)

kernel_name = 'hybrid_mlstm_diffattn_block'


def rms_norm(x, g):
    xf = x.astype(jnp.float32)
    y = xf * lax.rsqrt(jnp.mean(xf * xf, axis=-1, keepdims=True) + EPS)
    return (y * g.astype(jnp.float32)).astype(x.dtype)


def split_cols(t, sizes):
    out, start = [], 0
    for s in sizes:
        out.append(t[..., start:start + s])
        start += s
    return out


def causal_dwconv(x, w, b):
    y = lax.conv_general_dilated(x, w[:, None, :].astype(x.dtype), window_strides=(1,),
                                 padding=((M_CONV - 1, 0),),
                                 dimension_numbers=('NWC', 'WIO', 'NWC'),
                                 feature_group_count=x.shape[-1])
    return y + b.astype(x.dtype)


def partial_rope(x, positions):
    half = ROPE_DIM // 2
    inv = jnp.power(ROPE_THETA, -jnp.arange(half, dtype=jnp.float32) * (2.0 / ROPE_DIM))
    ang = positions.astype(jnp.float32)[..., None] * inv
    cos = jnp.cos(ang)[:, :, None, None, :]
    sin = jnp.sin(ang)[:, :, None, None, :]
    xf = x.astype(jnp.float32)
    x1, x2, xp = xf[..., :half], xf[..., half:ROPE_DIM], xf[..., ROPE_DIM:]
    out = jnp.concatenate([x1 * cos - x2 * sin, x2 * cos + x1 * sin, xp], axis=-1)
    return out.astype(x.dtype)


def mlstm_chunkwise(q, k, v, log_i, log_f):
    B, S, H, dk = q.shape
    dv = v.shape[-1]
    L = M_CHUNK
    nc = S // L

    def to_chunks(t):
        t = t.reshape((B, nc, L, H) + t.shape[3:])
        return jnp.moveaxis(t, (1, 3), (0, 2))

    causal = jnp.tril(jnp.ones((L, L), dtype=bool))

    def step(carry, xs):
        C, n, m = carry
        qc, kc, vc, lic, lfc = xs
        b = jnp.cumsum(lfc, axis=-1)
        dmat = jnp.where(causal, b[..., :, None] - b[..., None, :] + lic[..., None, :], -jnp.inf)
        m_inter = b + m[..., None]
        m_t = jnp.maximum(jnp.max(dmat, axis=-1), m_inter)
        w_intra = jnp.exp(dmat - m_t[..., None])
        w_inter = jnp.exp(m_inter - m_t)
        s = jnp.einsum('bhtd,bhsd->bhts', qc, kc) * w_intra
        num = jnp.einsum('bhts,bhsv->bhtv', s, vc) + w_inter[..., None] * jnp.einsum('bhtd,bhdv->bhtv', qc, C)
        den = jnp.sum(s, axis=-1) + w_inter * jnp.einsum('bhtd,bhd->bht', qc, n)
        h = num / jnp.maximum(jnp.abs(den), jnp.exp(-m_t))[..., None]
        g = b[..., -1]
        a = g[..., None] - b + lic
        m_new = jnp.maximum(g + m, jnp.max(a, axis=-1))
        decay = jnp.exp(g + m - m_new)
        w_s = jnp.exp(a - m_new[..., None])
        C = decay[..., None, None] * C + jnp.einsum('bhs,bhsd,bhsv->bhdv', w_s, kc, vc)
        n = decay[..., None] * n + jnp.einsum('bhs,bhsd->bhd', w_s, kc)
        return (C, n, m_new), h

    init = (jnp.zeros((B, H, dk, dv), jnp.float32), jnp.zeros((B, H, dk), jnp.float32),
            jnp.zeros((B, H), jnp.float32))
    xs = (to_chunks(q), to_chunks(k), to_chunks(v), to_chunks(log_i), to_chunks(log_f))
    _, h = lax.scan(step, init, xs)
    return jnp.moveaxis(h, (0, 2), (1, 3)).reshape(B, S, H, dv)


def diff_attention(q, k, v, lam, lam_init, g_sub):
    B, S, H, _, dh = q.shape
    dv = v.shape[-1]
    nq = S // Q_BLOCK
    scale = dh ** -0.5
    qh = jnp.moveaxis(q, 1, 3)
    kh = jnp.moveaxis(k, 1, 3)
    vh = jnp.moveaxis(v, 1, 2)
    qb = jnp.moveaxis(qh.reshape(B, H, 2, nq, Q_BLOCK, dh), 3, 0)
    kpos = jnp.arange(S)

    def block(args):
        qblk, i = args
        s = jnp.einsum('bhcqd,bhckd->bhcqk', qblk, kh).astype(jnp.float32) * scale
        qpos = i * Q_BLOCK + jnp.arange(Q_BLOCK)
        mask = kpos[None, :] <= qpos[:, None]
        p = jax.nn.softmax(jnp.where(mask, s, -jnp.inf), axis=-1)
        attn = p[:, :, 0] - lam * p[:, :, 1]
        return jnp.einsum('bhqk,bhkv->bhqv', attn.astype(vh.dtype), vh)

    o = lax.map(block, (qb, jnp.arange(nq)))
    o = jnp.moveaxis(o, 0, 2).reshape(B, H, S, dv)
    o = rms_norm(o, g_sub) * (1.0 - lam_init)
    return jnp.moveaxis(o, 1, 2).reshape(B, S, H * dv)


def setup_inputs(seed: int = 0) -> dict:
    key = jax.random.key(seed)
    ks = jax.random.split(key, 24)
    nrm = lambda k, shape, s: jax.random.normal(k, shape, jnp.float32) * s
    x = jax.random.normal(ks[0], (BATCH, SEQ, D_MODEL), jnp.float32)
    positions = jnp.broadcast_to(jnp.arange(SEQ, dtype=jnp.int32), (BATCH, SEQ))
    return {
        'x': x,
        'positions': positions,
        'g_mix': 1.0 + nrm(ks[1], (DEPTH, D_MODEL), 0.01),
        'w_in': nrm(ks[2], (DEPTH, D_MODEL, D_IN), D_MODEL ** -0.5),
        'conv_w': nrm(ks[3], (DEPTH, M_CONV, M_QK_W), M_CONV ** -0.5),
        'conv_b': nrm(ks[4], (DEPTH, M_QK_W), 0.01),
        'i_bias': nrm(ks[5], (DEPTH, M_HEADS), 0.1),
        'f_bias': jnp.linspace(3.0, 6.0, M_HEADS, dtype=jnp.float32)[None, :] + nrm(ks[6], (DEPTH, M_HEADS), 0.1),
        'g_mhead': 1.0 + nrm(ks[7], (DEPTH, M_V_W), 0.01),
        'lambda_q1': nrm(ks[8], (DEPTH, A_DH), 0.1),
        'lambda_k1': nrm(ks[9], (DEPTH, A_DH), 0.1),
        'lambda_q2': nrm(ks[10], (DEPTH, A_DH), 0.1),
        'lambda_k2': nrm(ks[11], (DEPTH, A_DH), 0.1),
        'g_sub': 1.0 + nrm(ks[12], (DEPTH, A_DV), 0.01),
        'p_m': nrm(ks[13], (DEPTH, M_V_W, D_MODEL), M_V_W ** -0.5),
        'p_a': nrm(ks[14], (DEPTH, A_V_W, D_MODEL), A_V_W ** -0.5),
        'w_out': nrm(ks[15], (DEPTH, D_MODEL, D_MODEL), D_MODEL ** -0.5),
        'g_ffn': 1.0 + nrm(ks[16], (DEPTH, D_MODEL), 0.01),
        'w_gate': nrm(ks[17], (DEPTH, D_MODEL, D_FF), D_MODEL ** -0.5),
        'w_up': nrm(ks[18], (DEPTH, D_MODEL, D_FF), D_MODEL ** -0.5),
        'w_down': nrm(ks[19], (DEPTH, D_FF, D_MODEL), D_FF ** -0.5),
        'g_final': 1.0 + nrm(ks[20], (D_MODEL,), 0.01),
    }


def reference(x, positions, g_mix, w_in, conv_w, conv_b, i_bias, f_bias, g_mhead,
              lambda_q1, lambda_k1, lambda_q2, lambda_k2, g_sub, p_m, p_a, w_out,
              g_ffn, w_gate, w_up, w_down, g_final):
    B, S, _ = x.shape
    for l in range(DEPTH):
        lam_init = 0.8 - 0.6 * math.exp(-0.3 * l)
        h = rms_norm(x, g_mix[l])
        proj = h @ w_in[l]
        m_qk, m_v, m_o, m_i, m_f, a_q, a_k, a_v, gate_m, gate_a = split_cols(proj, COL_SIZES)

        m_qk = jax.nn.silu(causal_dwconv(m_qk, conv_w[l], conv_b[l]))
        m_q = m_qk[..., :M_QK_W // 2].reshape(B, S, M_HEADS, M_DQK).astype(jnp.float32)
        m_k = m_qk[..., M_QK_W // 2:].reshape(B, S, M_HEADS, M_DQK).astype(jnp.float32) * (M_DQK ** -0.5)
        m_vv = m_v.reshape(B, S, M_HEADS, M_DV).astype(jnp.float32)
        log_i = (m_i + i_bias[l]).astype(jnp.float32)
        log_f = jax.nn.log_sigmoid((m_f + f_bias[l]).astype(jnp.float32))
        h_m = mlstm_chunkwise(m_q, m_k, m_vv, log_i, log_f)
        h_m = rms_norm(h_m, g_mhead[l].reshape(M_HEADS, M_DV)).reshape(B, S, M_V_W).astype(x.dtype)
        h_m = jax.nn.sigmoid(m_o) * h_m

        q = partial_rope(a_q.reshape(B, S, A_HEADS, 2, A_DH), positions)
        k = partial_rope(a_k.reshape(B, S, A_HEADS, 2, A_DH), positions)
        lam = (jnp.exp(jnp.sum(lambda_q1[l].astype(jnp.float32) * lambda_k1[l].astype(jnp.float32)))
               - jnp.exp(jnp.sum(lambda_q2[l].astype(jnp.float32) * lambda_k2[l].astype(jnp.float32)))
               + lam_init)
        h_a = diff_attention(q, k, a_v.reshape(B, S, A_HEADS, A_DV), lam, lam_init, g_sub[l])

        y = jax.nn.sigmoid(gate_m) * (h_m @ p_m[l]) + jax.nn.sigmoid(gate_a) * (h_a @ p_a[l])
        x = x + y @ w_out[l]

        h = rms_norm(x, g_ffn[l])
        x = x + (jax.nn.silu(h @ w_gate[l]) * (h @ w_up[l])) @ w_down[l]
    return rms_norm(x, g_final)
```

```cpp
#include <hip/hip_runtime.h>
#include <cstdio>
#include <cstdint>
#define DBG 0
#define DBG_STOP_LAYER 0
#define DBG_STOP_PHASE 3
#ifndef PHMASK
#define PHMASK 0xFFFF
#endif
#ifndef PROBE_REP2
#define PROBE_REP2 1
#endif
#ifndef PROBE_REP0
#define PROBE_REP0 1
#endif
namespace pg8 {
#define PG8_LAS __attribute__((address_space(3)))
typedef unsigned short bf16_t;
typedef short bf16x8 __attribute__((ext_vector_type(8)));
typedef float f32x4 __attribute__((ext_vector_type(4)));
typedef unsigned u32x4 __attribute__((ext_vector_type(4)));
constexpr int BM = 256, BK = 64, HALF = 128, HTB = HALF * BK * 2  , STAGE_BYTES = 8 * HTB, NXCD = 8, WGM = 8;

__host__ __device__ __forceinline__ int lds_byte(int r, int c) { const int st = (r >> 4) * 2 + (c >> 5), rr = r & 15, cc = c & 31, ob = rr * 64 + cc * 2; return st * 1024 + (ob ^ (((ob >> 9) & 1) << 5)); }
__host__ __device__ __forceinline__ void stage_rc(int b, int& R, int& C) { const int st = b / 1024, sb = b % 1024, swz = sb ^ (((sb >> 9) & 1) << 5); R = (st >> 1) * 16 + swz / 64; C = (st & 1) * 32 + (swz % 64) / 2; }
__host__ __device__ __forceinline__ int perm32(int rho) { const int n = rho >> 4, i = rho & 15; return 8 * (i >> 2) + 4 * n + (i & 3); }

struct Unit { int pm, pn; };
struct Gemm { const bf16_t* A; const bf16_t* Bt; int lda; int K; };

struct StaticOrder {
    int nM, nN, nwg, G, c;
    __host__ __device__ void init(int M, int N, int G_, int c_) { nM = M / BM; nN = N / BM; nwg = nM * nN; G = G_; c = c_; }
    __host__ __device__ bool next(int i, Unit& u) const {
        const long L = (long)i * G + c; if (L >= nwg) return false;
        int wgid = (int)L; { const int q = nwg / NXCD, r = nwg % NXCD, xcd = wgid % NXCD, off = wgid / NXCD; wgid = (xcd < r ? xcd * (q + 1) : r * (q + 1) + (xcd - r) * q) + off; }
        const int nig = WGM * nN, gid = wgid / nig, fm = gid * WGM, gsz = (nM - fm) < WGM ? (nM - fm) : WGM;
        u.pm = fm + ((wgid % nig) % gsz); u.pn = (wgid % nig) / gsz; return true;
    }
};

__device__ __forceinline__ unsigned cvt_pk_bf16(float lo, float hi) { unsigned r; asm volatile("v_cvt_pk_bf16_f32 %0, %1, %2" : "=v"(r) : "v"(lo), "v"(hi)); return r; }
__device__ __forceinline__ float bf_lo(unsigned u) { return __uint_as_float(u << 16); }
__device__ __forceinline__ float bf_hi(unsigned u) { return __uint_as_float(u & 0xffff0000u); }
__device__ __forceinline__ float sigm(float x) { return __builtin_amdgcn_rcpf(1.0f + __builtin_amdgcn_exp2f(-1.4426950408889634f * x)); }
__device__ __forceinline__ u32x4 pack8f(f32x4 a, f32x4 b) { u32x4 w; w.x = cvt_pk_bf16(a[0], a[1]); w.y = cvt_pk_bf16(a[2], a[3]); w.z = cvt_pk_bf16(b[0], b[1]); w.w = cvt_pk_bf16(b[2], b[3]); return w; }

struct EpiProj {
    static constexpr bool PERM = true;
    bf16_t* O; int ldc; const float* rope;
    __device__ __forceinline__ void operator()(const f32x4 (&acc)[2][2][4][2], const Unit& u, int wr, int wc, int fr, int fq) const {
        const int row0 = u.pm * BM + wr * 64 + fr, col0 = u.pn * BM + wc * 32 + 8 * fq;
        const int pn = u.pn;
        const bool is_sig = (pn >= 8 && pn < 12) || pn >= 36;
        const bool is_rope = (pn >= 12 && pn < 28) && (wc == 0);
#pragma unroll
        for (int ai = 0; ai < 2; ++ai)
#pragma unroll
            for (int m = 0; m < 4; ++m) {
                const int row = row0 + ai * HALF + m * 16;
                bf16_t* rowp = O + (size_t)row * ldc + col0;
                f32x4 cs = (f32x4){1.f, 1.f, 1.f, 1.f}, sn = (f32x4){0.f, 0.f, 0.f, 0.f};
                if (is_rope) { cs = *(const f32x4*)(rope + (size_t)row * 32 + 4 * fq); sn = *(const f32x4*)(rope + (size_t)row * 32 + 16 + 4 * fq); }
#pragma unroll
                for (int bj = 0; bj < 2; ++bj) {
                    f32x4 v0 = acc[ai][bj][m][0], v1 = acc[ai][bj][m][1];
                    if (is_sig) {
#pragma unroll
                        for (int e = 0; e < 4; ++e) { v0[e] = sigm(v0[e]); v1[e] = sigm(v1[e]); }
                    }
                    if (is_rope) {
                        f32x4 a0, a1;
                        a0[0] = v0[0] * cs[0] - v0[1] * sn[0]; a0[1] = v0[1] * cs[0] + v0[0] * sn[0];
                        a0[2] = v0[2] * cs[1] - v0[3] * sn[1]; a0[3] = v0[3] * cs[1] + v0[2] * sn[1];
                        a1[0] = v1[0] * cs[2] - v1[1] * sn[2]; a1[1] = v1[1] * cs[2] + v1[0] * sn[2];
                        a1[2] = v1[2] * cs[3] - v1[3] * sn[3]; a1[3] = v1[3] * cs[3] + v1[2] * sn[3];
                        v0 = a0; v1 = a1;
                    }
                    *(u32x4*)(rowp + bj * HALF) = pack8f(v0, v1);
                }
                asm volatile("" ::: "memory");
            }
    }
};
struct EpiGateT {
    static constexpr bool PERM = true;
    float* T; int ldt; const bf16_t* G; int ldg;
    __device__ __forceinline__ void operator()(const f32x4 (&acc)[2][2][4][2], const Unit& u, int wr, int wc, int fr, int fq) const {
        const int row0 = u.pm * BM + wr * 64 + fr, col0 = u.pn * BM + wc * 32 + 8 * fq;
#pragma unroll
        for (int ai = 0; ai < 2; ++ai)
#pragma unroll
            for (int m = 0; m < 4; ++m) {
                const int row = row0 + ai * HALF + m * 16;
#pragma unroll
                for (int bj = 0; bj < 2; ++bj) {
                    const int col = col0 + bj * HALF;
                    const u32x4 g = *(const u32x4*)(G + (size_t)row * ldg + col);
                    const f32x4 v0 = acc[ai][bj][m][0], v1 = acc[ai][bj][m][1];
                    f32x4 o0, o1;
                    o0[0] = bf_lo(g.x) * v0[0]; o0[1] = bf_hi(g.x) * v0[1]; o0[2] = bf_lo(g.y) * v0[2]; o0[3] = bf_hi(g.y) * v0[3];
                    o1[0] = bf_lo(g.z) * v1[0]; o1[1] = bf_hi(g.z) * v1[1]; o1[2] = bf_lo(g.w) * v1[2]; o1[3] = bf_hi(g.w) * v1[3];
                    float* tp = T + (size_t)row * ldt + col;
                    *(f32x4*)tp = o0; *(f32x4*)(tp + 4) = o1;
                }
                asm volatile("" ::: "memory");
            }
    }
};
struct EpiGateY {
    static constexpr bool PERM = true;
    const float* T; int ldt; const bf16_t* G; int ldg; bf16_t* Y; int ldy;
    __device__ __forceinline__ void operator()(const f32x4 (&acc)[2][2][4][2], const Unit& u, int wr, int wc, int fr, int fq) const {
        const int row0 = u.pm * BM + wr * 64 + fr, col0 = u.pn * BM + wc * 32 + 8 * fq;
#pragma unroll
        for (int ai = 0; ai < 2; ++ai)
#pragma unroll
            for (int m = 0; m < 4; ++m) {
                const int row = row0 + ai * HALF + m * 16;
#pragma unroll
                for (int bj = 0; bj < 2; ++bj) {
                    const int col = col0 + bj * HALF;
                    const u32x4 g = *(const u32x4*)(G + (size_t)row * ldg + col);
                    const float* tp = T + (size_t)row * ldt + col;
                    const f32x4 t0 = *(const f32x4*)tp, t1 = *(const f32x4*)(tp + 4);
                    const f32x4 v0 = acc[ai][bj][m][0], v1 = acc[ai][bj][m][1];
                    f32x4 o0, o1;
                    o0[0] = t0[0] + bf_lo(g.x) * v0[0]; o0[1] = t0[1] + bf_hi(g.x) * v0[1]; o0[2] = t0[2] + bf_lo(g.y) * v0[2]; o0[3] = t0[3] + bf_hi(g.y) * v0[3];
                    o1[0] = t1[0] + bf_lo(g.z) * v1[0]; o1[1] = t1[1] + bf_hi(g.z) * v1[1]; o1[2] = t1[2] + bf_lo(g.w) * v1[2]; o1[3] = t1[3] + bf_hi(g.w) * v1[3];
                    *(u32x4*)(Y + (size_t)row * ldy + col) = pack8f(o0, o1);
                }
                asm volatile("" ::: "memory");
            }
    }
};
struct EpiRes {
    static constexpr bool PERM = false;
    const float* res; float* out; int ldc;
    __device__ __forceinline__ void operator()(const f32x4 (&acc)[2][2][4][2], const Unit& u, int wr, int wc, int fr, int fq) const {
        const int row0 = u.pm * BM + wr * 64 + fr, col0 = u.pn * BM + wc * 32 + 4 * fq;
#pragma unroll
        for (int ai = 0; ai < 2; ++ai)
#pragma unroll
            for (int m = 0; m < 4; ++m) {
                const size_t off = (size_t)(row0 + ai * HALF + m * 16) * ldc + col0;
#pragma unroll
                for (int bj = 0; bj < 2; ++bj)
#pragma unroll
                    for (int n = 0; n < 2; ++n) { const f32x4 r = *(const f32x4*)(res + off + bj * HALF + n * 16); *(f32x4*)(out + off + bj * HALF + n * 16) = r + acc[ai][bj][m][n]; }
            }
    }
};
struct EpiSwiglu {
    static constexpr bool PERM = true;
    bf16_t* H; int ldh;
    __device__ __forceinline__ void operator()(const f32x4 (&acc)[2][2][4][2], const Unit& u, int wr, int wc, int fr, int fq) const {
        const int row0 = u.pm * BM + wr * 64 + fr, col0 = u.pn * HALF + wc * 32 + 8 * fq;
#pragma unroll
        for (int ai = 0; ai < 2; ++ai)
#pragma unroll
            for (int m = 0; m < 4; ++m) {
                const int row = row0 + ai * HALF + m * 16;
                f32x4 o0, o1;
#pragma unroll
                for (int e = 0; e < 4; ++e) { const float g0 = acc[ai][0][m][0][e], g1 = acc[ai][0][m][1][e];
                    o0[e] = g0 * sigm(g0) * acc[ai][1][m][0][e]; o1[e] = g1 * sigm(g1) * acc[ai][1][m][1][e]; }
                *(u32x4*)(H + (size_t)row * ldh + col0) = pack8f(o0, o1);
            }
    }
};

template <class Epi, bool ALIGN_EPI>
__device__ __forceinline__ void gemm_phase(PG8_LAS unsigned char* lds, const Gemm g, const StaticOrder& S, const Epi& E, const int tid) {
    const int wid = __builtin_amdgcn_readfirstlane(tid >> 6), lane = tid & 63, wr = wid >> 2, wc = wid & 3, fr = lane & 15, fq = lane >> 4;
    const int K = g.K, nt = K / BK, lda = g.lda;
    unsigned voffA[2], voffB[2];
#pragma unroll
    for (int i = 0; i < 2; ++i) { int R, C; stage_rc(tid * 16 + i * 8192, R, C); const int Rb = Epi::PERM ? ((R & ~31) + perm32(R & 31)) : R;
        voffA[i] = (unsigned)(R * lda + C) * 2u; voffB[i] = (unsigned)(Rb * K + C) * 2u; }
    const size_t kstep = (size_t)(BK * 2);
    const size_t hstepA = (size_t)HALF * lda * 2, hstepB = (size_t)HALF * K * 2;
    const size_t tstepA = 2 * hstepA, tstepB = 2 * hstepB;
    const unsigned ldsw = (unsigned)wid * 1024u;
    const int aoff = lds_byte(wr * 64 + fr, fq * 8), boff = lds_byte(wc * 32 + fr, fq * 8);
#define PG8_SA(b, h) (((b) * 2 + (h)) * HTB)
#define PG8_SB(b, h) ((4 + (b) * 2 + (h)) * HTB)
#define PG8_STAGE(bufoff, gbase, voff) do { _Pragma("unroll") for (int _i = 0; _i < 2; ++_i) \
        __builtin_amdgcn_global_load_lds((const unsigned*)((const char*)(gbase) + (voff)[_i]), (PG8_LAS unsigned*)(lds + (bufoff) + ldsw + _i * 8192), 16, 0, 0); } while (0)
#define PG8_LDA(dst, b, h) do { _Pragma("unroll") for (int m = 0; m < 4; ++m) _Pragma("unroll") for (int k = 0; k < 2; ++k) dst[m][k] = *(const PG8_LAS bf16x8*)(lds + PG8_SA(b, h) + aoff + m * 2048 + k * 1024); } while (0)
#define PG8_LDB(dst, b, h) do { _Pragma("unroll") for (int n = 0; n < 2; ++n) _Pragma("unroll") for (int k = 0; k < 2; ++k) dst[n][k] = *(const PG8_LAS bf16x8*)(lds + PG8_SB(b, h) + boff + n * 2048 + k * 1024); } while (0)
#define PG8_MMA(ai, bj, At, Bt) do { __builtin_amdgcn_s_setprio(1); _Pragma("unroll") for (int m = 0; m < 4; ++m) _Pragma("unroll") for (int n = 0; n < 2; ++n) _Pragma("unroll") for (int k = 0; k < 2; ++k) \
        acc[ai][bj][m][n] = __builtin_amdgcn_mfma_f32_16x16x32_bf16(Bt[n][k], At[m][k], acc[ai][bj][m][n], 0, 0, 0); __builtin_amdgcn_s_setprio(0); } while (0)
#define PG8_WAIT_V(n) asm volatile("s_waitcnt vmcnt(" #n ")" ::: "memory")
#define PG8_WAIT_L(n) asm volatile("s_waitcnt lgkmcnt(" #n ")" ::: "memory")
#define PG8_BAR __builtin_amdgcn_s_barrier()
#define PG8_SCHED __builtin_amdgcn_sched_barrier(0)
    Unit cur, nxt; int ui = 0;
    if (!S.next(0, cur)) return;
    f32x4 acc[2][2][4][2];
#pragma unroll
    for (int a = 0; a < 2; ++a)
#pragma unroll
        for (int b = 0; b < 2; ++b)
#pragma unroll
            for (int m = 0; m < 4; ++m)
#pragma unroll
                for (int n = 0; n < 2; ++n) acc[a][b][m][n] = (f32x4){0.f, 0.f, 0.f, 0.f};
    bf16x8 At[4][2], B0[2][2], B1[2][2];
    const char* cA = (const char*)g.A + (size_t)cur.pm * tstepA; const char* cB = (const char*)g.Bt + (size_t)cur.pn * tstepB;
    PG8_STAGE(PG8_SB(0, 0), cB, voffB); PG8_STAGE(PG8_SB(0, 1), cB + hstepB, voffB); PG8_STAGE(PG8_SA(0, 0), cA, voffA); PG8_STAGE(PG8_SA(0, 1), cA + hstepA, voffA);
    if (wr == 1) PG8_BAR;
    PG8_WAIT_V(2); PG8_BAR;
    PG8_STAGE(PG8_SB(1, 0), cB + kstep, voffB); PG8_STAGE(PG8_SA(1, 0), cA + kstep, voffA); PG8_STAGE(PG8_SB(1, 1), cB + hstepB + kstep, voffB);
    PG8_WAIT_V(6); PG8_BAR;
    for (;;) {
        const bool has_next = S.next(ui + 1, nxt);
        const char* nA = has_next ? (const char*)g.A + (size_t)nxt.pm * tstepA : cA; const char* nB = has_next ? (const char*)g.Bt + (size_t)nxt.pn * tstepB : cB;
        for (int t = 0; t < nt; t += 2) {
            const bool last = (t == nt - 2);
            const char* a1 = cA + (size_t)(t + 1) * kstep;
            const char* a2 = last ? nA : cA + (size_t)(t + 2) * kstep; const char* b2 = last ? nB : cB + (size_t)(t + 2) * kstep;
            const char* a3 = a2 + kstep; const char* b3 = b2 + kstep;
            PG8_LDB(B0, 0, 0); PG8_LDB(B1, 0, 1); PG8_SCHED; PG8_LDA(At, 0, 0); PG8_STAGE(PG8_SA(1, 1), a1 + hstepA, voffA);
            PG8_WAIT_V(8); PG8_WAIT_L(0); PG8_BAR; PG8_MMA(0, 0, At, B0); PG8_MMA(0, 1, At, B1); PG8_BAR; PG8_SCHED;
            PG8_LDA(At, 0, 1); PG8_STAGE(PG8_SB(0, 0), b2, voffB); PG8_STAGE(PG8_SB(0, 1), b2 + hstepB, voffB); PG8_STAGE(PG8_SA(0, 0), a2, voffA);
            PG8_WAIT_V(8); PG8_WAIT_L(0); PG8_BAR; PG8_MMA(1, 0, At, B0); PG8_MMA(1, 1, At, B1); PG8_BAR; PG8_SCHED;
            PG8_LDB(B0, 1, 0); PG8_LDB(B1, 1, 1); PG8_SCHED; PG8_LDA(At, 1, 0); PG8_STAGE(PG8_SA(0, 1), a2 + hstepA, voffA);
            PG8_WAIT_V(8); PG8_WAIT_L(0); PG8_BAR; PG8_MMA(0, 0, At, B0); PG8_MMA(0, 1, At, B1); PG8_BAR; PG8_SCHED;
            PG8_LDA(At, 1, 1); PG8_STAGE(PG8_SB(1, 0), b3, voffB); PG8_STAGE(PG8_SB(1, 1), b3 + hstepB, voffB); PG8_STAGE(PG8_SA(1, 0), a3, voffA);
            PG8_WAIT_V(8); PG8_WAIT_L(0); PG8_BAR; PG8_MMA(1, 0, At, B0); PG8_MMA(1, 1, At, B1); PG8_BAR; PG8_SCHED;
        }
        if constexpr (ALIGN_EPI) { if (wr == 0) PG8_BAR; }
        E(acc, cur, wr, wc, fr, fq);
        if (!has_next) break;
#pragma unroll
        for (int a = 0; a < 2; ++a)
#pragma unroll
            for (int b = 0; b < 2; ++b)
#pragma unroll
                for (int m = 0; m < 4; ++m)
#pragma unroll
                    for (int n = 0; n < 2; ++n) acc[a][b][m][n] = (f32x4){0.f, 0.f, 0.f, 0.f};
        cur = nxt; cA = nA; cB = nB; ++ui;
        if constexpr (ALIGN_EPI) { if (wr == 1) PG8_BAR; }
    }
    PG8_WAIT_V(0);
    if constexpr (!ALIGN_EPI) { if (wr == 0) PG8_BAR; }
    PG8_BAR;
#undef PG8_SA
#undef PG8_SB
#undef PG8_STAGE
#undef PG8_LDA
#undef PG8_LDB
#undef PG8_MMA
#undef PG8_WAIT_V
#undef PG8_WAIT_L
#undef PG8_BAR
#undef PG8_SCHED
}
}
namespace att {
typedef unsigned short bf16;
typedef short bf16x8 __attribute__((ext_vector_type(8)));
typedef short s16x4 __attribute__((ext_vector_type(4)));
typedef float f32x16 __attribute__((ext_vector_type(16)));
typedef float f32x4 __attribute__((ext_vector_type(4)));
typedef unsigned u32x4 __attribute__((ext_vector_type(4)));
constexpr int D = 128;
constexpr float SCALE = 0.08838834764831845f;
constexpr float THR = 8.f;
constexpr int NW = 8, QBLK = 32, KVBLK = 64, QB = NW * QBLK;
constexpr int SHM_V = KVBLK * D * 2, SHM_K = KVBLK * D * 2;
constexpr int LDS_BYTES = 2 * SHM_V + 2 * SHM_K + NW * 64 * 4;
constexpr int LDS_QIMG = LDS_BYTES + 32, LDS_TOTAL = LDS_QIMG + NW * 8192;

#define KSWZ(row, colB) ((row) * 256 + ((colB) ^ (((row) & 7) << 4)))
#define SBAR() __builtin_amdgcn_sched_barrier(0)
__device__ __forceinline__ int v_st(int k, int c) { const int kk = (k & ~0xC) | ((k & 4) << 1) | ((k & 8) >> 1); return ((kk >> 3) * 4 + (c >> 5)) * 512 + ((kk & 7) * 32 + (c & 31)) * 2; }
__device__ __forceinline__ int v_rd_base(int lane) { return ((lane & 3) << 3) | (((lane >> 2) & 3) << 6) | (((lane >> 4) & 1) << 5) | (((lane >> 5) & 1) << 8); }
constexpr int v_rd_off(int d0, int ks, int half) { return d0 * 512 + ks * 4096 + half * 2048; }
__device__ __forceinline__ int crow(int r, int hi) { return (r & 3) + 8 * (r >> 2) + 4 * hi; }
__device__ __forceinline__ unsigned cvtpk(float lo, float hi) { unsigned r; asm volatile("v_cvt_pk_bf16_f32 %0, %1, %2" : "=v"(r) : "v"(lo), "v"(hi)); return r; }
__device__ __forceinline__ bf16x8 load8(const bf16* p) { return *reinterpret_cast<const bf16x8*>(p); }
template <bool ZERO>
__device__ __forceinline__ void mask_tile(f32x16& p0, f32x16& p1, int dq) {
    const float NEG = ZERO ? 0.f : -__builtin_inff();
#pragma unroll
    for (int r = 0; r < 16; ++r) {
        const int c = (r & 3) + 8 * (r >> 2);
        if (dq - c < 0) p0[r] = NEG;
        if (dq - c - 32 < 0) p1[r] = NEG;
    }
}
__device__ __forceinline__ void partialSM(f32x16& p0, f32x16& p1, float& m_reg, float& mn, float& alpha) {
    float pmax = p0[0]; for (int r = 1; r < 16; ++r) pmax = fmaxf(pmax, p0[r]); for (int r = 0; r < 16; ++r) pmax = fmaxf(pmax, p1[r]);
    { auto rr = __builtin_amdgcn_permlane32_swap(__float_as_uint(pmax), __float_as_uint(pmax), false, false);
      pmax = fmaxf(__uint_as_float(rr[0]), __uint_as_float(rr[1])); }
    constexpr float C2 = 1.4426950408889634f * SCALE;
    if (__builtin_expect(__all((pmax - m_reg) * SCALE <= THR), 1)) { mn = m_reg; alpha = 1.f; }
    else { mn = fmaxf(m_reg, pmax); alpha = __builtin_amdgcn_exp2f((m_reg - mn) * C2); m_reg = mn; }
    const float mnL = -mn * C2;
    for (int r = 0; r < 16; ++r) p0[r] = fmaf(p0[r], C2, mnL); for (int r = 0; r < 16; ++r) p1[r] = fmaf(p1[r], C2, mnL);
    for (int r = 0; r < 16; ++r) p0[r] = __builtin_amdgcn_exp2f(p0[r]);
}
#define ATT_PK4(P, B_, OUT) do { unsigned a0 = cvtpk(P[B_+0], P[B_+1]), a1 = cvtpk(P[B_+2], P[B_+3]);                          \
        unsigned b0 = cvtpk(P[B_+4], P[B_+5]), b1 = cvtpk(P[B_+6], P[B_+7]);                                             \
        auto r0 = __builtin_amdgcn_permlane32_swap(a0, b0, false, false); auto r1 = __builtin_amdgcn_permlane32_swap(a1, b1, false, false); \
        u32x4 w = {r0[0], r1[0], r0[1], r1[1]}; OUT = *reinterpret_cast<bf16x8*>(&w); } while (0)
__device__ __forceinline__ void finishSM(f32x16& p0, f32x16& p1, float alpha, float& l_reg, bf16x8& pa0, bf16x8& pa1, bf16x8& pa2, bf16x8& pa3) {
    for (int r = 0; r < 16; ++r) p1[r] = __builtin_amdgcn_exp2f(p1[r]);
    float ps = 0; for (int r = 0; r < 16; ++r) ps += p0[r]; for (int r = 0; r < 16; ++r) ps += p1[r];
    { auto rr = __builtin_amdgcn_permlane32_swap(__float_as_uint(ps), __float_as_uint(ps), false, false);
      ps = __uint_as_float(rr[0]) + __uint_as_float(rr[1]); }
    l_reg = l_reg * alpha + ps;
    ATT_PK4(p0, 0, pa0); ATT_PK4(p0, 8, pa1); ATT_PK4(p1, 0, pa2); ATT_PK4(p1, 8, pa3);
}
__device__ __forceinline__ void partialLin(f32x16& p0, f32x16& p1, float f) {
    for (int r = 0; r < 16; ++r) { p0[r] *= f; p1[r] *= f; }
}
__device__ __forceinline__ void finishLin(f32x16& p0, f32x16& p1, float& den, bf16x8& pa0, bf16x8& pa1, bf16x8& pa2, bf16x8& pa3) {
    float ps = 0; for (int r = 0; r < 16; ++r) ps += p0[r]; for (int r = 0; r < 16; ++r) ps += p1[r];
    den += ps;
    ATT_PK4(p0, 0, pa0); ATT_PK4(p0, 8, pa1); ATT_PK4(p1, 0, pa2); ATT_PK4(p1, 8, pa3);
}
template <int KB, bool QL>
__device__ __forceinline__ void qkt(f32x16& p0, f32x16& p1, const char* K_lds, int r32, int hi, const bf16x8* qr, const char* qlds) {
    p0 = f32x16{}; p1 = f32x16{};
    __builtin_amdgcn_s_setprio(1);
    const char* kb[4];
#pragma unroll
    for (int dd = 0; dd < 4; ++dd) kb[dd] = K_lds + KB * SHM_K + KSWZ(r32, (dd * 16 + hi * 8) * 2);
#pragma unroll
    for (int d0 = 0; d0 < 8; ++d0) { const char* a = kb[d0 & 3] + (d0 >> 2) * 128;
        bf16x8 b0 = *reinterpret_cast<const bf16x8*>(a);
        bf16x8 b1 = *reinterpret_cast<const bf16x8*>(a + 32 * 256);
        bf16x8 qf; if constexpr (QL) qf = *reinterpret_cast<const bf16x8*>(qlds + d0 * 1024); else qf = qr[d0];
        p0 = __builtin_amdgcn_mfma_f32_32x32x16_bf16(b0, qf, p0, 0, 0, 0);
        p1 = __builtin_amdgcn_mfma_f32_32x32x16_bf16(b1, qf, p1, 0, 0, 0); }
    __builtin_amdgcn_s_setprio(0);
}
template <int VB>
__device__ __forceinline__ void pv_tile(f32x16* o, int vb0, bf16x8 pa0, bf16x8 pa1, bf16x8 pa2, bf16x8 pa3) {
#define TRRD(dst, off) asm volatile("ds_read_b64_tr_b16 %0, %1 offset:%2" : "=&v"(dst) : "v"(vb0), "i"(off) : "memory")
#define PV_D0(d0) do { s16x4 l0, l1, l2, l3, h0, h1, h2, h3; constexpr int b_ = VB * SHM_V + v_rd_off(d0, 0, 0); \
        TRRD(l0, b_); TRRD(h0, b_ + 2048); TRRD(l1, b_ + 4096); TRRD(h1, b_ + 6144); TRRD(l2, b_ + 8192); TRRD(h2, b_ + 10240); TRRD(l3, b_ + 12288); TRRD(h3, b_ + 14336); \
        asm volatile("s_waitcnt lgkmcnt(0)" ::: "memory"); SBAR();   \
        o[d0] = __builtin_amdgcn_mfma_f32_32x32x16_bf16(pa0, (bf16x8){l0[0], l0[1], l0[2], l0[3], h0[0], h0[1], h0[2], h0[3]}, o[d0], 0, 0, 0);   \
        o[d0] = __builtin_amdgcn_mfma_f32_32x32x16_bf16(pa1, (bf16x8){l1[0], l1[1], l1[2], l1[3], h1[0], h1[1], h1[2], h1[3]}, o[d0], 0, 0, 0);   \
        o[d0] = __builtin_amdgcn_mfma_f32_32x32x16_bf16(pa2, (bf16x8){l2[0], l2[1], l2[2], l2[3], h2[0], h2[1], h2[2], h2[3]}, o[d0], 0, 0, 0);   \
        o[d0] = __builtin_amdgcn_mfma_f32_32x32x16_bf16(pa3, (bf16x8){l3[0], l3[1], l3[2], l3[3], h3[0], h3[1], h3[2], h3[3]}, o[d0], 0, 0, 0); } while (0)
    __builtin_amdgcn_s_setprio(1);
    PV_D0(0); PV_D0(1); PV_D0(2); PV_D0(3);
    __builtin_amdgcn_s_setprio(0);
#undef PV_D0
#undef TRRD
}

struct BlockRef { const bf16* Q; const bf16* K; const bf16* V; float* O; int P0; };
struct LinRef { const float* MT; const float* EMT; const float* REF; };
struct Seam { bf16x8 qr[8]; bf16x8 st_v0, st_v1, st_k0, st_k1; };

#define ATT_VMW() asm volatile("s_waitcnt vmcnt(0)" ::: "memory")
#define ATT_VMWN(n) asm volatile("s_waitcnt vmcnt(%0)" :: "i"(n) : "memory")
__device__ __forceinline__ bf16x8 load8o(const bf16* base, unsigned voff) { return *reinterpret_cast<const bf16x8*>(reinterpret_cast<const char*>(base) + voff); }
template <class T> __device__ __forceinline__ T* uni(T* p) {
    const unsigned long long u = (unsigned long long)p; const unsigned lo = __builtin_amdgcn_readfirstlane((unsigned)u), hi = __builtin_amdgcn_readfirstlane((unsigned)(u >> 32));
    return (T*)(((unsigned long long)hi << 32) | lo); }
#define ATT_SLOAD(Kp, Vp, k0) do { const bf16* vb_ = uni((Vp) + (size_t)(k0) * LDV); const bf16* kb_ = uni((Kp) + (size_t)(k0) * LDK);                                         \
                                   S.st_v0 = load8o(vb_, offV); S.st_v1 = load8o(vb_, offV + 32u * LDV * 2u);              \
                                   S.st_k0 = load8o(kb_, offK); S.st_k1 = load8o(kb_, offK + 32u * LDK * 2u); } while (0)
#define ATT_SWRITE_K(bf) do { *(bf16x8*)(K_lds + (bf) * SHM_K + kws) = S.st_k0; *(bf16x8*)(K_lds + (bf) * SHM_K + kws + 32 * 256) = S.st_k1; } while (0)
#define ATT_SWRITE_V(bf) do { *(bf16x8*)(V_lds + (bf) * SHM_V + vst0) = S.st_v0; *(bf16x8*)(V_lds + (bf) * SHM_V + vst1) = S.st_v1; } while (0)

template <int LDQ, int LDK, int LDV>
__device__ __forceinline__ void prime(const BlockRef& cur, char* lds, Seam& S, const int tid) {
    const int wid = __builtin_amdgcn_readfirstlane(tid >> 6), lane = tid & 63, r32 = lane & 31, hi = lane >> 5;
    const int sr = tid >> 4, sc = (tid & 15) * 8, kws = KSWZ(sr, sc * 2); char* K_lds = lds + 2 * SHM_V;
    const unsigned offV = (unsigned)(sr * LDV + sc) * 2u, offK = (unsigned)(sr * LDK + sc) * 2u, offQ = (unsigned)(r32 * LDQ + hi * 8) * 2u;
    { const bf16* qb_ = uni(cur.Q + (size_t)(wid * QBLK) * LDQ);
#pragma unroll
    for (int d0 = 0; d0 < 8; ++d0) S.qr[d0] = load8o(qb_, offQ + d0 * 32u); }
    ATT_SLOAD(cur.K, cur.V, 0); ATT_VMW(); ATT_SWRITE_K(0);
    __syncthreads();
}

__device__ __forceinline__ void put_next(char* lds, const BlockRef& nxt, const int tid) {
    if (tid == 0) { volatile unsigned long long* p = (volatile unsigned long long*)(lds + LDS_BYTES); p[0] = (unsigned long long)nxt.Q; p[1] = (unsigned long long)nxt.K; p[2] = (unsigned long long)nxt.V; }
}
__device__ __forceinline__ const bf16* get_next(char* lds, int k) {
    const volatile unsigned* p = (const volatile unsigned*)(lds + LDS_BYTES) + 2 * k; const unsigned lo = p[0], hi = p[1];
    return (const bf16*)(((unsigned long long)(unsigned)__builtin_amdgcn_readfirstlane(hi) << 32) | (unsigned)__builtin_amdgcn_readfirstlane(lo));
}
template <int LDQ, int LDK, int LDV, int LDO, int MODE>
__device__ __forceinline__ void block(const BlockRef& cur, char* lds, Seam& S, float lam, const LinRef& lr, const int tid) {
    constexpr bool LIN = (MODE == 2);
    const int wid = __builtin_amdgcn_readfirstlane(tid >> 6), lane = tid & 63, r32 = lane & 31, hi = lane >> 5;
    const int NT = cur.P0 / KVBLK + QB / KVBLK;
    const int qlo = cur.P0 + wid * QBLK, qm = qlo + r32 - 4 * hi;
    char* V_lds = lds; char* K_lds = lds + 2 * SHM_V;
    float* ws = (float*)(lds + 2 * SHM_V + 2 * SHM_K) + wid * 64; float* li_l = ws, * al_l = ws + 32;
    float m_reg = -1e30f, l_reg = 0; f32x16 o[4] = {};
    const int sr = tid >> 4, sc = (tid & 15) * 8, vst0 = v_st(sr, sc), vst1 = v_st(32 + sr, sc), kws = KSWZ(sr, sc * 2);
    const int vb0 = (int)(uintptr_t)V_lds + v_rd_base(lane);
    const bf16* Kh = cur.K; const bf16* Vh = cur.V;
    const unsigned offV = (unsigned)(sr * LDV + sc) * 2u, offK = (unsigned)(sr * LDK + sc) * 2u, offQ = (unsigned)(r32 * LDQ + hi * 8) * 2u;
    float Mt = 0.f; if constexpr (LIN) Mt = *reinterpret_cast<const float*>(reinterpret_cast<const char*>(uni(lr.MT + qlo)) + (unsigned)r32 * 4u);
#define ATT_RESC(a) do { if constexpr (!LIN) { if (__any((a) < 1.f)) { if (hi == 0) al_l[r32] = (a); asm volatile("s_waitcnt lgkmcnt(0)" ::: "memory");              \
                     for (int d_ = 0; d_ < 4; ++d_) for (int r = 0; r < 16; ++r) o[d_][r] *= al_l[crow(r, hi)]; } } } while (0)
#define ATT_KBASE(t) ((t) * KVBLK)
#define ATT_MASKT(P0_, P1_, t) do { const int kb_ = ATT_KBASE(t); if (kb_ + KVBLK - 1 > qlo) mask_tile<LIN>(P0_, P1_, qm - kb_); } while (0)
#define ATT_PSM(P0_, P1_, mnX, alX, t) do { if constexpr (LIN) { mnX = __builtin_amdgcn_exp2f((lr.REF[t] - Mt) * 1.4426950408889634f); } \
                                            else partialSM(P0_, P1_, m_reg, mnX, alX); } while (0)
#define ATT_FSM(P0_, P1_, alY, mnY) do { if constexpr (LIN) { partialLin(P0_, P1_, mnY); finishLin(P0_, P1_, l_reg, pa0, pa1, pa2, pa3); } else finishSM(P0_, P1_, alY, l_reg, pa0, pa1, pa2, pa3); } while (0)
#define ATT_SEAM_K0() do { ATT_VMW(); ATT_SWRITE_K(0); SBAR(); } while (0)
    f32x16 pA0, pA1, pB0, pB1; float mnA = 0.f, mnB = 0.f, alA = 1.f, alB = 1.f; bf16x8 pa0, pa1, pa2, pa3;
    ATT_SWRITE_V(0); SBAR();
    const char* qlds = lds + LDS_QIMG + wid * 8192 + lane * 16;
    if constexpr (LIN) {
#pragma unroll
        for (int d0 = 0; d0 < 8; ++d0) *reinterpret_cast<bf16x8*>(const_cast<char*>(qlds) + d0 * 1024) = S.qr[d0];
    }
    if (NT > 1) ATT_SLOAD(Kh, Vh, ATT_KBASE(1));
    SBAR(); qkt<0, LIN>(pA0, pA1, K_lds, r32, hi, S.qr, qlds);
    ATT_MASKT(pA0, pA1, 0); ATT_PSM(pA0, pA1, mnA, alA, 0);
    if (NT > 1) { ATT_VMW(); ATT_SWRITE_V(1); ATT_SWRITE_K(1); }
    __syncthreads();
#define ATT_HALF_STEP(PX0, PX1, mnX, alX, PY0, PY1, alY, mnY, t, KB, VB, SB) do {                                                      \
        SBAR(); qkt<KB, LIN>(PX0, PX1, K_lds, r32, hi, S.qr, qlds);                                             \
        ATT_FSM(PY0, PY1, alY, mnY); SBAR();                                                           \
        if ((t) + 1 < NT) { ATT_SLOAD(Kh, Vh, ATT_KBASE((t) + 1)); SBAR(); }                                               \
        pv_tile<VB>(o, vb0, pa0, pa1, pa2, pa3); ATT_MASKT(PX0, PX1, (t)); ATT_PSM(PX0, PX1, mnX, alX, (t));                                        \
        __syncthreads();                                                                                                      \
        if ((t) + 1 < NT) { ATT_VMW(); ATT_SWRITE_V(SB); ATT_SWRITE_K(SB); }                                                                          \
        ATT_RESC(alX); __syncthreads(); } while (0)
    for (int t = 1; t + 1 < NT; t += 2) {
        ATT_HALF_STEP(pB0, pB1, mnB, alB, pA0, pA1, alA, mnA, t, 1, 0, 0);
        ATT_HALF_STEP(pA0, pA1, mnA, alA, pB0, pB1, alB, mnB, t + 1, 0, 1, 1);
    }
    SBAR(); qkt<1, LIN>(pB0, pB1, K_lds, r32, hi, S.qr, qlds); SBAR();
    { const bf16* nK = get_next(lds, 1); const bf16* nV = get_next(lds, 2); ATT_SLOAD(nK, nV, 0); } SBAR();
    ATT_FSM(pA0, pA1, alA, mnA); SBAR();
    pv_tile<0>(o, vb0, pa0, pa1, pa2, pa3);
    ATT_MASKT(pB0, pB1, NT - 1); ATT_PSM(pB0, pB1, mnB, alB, NT - 1); __syncthreads(); ATT_RESC(alB);
    ATT_FSM(pB0, pB1, alB, mnB); SBAR(); pv_tile<1>(o, vb0, pa0, pa1, pa2, pa3);
    SBAR(); ATT_SEAM_K0();
    { const bf16* qb_ = uni(get_next(lds, 0) + (size_t)(wid * QBLK) * LDQ);
#pragma unroll
    for (int d0 = 0; d0 < 8; ++d0) S.qr[d0] = load8o(qb_, offQ + d0 * 32u); }
    SBAR();
    if constexpr (LIN) { auto rr = __builtin_amdgcn_permlane32_swap(__float_as_uint(l_reg), __float_as_uint(l_reg), false, false); l_reg = __uint_as_float(rr[0]) + __uint_as_float(rr[1]); }
    if (hi == 0) li_l[r32] = l_reg; asm volatile("s_waitcnt lgkmcnt(0)" ::: "memory");
    float rli[16];
    const float* emtp = LIN ? reinterpret_cast<const float*>(reinterpret_cast<const char*>(uni(lr.EMT + (cur.P0 + wid * QBLK))) + (unsigned)hi * 16u) : nullptr;
#pragma unroll
    for (int r = 0; r < 16; ++r) {
        const float lv = li_l[crow(r, hi)];
        if constexpr (LIN) { const float em = emtp[(r & 3) + 8 * (r >> 2)]; rli[r] = __builtin_amdgcn_rcpf(fmaxf(fabsf(lv), em)); }
        else rli[r] = __builtin_amdgcn_rcpf(lv);
    }
    char* Ow = reinterpret_cast<char*>(uni(cur.O + (size_t)(wid * QBLK) * LDO));
    const unsigned offO = (unsigned)(4 * hi * LDO + r32) * 4u;
#pragma unroll
    for (int r = 0; r < 16; ++r) {
#pragma unroll
        for (int d0 = 0; d0 < 4; ++d0) { const float v = o[d0][r] * rli[r];
            float* p = reinterpret_cast<float*>(Ow + (offO + (unsigned)((((r & 3) + 8 * (r >> 2)) * LDO + d0 * 32) * 4)));
            if constexpr (MODE == 1) { const float prev = *p; *p = prev - lam * v; }
            else *p = v; } }
    __syncthreads();
#undef ATT_RESC
#undef ATT_KBASE
#undef ATT_MASKT
#undef ATT_PSM
#undef ATT_FSM
#undef ATT_SEAM_K0
#undef ATT_HALF_STEP
}
#undef ATT_VMW
#undef ATT_VMWN
#undef ATT_SLOAD
#undef ATT_SWRITE_K
#undef ATT_SWRITE_V
#undef ATT_PK4
#undef KSWZ
#undef SBAR
}
constexpr int NWAVES = 8;
constexpr int DM = 2048, NB = 8, SEQ = 4096, DEPTH = 4, M = NB * SEQ;
constexpr int DIN = 13320, NP = 13312, DFF = 5632, NGU = 2 * DFF;
constexpr int C_MQK = 0, C_MV = 1024, C_MO = 2048, C_AQ = 3072, C_AK = 5120, C_AV = 7168, C_GM = 9216, C_GA = 11264;
constexpr float EPS = 1e-6f;
#ifndef DBG
#define DBG 0
#endif

constexpr size_t MiB = 1u << 20;
constexpr size_t WS_CTL = 0, CTL_ZERO_BYTES = 1 * MiB;
constexpr size_t WS_ROPE = 2 * MiB;
constexpr size_t WS_LIF = 6 * MiB;
constexpr size_t WS_MT = 7 * MiB;
constexpr size_t WS_EMT = WS_MT + 512 * 1024;
constexpr size_t WS_KSC = 8 * MiB;
constexpr size_t WS_REF = WS_KSC + 512 * 1024;
constexpr size_t WS_WIN = 16 * MiB, WS_PM = 68 * MiB, WS_PA = 72 * MiB, WS_WO = 80 * MiB, WS_WGU = 88 * MiB, WS_WD = 132 * MiB;
constexpr size_t WS_HY = 154 * MiB;
constexpr size_t WS_QKM = 282 * MiB;
constexpr size_t WS_HT = 346 * MiB;
constexpr size_t WS_OST = 474 * MiB;
constexpr size_t WS_PROJ = 730 * MiB;
constexpr size_t WS_END = 1562 * MiB;
static_assert(WS_PROJ + (size_t)M * NP * 2 == WS_END, "ws map");
constexpr int CW_BAR = 4096;

constexpr int RING_OFF = 0, RING_BYTES = 135168;
constexpr int LDSCTL_OFF = RING_BYTES, MISC_OFF = LDSCTL_OFF + 320;
constexpr int LDS_BYTES = 147456;

#define GAS __attribute__((address_space(1)))
#define LAS __attribute__((address_space(3)))
typedef unsigned short bf16;
typedef unsigned v4u __attribute__((ext_vector_type(4)));
typedef unsigned v2u __attribute__((ext_vector_type(2)));
typedef float f32x4 __attribute__((ext_vector_type(4)));
typedef GAS unsigned gu32;
#define LDS_WAIT() asm volatile("s_waitcnt lgkmcnt(0)" ::: "memory")
#define VM_WAIT() asm volatile("s_waitcnt vmcnt(0)" ::: "memory")
__device__ __forceinline__ unsigned f2bf(float f) { unsigned u = __builtin_bit_cast(unsigned, f); return (u + 0x7fffu + ((u >> 16) & 1u)) >> 16; }
__device__ __forceinline__ unsigned pk2(float lo, float hi) { return f2bf(lo) | (f2bf(hi) << 16); }
__device__ __forceinline__ float bflo(unsigned u) { return __uint_as_float(u << 16); }
__device__ __forceinline__ float bfhi(unsigned u) { return __uint_as_float(u & 0xffff0000u); }
__device__ __forceinline__ float bf2f(bf16 h) { return __uint_as_float((unsigned)h << 16); }
#define SWZ_XOR(v, o) __uint_as_float((unsigned)__builtin_amdgcn_ds_swizzle((int)__float_as_uint(v), ((o) << 10) | 0x1f))
__device__ __forceinline__ float xhalf(float v, bool is_max) { auto rr = __builtin_amdgcn_permlane32_swap(__float_as_uint(v), __float_as_uint(v), false, false);
    const float a = __uint_as_float(rr[0]), b = __uint_as_float(rr[1]); return is_max ? fmaxf(a, b) : a + b; }
__device__ __forceinline__ float wave_sum(float v) {
    v += SWZ_XOR(v, 1); v += SWZ_XOR(v, 2); v += SWZ_XOR(v, 4); v += SWZ_XOR(v, 8); v += SWZ_XOR(v, 16);
    return xhalf(v, false);
}
__device__ __forceinline__ float shfl_up_l(float v, int o, int lane) { return __uint_as_float((unsigned)__builtin_amdgcn_ds_bpermute(((lane - o) & 63) << 2, (int)__float_as_uint(v))); }
__device__ __forceinline__ float sigmoidf_(float x) { return 1.0f / (1.0f + __expf(-x)); }

#define XB_TMO      128
#define XB_XCNT(j)  (256  + 64 * (j))
#define XB_XSUB(j)  (1280 + 64 * (j))
#define XB_XGEN(j)  (2304 + 64 * (j))
#define XB_TOP      3328
#define XB_TOPGEN   3392
#define XCD_BAR_WORDS 3456
#define XB_SPIN_CAP (1u << 18)
__device__ __forceinline__ unsigned xb_ld(unsigned* p)              { return __hip_atomic_load(p, __ATOMIC_RELAXED, __HIP_MEMORY_SCOPE_AGENT); }
__device__ __forceinline__ unsigned xb_add(unsigned* p, unsigned v) { return __hip_atomic_fetch_add(p, v, __ATOMIC_RELAXED, __HIP_MEMORY_SCOPE_AGENT); }
__device__ __forceinline__ unsigned xb_xcc_id() { return (unsigned)__builtin_amdgcn_s_getreg((3 << 11) | 20) & 0xFu; }
#define XB_SPIN(cond, bar) do { unsigned _sp = 0; while (cond) { __builtin_amdgcn_s_sleep(1); \
    if ((++_sp & 255u) == 0u) { if (xb_ld(&(bar)[XB_TMO])) break; if (_sp > XB_SPIN_CAP) { atomicAdd(&(bar)[XB_TMO], 1u); break; } } } } while (0)
struct XcdBarrier { unsigned* bar; unsigned x; volatile LAS unsigned* st; };
__device__ __forceinline__ XcdBarrier xcd_barrier_post(unsigned* bar, volatile LAS unsigned* st) {
    XcdBarrier b; b.bar = bar; b.x = xb_xcc_id(); b.st = st;
    if (threadIdx.x == 0) (void)xb_add(&bar[XB_XCNT(b.x)], 1u);
    return b;
}
__device__ __forceinline__ void xcd_barrier_complete(unsigned* bar, unsigned x, unsigned& nloc, unsigned& nx) {
    const unsigned G = gridDim.x * gridDim.y * gridDim.z;
    unsigned sum, cnt, mine, sp = 0u;
    for (;;) {
        sum = 0u; cnt = 0u; mine = 0u;
#pragma unroll
        for (unsigned j = 0; j < 16; ++j) { const unsigned c = xb_ld(&bar[XB_XCNT(j)]); sum += c; cnt += (c > 0u) ? 1u : 0u; mine = (j == x) ? c : mine; }
        if (sum == G) break;
        __builtin_amdgcn_s_sleep(1);
        if ((++sp & 255u) == 0u) { if (xb_ld(&bar[XB_TMO])) break; if (sp > XB_SPIN_CAP) { atomicAdd(&bar[XB_TMO], 1u); break; } }
    }
    nloc = mine > 0u ? mine : 1u; nx = cnt > 0u ? cnt : 1u;
}
__device__ __forceinline__ void xcd_barrier(const XcdBarrier& b) {
    asm volatile("s_waitcnt vmcnt(0)" ::: "memory");
    __syncthreads();
    if (threadIdx.x == 0) {
        unsigned* bar = b.bar;
        __builtin_amdgcn_s_waitcnt(0);
        unsigned nloc = b.st[0], nx = b.st[1];
        if (nloc == 0u) { xcd_barrier_complete(bar, b.x, nloc, nx); b.st[0] = nloc; b.st[1] = nx; }
        const unsigned old = xb_add(&bar[XB_XSUB(b.x)], 1u);
        const unsigned gen = old / nloc;
        if (old + 1u == (gen + 1u) * nloc) {
            __builtin_amdgcn_fence(__ATOMIC_RELEASE, "agent");
            asm volatile("s_waitcnt vmcnt(0)" ::: "memory");
            const unsigned og = xb_add(&bar[XB_TOP], 1u);
            const unsigned tg = og / nx;
            if (og + 1u == (tg + 1u) * nx) xb_add(&bar[XB_TOPGEN], 1u);
            else XB_SPIN(xb_ld(&bar[XB_TOPGEN]) == tg, bar);
            __builtin_amdgcn_fence(__ATOMIC_ACQUIRE, "agent");
            xb_add(&bar[XB_XGEN(b.x)], 1u);
            asm volatile("s_waitcnt vmcnt(0)" ::: "memory");
        } else {
            XB_SPIN(xb_ld(&bar[XB_XGEN(b.x)]) == gen, bar);
            __builtin_amdgcn_fence(__ATOMIC_ACQUIRE, "agent");
            asm volatile("s_waitcnt vmcnt(0)" ::: "memory");
        }
    }
    __syncthreads();
}

__device__ const double ROPE_INV[16] = {1.0, 0.44036660267178046, 0.19392274474868576, 0.08539710028576561, 0.03760603093086393, 0.016560440080994446, 0.007292664737217109, 0.003211445994752591,
    0.001414213562373095, 0.000622772421914596, 0.0002742481756762073, 0.00012076973741146504, 5.318295896944988e-05, 2.341999896140934e-05, 1.031338537721246e-05, 4.5416704806078695e-06};

__device__ __forceinline__ void rope_table_phase(const int* pos, float* rope, int gtid, int gthreads) {
    for (int idx = gtid; idx < M * 16; idx += gthreads) {
        const int row = idx >> 4, i = idx & 15;
        const float angf = (float)pos[row] * (float)ROPE_INV[i];
        const double rev = (double)angf * 0.15915494309189535;
        const float fr = (float)(rev - __builtin_rint(rev));
        rope[(size_t)row * 32 + i] = __builtin_amdgcn_cosf(fr);
        rope[(size_t)row * 32 + 16 + i] = __builtin_amdgcn_sinf(fr);
    }
}

__device__ __forceinline__ void tr_item64(const float* W, int ldw, int K, bf16* WT, int k0, int n0d, int n0s, bool ropeperm, LAS float* scr, int lane) {
    const int c = lane & 15, rr = lane >> 4;
    f32x4 v[16];
    const float* src = W + (size_t)(k0 + rr) * ldw + n0s + 4 * c;
#pragma unroll
    for (int i = 0; i < 16; ++i) v[i] = *(const GAS f32x4*)(src + (size_t)(4 * i) * ldw);
#pragma unroll
    for (int i = 0; i < 16; ++i) { LAS float* d = scr + (4 * c) * 65 + 4 * i + rr; d[0] = v[i].x; d[65] = v[i].y; d[130] = v[i].z; d[195] = v[i].w; }
    LDS_WAIT(); asm volatile("" ::: "memory");
    const int c8 = lane & 7;
#pragma unroll
    for (int j = 0; j < 8; ++j) { const int n = 8 * j + (lane >> 3); const int ns = (ropeperm && n < 32) ? ((n >> 1) + 16 * (n & 1)) : n; const LAS float* s = scr + ns * 65 + 8 * c8;
        v4u o; o.x = pk2(s[0], s[1]); o.y = pk2(s[2], s[3]); o.z = pk2(s[4], s[5]); o.w = pk2(s[6], s[7]);
        *(GAS v4u*)(WT + (size_t)(n0d + n) * K + k0 + 8 * c8) = o; }
    LDS_WAIT(); asm volatile("" ::: "memory");
}

__device__ __forceinline__ void convert_weights_phase(int l, const float* w_in, const float* p_m, const float* p_a, const float* w_out, const float* w_gate, const float* w_up, const float* w_down,
                                                      unsigned char* ws, LAS float* scr, int gw, int ngw, int lane) {
    constexpr int I1 = (DM / 64) * (NP / 64), I2 = (1024 / 64) * (DM / 64), I3 = (DM / 64) * (DM / 64), I4 = I3, I5 = (DM / 64) * (NGU / 64), I6 = (DFF / 64) * (DM / 64);
    constexpr int NIT = I1 + I2 + I3 + I4 + I5 + I6;
    for (int it = gw; it < NIT; it += ngw) {
        int r = it; const float* W; int ldw, K, nblk; size_t wsoff; int mode;
        if (r < I1) { W = w_in + (size_t)l * DM * DIN; ldw = DIN; K = DM; nblk = NP / 64; wsoff = WS_WIN; mode = 1; }
        else if ((r -= I1) < I2) { W = p_m + (size_t)l * 1024 * DM; ldw = DM; K = 1024; nblk = DM / 64; wsoff = WS_PM; mode = 0; }
        else if ((r -= I2) < I3) { W = p_a + (size_t)l * DM * DM; ldw = DM; K = DM; nblk = DM / 64; wsoff = WS_PA; mode = 0; }
        else if ((r -= I3) < I4) { W = w_out + (size_t)l * DM * DM; ldw = DM; K = DM; nblk = DM / 64; wsoff = WS_WO; mode = 0; }
        else if ((r -= I4) < I5) { W = nullptr; ldw = DFF; K = DM; nblk = NGU / 64; wsoff = WS_WGU; mode = 2; }
        else { r -= I5; W = w_down + (size_t)l * DFF * DM; ldw = DM; K = DFF; nblk = DM / 64; wsoff = WS_WD; mode = 0; }
        const int kb = r / nblk, nb = r % nblk, n0d = nb * 64; int n0s = n0d; bool rp = false;
        if (mode == 1) { n0s = n0d < 3072 ? n0d : n0d + 8; rp = (n0d >= C_AQ && n0d < C_AV && (n0d & 127) == 0); }
        if (mode == 2) { const int pn = n0d >> 8, r0 = n0d & 255; W = (r0 < 128 ? w_gate : w_up) + (size_t)l * DM * DFF; n0s = pn * 128 + (r0 & 127); }
        tr_item64(W, ldw, K, (bf16*)(ws + wsoff), kb * 64, n0d, n0s, rp, scr, lane);
    }
}

__device__ __forceinline__ void norm_row(const float* xrow, const float* g, bf16* orow, int lane, f32x4 (&v)[8]) {
    const GAS f32x4* xr = (const GAS f32x4*)xrow + lane; const GAS f32x4* gr = (const GAS f32x4*)g + lane;
    float s = 0.f;
#pragma unroll
    for (int j = 0; j < 8; ++j) { v[j] = xr[64 * j]; s += (v[j].x * v[j].x + v[j].y * v[j].y) + (v[j].z * v[j].z + v[j].w * v[j].w); }
    const float rstd = 1.0f / sqrtf(wave_sum(s) * (1.f / DM) + EPS);
    GAS unsigned long long* o8 = (GAS unsigned long long*)orow + lane;
#pragma unroll
    for (int j = 0; j < 8; ++j) { const f32x4 gg = gr[64 * j]; v[j] = v[j] * rstd * gg;
        o8[64 * j] = (unsigned long long)pk2(v[j].x, v[j].y) | ((unsigned long long)pk2(v[j].z, v[j].w) << 32); }
}

__device__ __forceinline__ void mlstm_scan(int b, int h, const float* LIF, float* KSC, float* MT, float* EMT, float* REF, LAS float* sm, int tid) {
    const int lane = tid & 63, wave = tid >> 6;
    const float* base = LIF + (size_t)(b * SEQ) * 8;
    float li[8], c[8]; float run = 0.f;
#pragma unroll
    for (int j = 0; j < 8; ++j) { const int s = 8 * tid + j; li[j] = base[(size_t)s * 8 + h]; run += base[(size_t)s * 8 + 4 + h]; c[j] = run; }
    float inc = run;
#pragma unroll
    for (int o = 1; o < 64; o <<= 1) { const float vv = shfl_up_l(inc, o, lane); if (lane >= o) inc += vv; }
    if (lane == 63) sm[wave] = inc;
    __syncthreads();
    float woff = 0.f; for (int w = 0; w < wave; ++w) woff += sm[w];
    const float excl = woff + inc - run;
    float a[8], bs[8]; float lmax = -__builtin_inff();
#pragma unroll
    for (int j = 0; j < 8; ++j) { bs[j] = excl + c[j]; a[j] = li[j] - bs[j]; lmax = fmaxf(lmax, a[j]); }
    float tmax = lmax; tmax = fmaxf(tmax, SWZ_XOR(tmax, 1)); tmax = fmaxf(tmax, SWZ_XOR(tmax, 2)); tmax = fmaxf(tmax, SWZ_XOR(tmax, 4));
    float pm = lmax;
#pragma unroll
    for (int o = 1; o < 64; o <<= 1) { const float vv = shfl_up_l(pm, o, lane); if (lane >= o) pm = fmaxf(pm, vv); }
    if (lane == 63) sm[8 + wave] = pm;
    __syncthreads();
    float wpm = -__builtin_inff(); for (int w = 0; w < wave; ++w) wpm = fmaxf(wpm, sm[8 + w]);
    float prevl = shfl_up_l(pm, 1, lane); if (lane == 0) prevl = -__builtin_inff();
    float rmax = fmaxf(0.f, fmaxf(wpm, prevl));
    const size_t o0 = (size_t)(b * 4 + h) * SEQ + 8 * tid;
#pragma unroll
    for (int j = 0; j < 8; ++j) { rmax = fmaxf(rmax, a[j]); MT[o0 + j] = rmax; EMT[o0 + j] = __expf(-(bs[j] + rmax)); KSC[o0 + j] = __expf(a[j] - tmax); }
    if ((tid & 7) == 0) REF[(b * 4 + h) * 64 + (tid >> 3)] = tmax;
    __syncthreads();
}

__device__ __forceinline__ void mprep_strip(int strip, const bf16* PROJ, const float* cw, const float* cb, const float* KSC, bf16* QKM, int lane) {
    const int m0 = strip * 16, b = m0 / SEQ, s0 = m0 % SEQ, hh = lane >> 4;
    float w[4][16], bias[16];
#pragma unroll
    for (int j = 0; j < 4; ++j) {
#pragma unroll
        for (int e = 0; e < 8; ++e) { w[j][e] = cw[j * 1024 + 8 * lane + e]; w[j][8 + e] = cw[j * 1024 + 512 + 8 * lane + e]; } }
#pragma unroll
    for (int e = 0; e < 8; ++e) { bias[e] = cb[8 * lane + e]; bias[8 + e] = cb[512 + 8 * lane + e]; }
    float x0[16], x1[16], x2[16], x3[16];
#define LDROW(dst, s_) do { if ((s_) >= 0) { const bf16* rp = PROJ + (size_t)(b * SEQ + (s_)) * NP + C_MQK; const v4u q4 = *(const GAS v4u*)(rp + 8 * lane); const v4u k4 = *(const GAS v4u*)(rp + 512 + 8 * lane); \
            dst[0] = bflo(q4.x); dst[1] = bfhi(q4.x); dst[2] = bflo(q4.y); dst[3] = bfhi(q4.y); dst[4] = bflo(q4.z); dst[5] = bfhi(q4.z); dst[6] = bflo(q4.w); dst[7] = bfhi(q4.w); \
            dst[8] = bflo(k4.x); dst[9] = bfhi(k4.x); dst[10] = bflo(k4.y); dst[11] = bfhi(k4.y); dst[12] = bflo(k4.z); dst[13] = bfhi(k4.z); dst[14] = bflo(k4.w); dst[15] = bfhi(k4.w); } \
        else { _Pragma("unroll") for (int e_ = 0; e_ < 16; ++e_) dst[e_] = 0.f; } } while (0)
    LDROW(x0, s0 - 3); LDROW(x1, s0 - 2); LDROW(x2, s0 - 1);
    for (int i = 0; i < 16; ++i) {
        const int s = s0 + i;
        LDROW(x3, s);
        const float ksc = KSC[(size_t)(b * 4 + hh) * SEQ + s] * 0.08838834764831845f;
        float y[16];
#pragma unroll
        for (int e = 0; e < 16; ++e) { float t = bias[e] + w[0][e] * x0[e] + w[1][e] * x1[e] + w[2][e] * x2[e] + w[3][e] * x3[e]; t = t * sigmoidf_(t); y[e] = (e < 8) ? t : t * ksc; }
        v4u oq, ok; oq.x = pk2(y[0], y[1]); oq.y = pk2(y[2], y[3]); oq.z = pk2(y[4], y[5]); oq.w = pk2(y[6], y[7]);
        ok.x = pk2(y[8], y[9]); ok.y = pk2(y[10], y[11]); ok.z = pk2(y[12], y[13]); ok.w = pk2(y[14], y[15]);
        bf16* op = QKM + (size_t)(m0 + i) * 1024;
        *(GAS v4u*)(op + 8 * lane) = oq; *(GAS v4u*)(op + 512 + 8 * lane) = ok;
#pragma unroll
        for (int e = 0; e < 16; ++e) { x0[e] = x1[e]; x1[e] = x2[e]; x2[e] = x3[e]; }
    }
#undef LDROW
}

__device__ __forceinline__ void finish_row(int row, const float* HT, const float* OST, bf16* PROJ, const float* g_mhead, const float* g_sub, float one_m_laminit, int lane) {
    bf16* prow = PROJ + (size_t)row * NP;
#pragma unroll
    for (int hh = 0; hh < 4; ++hh) {
        const f32x4 v = *(const GAS f32x4*)(HT + (size_t)row * 1024 + hh * 256 + 4 * lane);
        const float ss = wave_sum((v.x * v.x + v.y * v.y) + (v.z * v.z + v.w * v.w));
        const float rstd = 1.0f / sqrtf(ss * (1.f / 256.f) + EPS);
        const f32x4 g = *(const GAS f32x4*)(g_mhead + hh * 256 + 4 * lane);
        const v2u so = *(const GAS v2u*)(prow + C_MO + hh * 256 + 4 * lane);
        const float o0 = bflo(so.x) * (v.x * rstd * g.x), o1 = bfhi(so.x) * (v.y * rstd * g.y), o2 = bflo(so.y) * (v.z * rstd * g.z), o3 = bfhi(so.y) * (v.w * rstd * g.w);
        v2u w; w.x = pk2(o0, o1); w.y = pk2(o2, o3);
        *(GAS v2u*)(prow + C_MQK + hh * 256 + 4 * lane) = w;
    }
    const f32x4 gs = *(const GAS f32x4*)(g_sub + 4 * lane);
#pragma unroll
    for (int hh = 0; hh < 8; ++hh) {
        const f32x4 v = *(const GAS f32x4*)(OST + (size_t)row * 2048 + hh * 256 + 4 * lane);
        const float ss = wave_sum((v.x * v.x + v.y * v.y) + (v.z * v.z + v.w * v.w));
        const float rstd = 1.0f / sqrtf(ss * (1.f / 256.f) + EPS) * one_m_laminit;
        v2u w; w.x = pk2(v.x * rstd * gs.x, v.y * rstd * gs.y); w.y = pk2(v.z * rstd * gs.z, v.w * rstd * gs.w);
        *(GAS v2u*)(prow + C_AQ + hh * 256 + 4 * lane) = w;
    }
}
struct Args { const void* in[22]; float* out; unsigned char* ws; int stop_layer; int stop_phase; };

constexpr int PT_OFF = MISC_OFF + 128;
constexpr int PT_OUT = 22, PT_WS = 23;
static_assert(PT_OFF + 24 * 8 <= LDS_BYTES, "LDS map");
__device__ __forceinline__ const void* ldp(LAS unsigned char* ldsA, int k) {
    const volatile LAS unsigned* p = (const volatile LAS unsigned*)(ldsA + PT_OFF) + 2 * k; const unsigned lo = p[0], hi = p[1];
    return (const void*)(((unsigned long long)(unsigned)__builtin_amdgcn_readfirstlane(hi) << 32) | (unsigned)__builtin_amdgcn_readfirstlane(lo));
}
#define LDPF(k) ((const float*)ldp(ldsA, (k)))

__global__ void __launch_bounds__(NWAVES * 64, 2) hybrid_fwd(Args args) {
    extern __shared__ __attribute__((aligned(16))) unsigned char lds[];
    LAS unsigned char* ldsA0 = (LAS unsigned char*)lds;
    const int tid0 = threadIdx.x;
    const int wave0 = __builtin_amdgcn_readfirstlane(tid0 >> 6);
    const int G0 = gridDim.x; const int bx0 = blockIdx.x;
    const int vcu0 = (G0 % 8 == 0) ? (bx0 % 8) * (G0 / 8) + bx0 / 8 : bx0;
#define PHASE_IDS() int tid = wave0 * 64 + (int)__builtin_amdgcn_mbcnt_hi(~0u, __builtin_amdgcn_mbcnt_lo(~0u, 0u)); asm volatile("" : "+v"(tid)); int lz_ = 0; asm volatile("" : "+s"(lz_)); \
    const int lane = tid & 63, wave = __builtin_amdgcn_readfirstlane(tid >> 6), G = G0 + lz_, bx = bx0 + lz_, vcu = vcu0 + lz_, NGW = G * NWAVES, gw = vcu * NWAVES + wave; \
    LAS unsigned char* ldsA = ldsA0 + lz_; char* ldsG = (char*)lds + lz_; (void)lane; (void)gw; (void)bx; (void)NGW; (void)ldsG
    for (int u = tid0; u < (LDS_BYTES - LDSCTL_OFF) / 4; u += NWAVES * 64) ((LAS unsigned*)(ldsA0 + LDSCTL_OFF))[u] = 0u;
    __syncthreads();
    if (tid0 < 24) { const unsigned long long v = (tid0 < 22) ? (unsigned long long)args.in[tid0] : (tid0 == 22 ? (unsigned long long)args.out : (unsigned long long)args.ws);
        ((volatile LAS unsigned long long*)(ldsA0 + PT_OFF))[tid0] = v; }
    __syncthreads();
    { XcdBarrier b0_ = xcd_barrier_post((unsigned*)((unsigned char*)ldp(ldsA0, PT_WS) + WS_CTL) + CW_BAR, (volatile LAS unsigned*)(ldsA0 + MISC_OFF) + 8); (void)b0_; }
#define GRID_BAR() do { int lzb_ = 0; asm volatile("" : "+s"(lzb_)); XcdBarrier b_; b_.bar = (unsigned*)((unsigned char*)ldp(ldsA0 + lzb_, PT_WS) + WS_CTL) + CW_BAR; b_.x = xb_xcc_id(); \
        b_.st = (volatile LAS unsigned*)(ldsA0 + lzb_ + MISC_OFF) + 8; xcd_barrier(b_); } while (0)
    const int stop_layer = args.stop_layer, stop_phase = args.stop_phase;

    { PHASE_IDS(); unsigned char* ws = (unsigned char*)ldp(ldsA, PT_WS); rope_table_phase((const int*)ldp(ldsA, 1), (float*)(ws + WS_ROPE), gw * 64 + lane, NGW * 64); }

#define STOP_AT(ph) do { if (DBG && l == stop_layer && stop_phase == (ph)) return; } while (0)
    for (int l = 0; l < DEPTH; ++l) {
        for (int rep_ = 0; rep_ < PROBE_REP0; ++rep_)
        {
            PHASE_IDS();
            unsigned char* ws = (unsigned char*)ldp(ldsA, PT_WS);
            const float* w_in = LDPF(3);
            convert_weights_phase(l, w_in, LDPF(14), LDPF(15), LDPF(16), LDPF(18), LDPF(19), LDPF(20), ws, (LAS float*)(ldsA + RING_OFF + wave * 16640), gw, NGW, lane);
            __syncthreads();
            LAS float* wgT = (LAS float*)(ldsA + RING_OFF);
            for (int k = tid; k < DM; k += NWAVES * 64) {
                const float* src = w_in + (size_t)l * DM * DIN + (size_t)k * DIN + 3072;
                const f32x4 a = *(const GAS f32x4*)src, b2 = *(const GAS f32x4*)(src + 4);
                wgT[0 * DM + k] = a.x; wgT[1 * DM + k] = a.y; wgT[2 * DM + k] = a.z; wgT[3 * DM + k] = a.w;
                wgT[4 * DM + k] = b2.x; wgT[5 * DM + k] = b2.y; wgT[6 * DM + k] = b2.z; wgT[7 * DM + k] = b2.w;
            }
            __syncthreads();
            const float* resid_in = (l == 0) ? LDPF(0) : LDPF(PT_OUT);
            const float* g_mix = LDPF(2) + (size_t)l * DM; const float* i_bias = LDPF(6) + l * 4; const float* f_bias = LDPF(7) + l * 4;
            bf16* HY = (bf16*)(ws + WS_HY); float* LIF = (float*)(ws + WS_LIF);
            for (int m = gw; m < M; m += NGW) {
                f32x4 v[8];
                norm_row(resid_in + (size_t)m * DM, g_mix, HY + (size_t)m * DM, lane, v);
                float ga[8];
#pragma unroll
                for (int c = 0; c < 8; ++c) { float s = 0.f;
#pragma unroll
                    for (int j = 0; j < 8; ++j) { const f32x4 wv = *(const LAS f32x4*)(wgT + c * DM + 256 * j + 4 * lane); s += (v[j].x * wv.x + v[j].y * wv.y) + (v[j].z * wv.z + v[j].w * wv.w); }
                    ga[c] = wave_sum(s); }
                if (lane < 8) {
                    float val = 0.f;
#pragma unroll
                    for (int c = 0; c < 8; ++c) if (lane == c) val = ga[c];
                    if (lane < 4) val += i_bias[lane];
                    else { const float z = val + f_bias[lane - 4]; const float e = __expf(-fabsf(z)), u = 1.0f + e, d = u - 1.0f; val = fminf(z, 0.f) - ((d == 0.f) ? e : __logf(u) * (e / d)); }
                    LIF[(size_t)m * 8 + lane] = val;
                }
            }
        }
        GRID_BAR(); STOP_AT(0);
        if constexpr (PHMASK & 2)
        {
            PHASE_IDS();
            unsigned char* ws = (unsigned char*)ldp(ldsA, PT_WS);
            {
                float* LIF = (float*)(ws + WS_LIF); float* MT = (float*)(ws + WS_MT); float* EMT = (float*)(ws + WS_EMT); float* KSC = (float*)(ws + WS_KSC); float* REF = (float*)(ws + WS_REF);
                for (int id = vcu; id < NB * 4; id += G) mlstm_scan(id >> 2, id & 3, LIF, KSC, MT, EMT, REF, (LAS float*)(ldsA + RING_OFF), tid);
            }
            pg8::Gemm g{(const bf16*)(ws + WS_HY), (const bf16*)(ws + WS_WIN), DM, DM}; pg8::StaticOrder S; S.init(M, NP, G, bx);
            pg8::EpiProj E{(bf16*)(ws + WS_PROJ), NP, (const float*)(ws + WS_ROPE)};
            pg8::gemm_phase<pg8::EpiProj, true>(ldsA + RING_OFF, g, S, E, tid);
        }
        GRID_BAR(); STOP_AT(1);
        if constexpr (PHMASK & 4)
        {
            PHASE_IDS();
            unsigned char* ws = (unsigned char*)ldp(ldsA, PT_WS);
            const float* cw = LDPF(4) + (size_t)l * 4 * 1024; const float* cb = LDPF(5) + (size_t)l * 1024;
            for (int st = gw; st < M / 16; st += NGW) mprep_strip(st, (const bf16*)(ws + WS_PROJ), cw, cb, (const float*)(ws + WS_KSC), (bf16*)(ws + WS_QKM), lane);
        }
        GRID_BAR(); STOP_AT(2);
        for (int rep_ = 0; rep_ < PROBE_REP2; ++rep_)
        {
            PHASE_IDS();
            unsigned char* ws = (unsigned char*)ldp(ldsA, PT_WS);
            char* albs = ldsG + RING_OFF;
            att::Seam S;
            if constexpr (!(PHMASK & 0x10000))
            {
                constexpr int NIT = NB * 4 * 2 * 8; const int cnt = (NIT + G - 1) / G; const int id0 = vcu * cnt; int nitems = NIT - id0; nitems = nitems < 0 ? 0 : (nitems > cnt ? cnt : nitems);
                const int nblk = 2 * nitems;
                bf16* QKM = (bf16*)(ws + WS_QKM); bf16* PROJ = (bf16*)(ws + WS_PROJ); float* HT = (float*)(ws + WS_HT);
                const float* MT = (const float*)(ws + WS_MT); const float* EMT = (const float*)(ws + WS_EMT); const float* REF = (const float*)(ws + WS_REF);
#define MREF(s_, R, L) do { const int id_ = id0 + ((s_) >> 1), bh_ = id_ >> 4, r_ = id_ & 15, j_ = r_ >> 3, p_ = r_ & 7, qb_ = ((s_) & 1) ? 15 - p_ : p_, b_ = bh_ >> 2, hm_ = bh_ & 3; \
                    R.Q = QKM + (size_t)(b_ * SEQ + qb_ * 256) * 1024 + hm_ * 128; R.K = QKM + (size_t)(b_ * SEQ) * 1024 + 512 + hm_ * 128; \
                    R.V = PROJ + (size_t)(b_ * SEQ) * NP + C_MV + hm_ * 256 + j_ * 128; R.O = HT + (size_t)(b_ * SEQ + qb_ * 256) * 1024 + hm_ * 256 + j_ * 128; R.P0 = qb_ * 256; \
                    L.MT = MT + (size_t)bh_ * SEQ; L.EMT = EMT + (size_t)bh_ * SEQ; L.REF = REF + bh_ * 64; } while (0)
                if (nblk > 0) {
                    { att::BlockRef cur; att::LinRef lc; MREF(0, cur, lc); att::prime<1024, 1024, NP>(cur, albs, S, tid); }
                    for (int s = 0; s < nblk; ++s) {
                        { att::BlockRef nxt; att::LinRef ln; const int sn = (s + 1 < nblk) ? s + 1 : s; MREF(sn, nxt, ln); att::put_next(albs, nxt, tid); }
                        att::BlockRef cur; att::LinRef lc; MREF(s, cur, lc);
                        { int t2 = tid; asm volatile("" : "+v"(t2)); att::block<1024, 1024, NP, 1024, 2>(cur, albs, S, 0.f, lc, t2); }
                    }
                }
#undef MREF
            }
            if constexpr (!(PHMASK & 0x20000))
            {
                float lam;
                { const float* lq1 = LDPF(9) + l * 128; const float* lk1 = LDPF(10) + l * 128; const float* lq2 = LDPF(11) + l * 128; const float* lk2 = LDPF(12) + l * 128;
                  const float a1 = lq1[lane] * lk1[lane] + lq1[64 + lane] * lk1[64 + lane];
                  const float a2 = lq2[lane] * lk2[lane] + lq2[64 + lane] * lk2[64 + lane];
                  const float lam_init = 0.8f - 0.6f * __expf(-0.3f * (float)l);
                  lam = __expf(wave_sum(a1)) - __expf(wave_sum(a2)) + lam_init; }
                constexpr int NIT = NB * 8 * 2 * 8; const int cnt = (NIT + G - 1) / G; const int id0 = vcu * cnt; int nitems = NIT - id0; nitems = nitems < 0 ? 0 : (nitems > cnt ? cnt : nitems);
                const int nps = 2 * nitems;
                bf16* PROJ = (bf16*)(ws + WS_PROJ); float* OST = (float*)(ws + WS_OST);
                att::LinRef lr0{nullptr, nullptr, nullptr};
#define AREF(ps_, c_, R) do { const int id_ = id0 + ((ps_) >> 1), bh_ = id_ >> 4, r_ = id_ & 15, j_ = r_ >> 3, p_ = r_ & 7, qb_ = ((ps_) & 1) ? 15 - p_ : p_, b_ = bh_ >> 3, h_ = bh_ & 7; \
                    R.Q = PROJ + (size_t)(b_ * SEQ + qb_ * 256) * NP + C_AQ + h_ * 256 + (c_) * 128; R.K = PROJ + (size_t)(b_ * SEQ) * NP + C_AK + h_ * 256 + (c_) * 128; \
                    R.V = PROJ + (size_t)(b_ * SEQ) * NP + C_AV + h_ * 256 + j_ * 128; R.O = OST + (size_t)(b_ * SEQ + qb_ * 256) * 2048 + h_ * 256 + j_ * 128; R.P0 = qb_ * 256; } while (0)
                if (nps > 0) {
                    { att::BlockRef c0; AREF(0, 0, c0); att::prime<NP, NP, NP>(c0, albs, S, tid); }
                    for (int ps = 0; ps < nps; ++ps) {
                        { att::BlockRef nx; AREF(ps, 1, nx); att::put_next(albs, nx, tid); }
                        { att::BlockRef c0; AREF(ps, 0, c0); int t2 = tid; asm volatile("" : "+v"(t2)); att::block<NP, NP, NP, 2048, 0>(c0, albs, S, lam, lr0, t2); }
                        { att::BlockRef nx; if (ps + 1 < nps) AREF(ps + 1, 0, nx); else AREF(ps, 1, nx); att::put_next(albs, nx, tid); }
                        { att::BlockRef c1; AREF(ps, 1, c1); int t2 = tid; asm volatile("" : "+v"(t2)); att::block<NP, NP, NP, 2048, 1>(c1, albs, S, lam, lr0, t2); }
                    }
                }
#undef AREF
            }
        }
        GRID_BAR(); STOP_AT(3);
        if constexpr (PHMASK & 16)
        {
            PHASE_IDS();
            unsigned char* ws = (unsigned char*)ldp(ldsA, PT_WS);
            const float oml = 1.0f - (0.8f - 0.6f * __expf(-0.3f * (float)l));
            const float* gmh = LDPF(8) + (size_t)l * 1024; const float* gsub = LDPF(13) + (size_t)l * 256;
            for (int m = gw; m < M; m += NGW) finish_row(m, (const float*)(ws + WS_HT), (const float*)(ws + WS_OST), (bf16*)(ws + WS_PROJ), gmh, gsub, oml, lane);
        }
        GRID_BAR(); STOP_AT(4);
        if constexpr (PHMASK & 32)
        {
            PHASE_IDS();
            unsigned char* ws = (unsigned char*)ldp(ldsA, PT_WS);
            bf16* PROJ = (bf16*)(ws + WS_PROJ); float* OST = (float*)(ws + WS_OST);
            pg8::StaticOrder S; S.init(M, DM, G, bx);
            { pg8::Gemm g{PROJ + C_MQK, (const bf16*)(ws + WS_PM), NP, 1024}; pg8::EpiGateT E{OST, DM, PROJ + C_GM, NP};
              pg8::gemm_phase<pg8::EpiGateT, true>(ldsA + RING_OFF, g, S, E, tid); }
            { pg8::Gemm g{PROJ + C_AQ, (const bf16*)(ws + WS_PA), NP, DM}; pg8::EpiGateY E{OST, DM, PROJ + C_GA, NP, (bf16*)(ws + WS_HY), DM};
              pg8::gemm_phase<pg8::EpiGateY, true>(ldsA + RING_OFF, g, S, E, tid); }
        }
        GRID_BAR(); STOP_AT(5);
        if constexpr (PHMASK & 64)
        {
            PHASE_IDS();
            unsigned char* ws = (unsigned char*)ldp(ldsA, PT_WS);
            float* out = (float*)ldp(ldsA, PT_OUT);
            const float* resid_in = (l == 0) ? LDPF(0) : (const float*)out;
            pg8::StaticOrder S; S.init(M, DM, G, bx);
            pg8::Gemm g{(const bf16*)(ws + WS_HY), (const bf16*)(ws + WS_WO), DM, DM}; pg8::EpiRes E{resid_in, out, DM};
            pg8::gemm_phase<pg8::EpiRes, true>(ldsA + RING_OFF, g, S, E, tid);
        }
        GRID_BAR(); STOP_AT(6);
        if constexpr (PHMASK & 128)
        {
            PHASE_IDS();
            unsigned char* ws = (unsigned char*)ldp(ldsA, PT_WS);
            const float* out = LDPF(PT_OUT); const float* g_ffn = LDPF(17) + (size_t)l * DM; bf16* HY = (bf16*)(ws + WS_HY);
            for (int m = gw; m < M; m += NGW) { f32x4 v[8]; norm_row(out + (size_t)m * DM, g_ffn, HY + (size_t)m * DM, lane, v); }
        }
        GRID_BAR(); STOP_AT(7);
        if constexpr (PHMASK & 256)
        {
            PHASE_IDS();
            unsigned char* ws = (unsigned char*)ldp(ldsA, PT_WS);
            pg8::StaticOrder S; S.init(M, NGU, G, bx);
            pg8::Gemm g{(const bf16*)(ws + WS_HY), (const bf16*)(ws + WS_WGU), DM, DM}; pg8::EpiSwiglu E{(bf16*)(ws + WS_PROJ), DFF};
            pg8::gemm_phase<pg8::EpiSwiglu, true>(ldsA + RING_OFF, g, S, E, tid);
        }
        GRID_BAR(); STOP_AT(8);
        if constexpr (PHMASK & 512)
        {
            PHASE_IDS();
            unsigned char* ws = (unsigned char*)ldp(ldsA, PT_WS);
            float* out = (float*)ldp(ldsA, PT_OUT);
            pg8::StaticOrder S; S.init(M, DM, G, bx);
            pg8::Gemm g{(const bf16*)(ws + WS_PROJ), (const bf16*)(ws + WS_WD), DFF, DFF};
            pg8::EpiRes E{out, (DBG && l == stop_layer && stop_phase == 9) ? (float*)(ws + WS_OST) : out, DM};
            pg8::gemm_phase<pg8::EpiRes, true>(ldsA + RING_OFF, g, S, E, tid);
        }
        GRID_BAR(); STOP_AT(9);
    }
    {
        PHASE_IDS();
        float* out = (float*)ldp(ldsA, PT_OUT); const float* g_final = LDPF(21);
        for (int m = gw; m < M; m += NGW) {
            GAS f32x4* xr = (GAS f32x4*)(out + (size_t)m * DM) + lane; const GAS f32x4* gr = (const GAS f32x4*)g_final + lane;
            f32x4 v[8]; float s = 0.f;
#pragma unroll
            for (int j = 0; j < 8; ++j) { v[j] = xr[64 * j]; s += (v[j].x * v[j].x + v[j].y * v[j].y) + (v[j].z * v[j].z + v[j].w * v[j].w); }
            const float rstd = 1.0f / sqrtf(wave_sum(s) * (1.f / DM) + EPS);
#pragma unroll
            for (int j = 0; j < 8; ++j) xr[64 * j] = v[j] * rstd * gr[64 * j];
        }
    }
#undef GRID_BAR
#undef STOP_AT
}
extern "C" void kernel_launch(void* const* d_in, const int* in_sizes, int n_in, void* d_out, int out_size, void* d_ws, size_t ws_size, hipStream_t stream) {
    static int grid = 0;
    if (grid == 0) {
        if (n_in != 22 || in_sizes[0] != M * DM || out_size != M * DM || ws_size < WS_END) {
            fprintf(stderr, "kernel_launch: shape mismatch (n_in %d, in0 %d, out %d, ws %zu < %zu); nothing launched\n", n_in, n_in > 0 ? in_sizes[0] : -1, out_size, ws_size, (size_t)WS_END); grid = -1; return; }
        int dev = 0, cus = 0, per_cu = 0;
        if (hipGetDevice(&dev) != hipSuccess || hipDeviceGetAttribute(&cus, hipDeviceAttributeMultiprocessorCount, dev) != hipSuccess) { grid = -1; return; }
        if (hipFuncSetAttribute((const void*)hybrid_fwd, hipFuncAttributeMaxDynamicSharedMemorySize, LDS_BYTES) != hipSuccess) { fprintf(stderr, "kernel_launch: hipFuncSetAttribute failed\n"); grid = -1; return; }
        if (hipOccupancyMaxActiveBlocksPerMultiprocessor(&per_cu, (const void*)hybrid_fwd, NWAVES * 64, LDS_BYTES) != hipSuccess || per_cu < 1)
            fprintf(stderr, "kernel_launch: note: occupancy query reports %d workgroups per CU\n", per_cu);
        (void)hipGetLastError();
        grid = cus;
    }
    if (grid < 0) return;
    if (hipMemsetAsync((char*)d_ws + WS_CTL, 0, CTL_ZERO_BYTES, stream) != hipSuccess) return;
    Args a{};
    for (int i = 0; i < 22; ++i) a.in[i] = d_in[i];
    a.out = (float*)d_out; a.ws = (unsigned char*)d_ws;
    a.stop_layer = DBG ? DBG_STOP_LAYER : -1; a.stop_phase = DBG ? DBG_STOP_PHASE : -1;
    hipLaunchKernelGGL(hybrid_fwd, dim3(grid), dim3(NWAVES * 64), LDS_BYTES, stream, a);
#if DBG
    dbg_checks(d_in, (float*)d_out, (unsigned char*)d_ws, stream);
#endif
}
```

```cpp
#include <hip/hip_runtime.h>
#include <cstdio>
#include <cstdint>
#define DBG 0
#define DBG_STOP_LAYER 0
#define DBG_STOP_PHASE 3
#define PROBE_PHASE -1
#define REPS(k) ((PROBE_PHASE == (k)) ? 2 : 1)
namespace pg8 {
#define PG8_LAS __attribute__((address_space(3)))
typedef unsigned short bf16_t;
typedef short bf16x8 __attribute__((ext_vector_type(8)));
typedef float f32x4 __attribute__((ext_vector_type(4)));
typedef unsigned u32x4 __attribute__((ext_vector_type(4)));
constexpr int BM = 256, BK = 64, HALF = 128, HTB = HALF * BK * 2  , STAGE_BYTES = 8 * HTB, NXCD = 8, WGM = 8;

__host__ __device__ __forceinline__ int lds_byte(int r, int c) { const int st = (r >> 4) * 2 + (c >> 5), rr = r & 15, cc = c & 31, ob = rr * 64 + cc * 2; return st * 1024 + (ob ^ (((ob >> 9) & 1) << 5)); }
__host__ __device__ __forceinline__ void stage_rc(int b, int& R, int& C) { const int st = b / 1024, sb = b % 1024, swz = sb ^ (((sb >> 9) & 1) << 5); R = (st >> 1) * 16 + swz / 64; C = (st & 1) * 32 + (swz % 64) / 2; }
__host__ __device__ __forceinline__ int perm32(int rho) { const int n = rho >> 4, i = rho & 15; return 8 * (i >> 2) + 4 * n + (i & 3); }

struct Unit { int pm, pn; };
struct Gemm { const bf16_t* A; const bf16_t* Bt; int lda; int K; };

struct StaticOrder {
    int nM, nN, nwg, G, c;
    __host__ __device__ void init(int M, int N, int G_, int c_) { nM = M / BM; nN = N / BM; nwg = nM * nN; G = G_; c = c_; }
    __host__ __device__ bool next(int i, Unit& u) const {
        const long L = (long)i * G + c; if (L >= nwg) return false;
        int wgid = (int)L; { const int q = nwg / NXCD, r = nwg % NXCD, xcd = wgid % NXCD, off = wgid / NXCD; wgid = (xcd < r ? xcd * (q + 1) : r * (q + 1) + (xcd - r) * q) + off; }
        const int nig = WGM * nN, gid = wgid / nig, fm = gid * WGM, gsz = (nM - fm) < WGM ? (nM - fm) : WGM;
        u.pm = fm + ((wgid % nig) % gsz); u.pn = (wgid % nig) / gsz; return true;
    }
};

__device__ __forceinline__ unsigned cvt_pk_bf16(float lo, float hi) { unsigned r; asm volatile("v_cvt_pk_bf16_f32 %0, %1, %2" : "=v"(r) : "v"(lo), "v"(hi)); return r; }
__device__ __forceinline__ float bf_lo(unsigned u) { return __uint_as_float(u << 16); }
__device__ __forceinline__ float bf_hi(unsigned u) { return __uint_as_float(u & 0xffff0000u); }
__device__ __forceinline__ float sigm(float x) { return __builtin_amdgcn_rcpf(1.0f + __builtin_amdgcn_exp2f(-1.4426950408889634f * x)); }
__device__ __forceinline__ u32x4 pack8f(f32x4 a, f32x4 b) { u32x4 w; w.x = cvt_pk_bf16(a[0], a[1]); w.y = cvt_pk_bf16(a[2], a[3]); w.z = cvt_pk_bf16(b[0], b[1]); w.w = cvt_pk_bf16(b[2], b[3]); return w; }

struct EpiProj {
    static constexpr bool PERM = true;
    bf16_t* O; int ldc; const float* rope;
    __device__ __forceinline__ void operator()(const f32x4 (&acc)[2][2][4][2], const Unit& u, int wr, int wc, int fr, int fq) const {
        const int row0 = u.pm * BM + wr * 64 + fr, col0 = u.pn * BM + wc * 32 + 8 * fq;
        const int pn = u.pn;
        const bool is_sig = (pn >= 8 && pn < 12) || pn >= 36;
        const bool is_rope = (pn >= 12 && pn < 28) && (wc == 0);
#pragma unroll
        for (int ai = 0; ai < 2; ++ai)
#pragma unroll
            for (int m = 0; m < 4; ++m) {
                const int row = row0 + ai * HALF + m * 16;
                bf16_t* rowp = O + (size_t)row * ldc + col0;
                f32x4 cs = (f32x4){1.f, 1.f, 1.f, 1.f}, sn = (f32x4){0.f, 0.f, 0.f, 0.f};
                if (is_rope) { cs = *(const f32x4*)(rope + (size_t)row * 32 + 4 * fq); sn = *(const f32x4*)(rope + (size_t)row * 32 + 16 + 4 * fq); }
#pragma unroll
                for (int bj = 0; bj < 2; ++bj) {
                    f32x4 v0 = acc[ai][bj][m][0], v1 = acc[ai][bj][m][1];
                    if (is_sig) {
#pragma unroll
                        for (int e = 0; e < 4; ++e) { v0[e] = sigm(v0[e]); v1[e] = sigm(v1[e]); }
                    }
                    if (is_rope) {
                        f32x4 a0, a1;
                        a0[0] = v0[0] * cs[0] - v0[1] * sn[0]; a0[1] = v0[1] * cs[0] + v0[0] * sn[0];
                        a0[2] = v0[2] * cs[1] - v0[3] * sn[1]; a0[3] = v0[3] * cs[1] + v0[2] * sn[1];
                        a1[0] = v1[0] * cs[2] - v1[1] * sn[2]; a1[1] = v1[1] * cs[2] + v1[0] * sn[2];
                        a1[2] = v1[2] * cs[3] - v1[3] * sn[3]; a1[3] = v1[3] * cs[3] + v1[2] * sn[3];
                        v0 = a0; v1 = a1;
                    }
                    *(u32x4*)(rowp + bj * HALF) = pack8f(v0, v1);
                }
                asm volatile("" ::: "memory");
            }
    }
};
struct EpiMerge {
    static constexpr bool PERM = true;
    const bf16_t* GM; const bf16_t* GA; int ldg; bf16_t* Y; int ldy;
    __device__ __forceinline__ void hook(f32x4 (&acc)[2][2][4][2], const Unit& u, int wr, int wc, int fr, int fq) const {
        int z_ = 0; asm volatile("" : "+v"(z_));
        const int row0 = u.pm * BM + wr * 64 + fr + z_, col0 = u.pn * BM + wc * 32 + 8 * fq;
#pragma unroll
        for (int ai = 0; ai < 2; ++ai)
#pragma unroll
            for (int m = 0; m < 4; ++m) {
                const int row = row0 + ai * HALF + m * 16;
#pragma unroll
                for (int bj = 0; bj < 2; ++bj) {
                    const size_t off = (size_t)row * ldg + col0 + bj * HALF;
                    const u32x4 a = *(const u32x4*)(GM + off), b = *(const u32x4*)(GA + off);
                    f32x4& v0 = acc[ai][bj][m][0]; f32x4& v1 = acc[ai][bj][m][1];
#define RQ(x, y) ((x) * __builtin_amdgcn_rcpf(fmaxf((y), 1e-30f)))
                    v0[0] *= RQ(bf_lo(a.x), bf_lo(b.x)); v0[1] *= RQ(bf_hi(a.x), bf_hi(b.x)); v0[2] *= RQ(bf_lo(a.y), bf_lo(b.y)); v0[3] *= RQ(bf_hi(a.y), bf_hi(b.y));
                    v1[0] *= RQ(bf_lo(a.z), bf_lo(b.z)); v1[1] *= RQ(bf_hi(a.z), bf_hi(b.z)); v1[2] *= RQ(bf_lo(a.w), bf_lo(b.w)); v1[3] *= RQ(bf_hi(a.w), bf_hi(b.w));
#undef RQ
                }
                asm volatile("" ::: "memory");
            }
    }
    __device__ __forceinline__ void operator()(const f32x4 (&acc)[2][2][4][2], const Unit& u, int wr, int wc, int fr, int fq) const {
        const int row0 = u.pm * BM + wr * 64 + fr, col0 = u.pn * BM + wc * 32 + 8 * fq;
#pragma unroll
        for (int ai = 0; ai < 2; ++ai)
#pragma unroll
            for (int m = 0; m < 4; ++m) {
                const int row = row0 + ai * HALF + m * 16;
#pragma unroll
                for (int bj = 0; bj < 2; ++bj) {
                    const int col = col0 + bj * HALF;
                    const u32x4 g = *(const u32x4*)(GA + (size_t)row * ldg + col);
                    const f32x4 v0 = acc[ai][bj][m][0], v1 = acc[ai][bj][m][1];
                    f32x4 o0, o1;
                    o0[0] = bf_lo(g.x) * v0[0]; o0[1] = bf_hi(g.x) * v0[1]; o0[2] = bf_lo(g.y) * v0[2]; o0[3] = bf_hi(g.y) * v0[3];
                    o1[0] = bf_lo(g.z) * v1[0]; o1[1] = bf_hi(g.z) * v1[1]; o1[2] = bf_lo(g.w) * v1[2]; o1[3] = bf_hi(g.w) * v1[3];
                    *(u32x4*)(Y + (size_t)row * ldy + col) = pack8f(o0, o1);
                }
                asm volatile("" ::: "memory");
            }
    }
};
struct EpiRes {
    static constexpr bool PERM = false;
    const float* res; float* out; int ldc;
    __device__ __forceinline__ void operator()(const f32x4 (&acc)[2][2][4][2], const Unit& u, int wr, int wc, int fr, int fq) const {
        const int row0 = u.pm * BM + wr * 64 + fr, col0 = u.pn * BM + wc * 32 + 4 * fq;
#pragma unroll
        for (int ai = 0; ai < 2; ++ai)
#pragma unroll
            for (int m = 0; m < 4; ++m) {
                const size_t off = (size_t)(row0 + ai * HALF + m * 16) * ldc + col0;
#pragma unroll
                for (int bj = 0; bj < 2; ++bj)
#pragma unroll
                    for (int n = 0; n < 2; ++n) { const f32x4 r = *(const f32x4*)(res + off + bj * HALF + n * 16); *(f32x4*)(out + off + bj * HALF + n * 16) = r + acc[ai][bj][m][n]; }
            }
    }
};
struct EpiSwiglu {
    static constexpr bool PERM = true;
    bf16_t* H; int ldh;
    __device__ __forceinline__ void operator()(const f32x4 (&acc)[2][2][4][2], const Unit& u, int wr, int wc, int fr, int fq) const {
        const int row0 = u.pm * BM + wr * 64 + fr, col0 = u.pn * HALF + wc * 32 + 8 * fq;
#pragma unroll
        for (int ai = 0; ai < 2; ++ai)
#pragma unroll
            for (int m = 0; m < 4; ++m) {
                const int row = row0 + ai * HALF + m * 16;
                f32x4 o0, o1;
#pragma unroll
                for (int e = 0; e < 4; ++e) { const float g0 = acc[ai][0][m][0][e], g1 = acc[ai][0][m][1][e];
                    o0[e] = g0 * sigm(g0) * acc[ai][1][m][0][e]; o1[e] = g1 * sigm(g1) * acc[ai][1][m][1][e]; }
                *(u32x4*)(H + (size_t)row * ldh + col0) = pack8f(o0, o1);
            }
    }
};

template <class Epi, bool ALIGN_EPI, int HOOKT = 0>
__device__ __forceinline__ void gemm_phase(PG8_LAS unsigned char* lds, const Gemm g, const StaticOrder& S, const Epi& E, const int tid) {
    const int wid = __builtin_amdgcn_readfirstlane(tid >> 6), lane = tid & 63, wr = wid >> 2, wc = wid & 3, fr = lane & 15, fq = lane >> 4;
    const int K = g.K, nt = K / BK, lda = g.lda;
    unsigned voffA[2], voffB[2];
#pragma unroll
    for (int i = 0; i < 2; ++i) { int R, C; stage_rc(tid * 16 + i * 8192, R, C); const int Rb = Epi::PERM ? ((R & ~31) + perm32(R & 31)) : R;
        voffA[i] = (unsigned)(R * lda + C) * 2u; voffB[i] = (unsigned)(Rb * K + C) * 2u; }
    const size_t kstep = (size_t)(BK * 2);
    const size_t hstepA = (size_t)HALF * lda * 2, hstepB = (size_t)HALF * K * 2;
    const size_t tstepA = 2 * hstepA, tstepB = 2 * hstepB;
    const unsigned ldsw = (unsigned)wid * 1024u;
    const int aoff = lds_byte(wr * 64 + fr, fq * 8), boff = lds_byte(wc * 32 + fr, fq * 8);
#define PG8_SA(b, h) (((b) * 2 + (h)) * HTB)
#define PG8_SB(b, h) ((4 + (b) * 2 + (h)) * HTB)
#define PG8_STAGE(bufoff, gbase, voff) do { _Pragma("unroll") for (int _i = 0; _i < 2; ++_i) \
        __builtin_amdgcn_global_load_lds((const unsigned*)((const char*)(gbase) + (voff)[_i]), (PG8_LAS unsigned*)(lds + (bufoff) + ldsw + _i * 8192), 16, 0, 0); } while (0)
#define PG8_LDA(dst, b, h) do { _Pragma("unroll") for (int m = 0; m < 4; ++m) _Pragma("unroll") for (int k = 0; k < 2; ++k) dst[m][k] = *(const PG8_LAS bf16x8*)(lds + PG8_SA(b, h) + aoff + m * 2048 + k * 1024); } while (0)
#define PG8_LDB(dst, b, h) do { _Pragma("unroll") for (int n = 0; n < 2; ++n) _Pragma("unroll") for (int k = 0; k < 2; ++k) dst[n][k] = *(const PG8_LAS bf16x8*)(lds + PG8_SB(b, h) + boff + n * 2048 + k * 1024); } while (0)
#define PG8_MMA(ai, bj, At, Bt) do { __builtin_amdgcn_s_setprio(1); _Pragma("unroll") for (int m = 0; m < 4; ++m) _Pragma("unroll") for (int n = 0; n < 2; ++n) _Pragma("unroll") for (int k = 0; k < 2; ++k) \
        acc[ai][bj][m][n] = __builtin_amdgcn_mfma_f32_16x16x32_bf16(Bt[n][k], At[m][k], acc[ai][bj][m][n], 0, 0, 0); __builtin_amdgcn_s_setprio(0); } while (0)
#define PG8_WAIT_V(n) asm volatile("s_waitcnt vmcnt(" #n ")" ::: "memory")
#define PG8_WAIT_L(n) asm volatile("s_waitcnt lgkmcnt(" #n ")" ::: "memory")
#define PG8_BAR __builtin_amdgcn_s_barrier()
#define PG8_SCHED __builtin_amdgcn_sched_barrier(0)
    Unit cur, nxt; int ui = 0;
    if (!S.next(0, cur)) return;
    f32x4 acc[2][2][4][2];
#pragma unroll
    for (int a = 0; a < 2; ++a)
#pragma unroll
        for (int b = 0; b < 2; ++b)
#pragma unroll
            for (int m = 0; m < 4; ++m)
#pragma unroll
                for (int n = 0; n < 2; ++n) acc[a][b][m][n] = (f32x4){0.f, 0.f, 0.f, 0.f};
    bf16x8 At[4][2], B0[2][2], B1[2][2];
    const char* cA = (const char*)g.A + (size_t)cur.pm * tstepA; const char* cB = (const char*)g.Bt + (size_t)cur.pn * tstepB;
    PG8_STAGE(PG8_SB(0, 0), cB, voffB); PG8_STAGE(PG8_SB(0, 1), cB + hstepB, voffB); PG8_STAGE(PG8_SA(0, 0), cA, voffA); PG8_STAGE(PG8_SA(0, 1), cA + hstepA, voffA);
    if (wr == 1) PG8_BAR;
    PG8_WAIT_V(2); PG8_BAR;
    PG8_STAGE(PG8_SB(1, 0), cB + kstep, voffB); PG8_STAGE(PG8_SA(1, 0), cA + kstep, voffA); PG8_STAGE(PG8_SB(1, 1), cB + hstepB + kstep, voffB);
    PG8_WAIT_V(6); PG8_BAR;
    for (;;) {
        const bool has_next = S.next(ui + 1, nxt);
        const char* nA = has_next ? (const char*)g.A + (size_t)nxt.pm * tstepA : cA; const char* nB = has_next ? (const char*)g.Bt + (size_t)nxt.pn * tstepB : cB;
        for (int t = 0; t < nt; t += 2) {
            if constexpr (HOOKT > 0) { if (t == HOOKT) { E.hook(acc, cur, wr, wc, fr, fq); PG8_SCHED; } }
            const bool last = (t == nt - 2);
            const char* a1 = cA + (size_t)(t + 1) * kstep;
            const char* a2 = last ? nA : cA + (size_t)(t + 2) * kstep; const char* b2 = last ? nB : cB + (size_t)(t + 2) * kstep;
            const char* a3 = a2 + kstep; const char* b3 = b2 + kstep;
            PG8_LDB(B0, 0, 0); PG8_LDB(B1, 0, 1); PG8_SCHED; PG8_LDA(At, 0, 0); PG8_STAGE(PG8_SA(1, 1), a1 + hstepA, voffA);
            PG8_WAIT_V(8); PG8_WAIT_L(0); PG8_BAR; PG8_MMA(0, 0, At, B0); PG8_MMA(0, 1, At, B1); PG8_BAR; PG8_SCHED;
            PG8_LDA(At, 0, 1); PG8_STAGE(PG8_SB(0, 0), b2, voffB); PG8_STAGE(PG8_SB(0, 1), b2 + hstepB, voffB); PG8_STAGE(PG8_SA(0, 0), a2, voffA);
            PG8_WAIT_V(8); PG8_WAIT_L(0); PG8_BAR; PG8_MMA(1, 0, At, B0); PG8_MMA(1, 1, At, B1); PG8_BAR; PG8_SCHED;
            PG8_LDB(B0, 1, 0); PG8_LDB(B1, 1, 1); PG8_SCHED; PG8_LDA(At, 1, 0); PG8_STAGE(PG8_SA(0, 1), a2 + hstepA, voffA);
            PG8_WAIT_V(8); PG8_WAIT_L(0); PG8_BAR; PG8_MMA(0, 0, At, B0); PG8_MMA(0, 1, At, B1); PG8_BAR; PG8_SCHED;
            PG8_LDA(At, 1, 1); PG8_STAGE(PG8_SB(1, 0), b3, voffB); PG8_STAGE(PG8_SB(1, 1), b3 + hstepB, voffB); PG8_STAGE(PG8_SA(1, 0), a3, voffA);
            PG8_WAIT_V(8); PG8_WAIT_L(0); PG8_BAR; PG8_MMA(1, 0, At, B0); PG8_MMA(1, 1, At, B1); PG8_BAR; PG8_SCHED;
        }
        if constexpr (ALIGN_EPI) { if (wr == 0) PG8_BAR; }
        E(acc, cur, wr, wc, fr, fq);
        if (!has_next) break;
#pragma unroll
        for (int a = 0; a < 2; ++a)
#pragma unroll
            for (int b = 0; b < 2; ++b)
#pragma unroll
                for (int m = 0; m < 4; ++m)
#pragma unroll
                    for (int n = 0; n < 2; ++n) acc[a][b][m][n] = (f32x4){0.f, 0.f, 0.f, 0.f};
        cur = nxt; cA = nA; cB = nB; ++ui;
        if constexpr (ALIGN_EPI) { if (wr == 1) PG8_BAR; }
    }
    PG8_WAIT_V(0);
    if constexpr (!ALIGN_EPI) { if (wr == 0) PG8_BAR; }
    PG8_BAR;
#undef PG8_SA
#undef PG8_SB
#undef PG8_STAGE
#undef PG8_LDA
#undef PG8_LDB
#undef PG8_MMA
#undef PG8_WAIT_V
#undef PG8_WAIT_L
#undef PG8_BAR
#undef PG8_SCHED
}
}
namespace att {
typedef unsigned short bf16;
typedef short bf16x8 __attribute__((ext_vector_type(8)));
typedef short s16x4 __attribute__((ext_vector_type(4)));
typedef float f32x16 __attribute__((ext_vector_type(16)));
typedef float f32x4 __attribute__((ext_vector_type(4)));
typedef unsigned u32x4 __attribute__((ext_vector_type(4)));
constexpr int D = 128;
constexpr float SCALE = 0.08838834764831845f;
constexpr float THR = 8.f;
constexpr int NW = 8, QBLK = 32, KVBLK = 64, QB = NW * QBLK;
constexpr int SHM_V = KVBLK * D * 2, SHM_K = KVBLK * D * 2;
constexpr int LDS_BYTES = 2 * SHM_V + 2 * SHM_K + NW * 64 * 4;
constexpr int LDS_QIMG = LDS_BYTES + 32, LDS_TOTAL = LDS_QIMG + NW * 8192;

#define KSWZ(row, colB) ((row) * 256 + ((colB) ^ (((row) & 7) << 4)))
#define SBAR() __builtin_amdgcn_sched_barrier(0)
__device__ __forceinline__ int v_st(int k, int c) { const int kk = (k & ~0xC) | ((k & 4) << 1) | ((k & 8) >> 1); return ((kk >> 3) * 4 + (c >> 5)) * 512 + ((kk & 7) * 32 + (c & 31)) * 2; }
__device__ __forceinline__ int v_rd_base(int lane) { return ((lane & 3) << 3) | (((lane >> 2) & 3) << 6) | (((lane >> 4) & 1) << 5) | (((lane >> 5) & 1) << 8); }
constexpr int v_rd_off(int d0, int ks, int half) { return d0 * 512 + ks * 4096 + half * 2048; }
__device__ __forceinline__ int crow(int r, int hi) { return (r & 3) + 8 * (r >> 2) + 4 * hi; }
__device__ __forceinline__ unsigned cvtpk(float lo, float hi) { unsigned r; asm volatile("v_cvt_pk_bf16_f32 %0, %1, %2" : "=v"(r) : "v"(lo), "v"(hi)); return r; }
__device__ __forceinline__ bf16x8 load8(const bf16* p) { return *reinterpret_cast<const bf16x8*>(p); }
template <bool ZERO>
__device__ __forceinline__ void mask_tile(f32x16& p0, f32x16& p1, int dq) {
    const float NEG = ZERO ? 0.f : -__builtin_inff();
#pragma unroll
    for (int r = 0; r < 16; ++r) {
        const int c = (r & 3) + 8 * (r >> 2);
        if (dq - c < 0) p0[r] = NEG;
        if (dq - c - 32 < 0) p1[r] = NEG;
    }
}
__device__ __forceinline__ void partialSM(f32x16& p0, f32x16& p1, float& m_reg, float& mn, float& alpha) {
    float pmax = p0[0]; for (int r = 1; r < 16; ++r) pmax = fmaxf(pmax, p0[r]); for (int r = 0; r < 16; ++r) pmax = fmaxf(pmax, p1[r]);
    { auto rr = __builtin_amdgcn_permlane32_swap(__float_as_uint(pmax), __float_as_uint(pmax), false, false);
      pmax = fmaxf(__uint_as_float(rr[0]), __uint_as_float(rr[1])); }
    constexpr float C2 = 1.4426950408889634f * SCALE;
    if (__builtin_expect(__all((pmax - m_reg) * SCALE <= THR), 1)) { mn = m_reg; alpha = 1.f; }
    else { mn = fmaxf(m_reg, pmax); alpha = __builtin_amdgcn_exp2f((m_reg - mn) * C2); m_reg = mn; }
    const float mnL = -mn * C2;
    for (int r = 0; r < 16; ++r) p0[r] = fmaf(p0[r], C2, mnL); for (int r = 0; r < 16; ++r) p1[r] = fmaf(p1[r], C2, mnL);
    for (int r = 0; r < 16; ++r) p0[r] = __builtin_amdgcn_exp2f(p0[r]);
}
#define ATT_PK4(P, B_, OUT) do { unsigned a0 = cvtpk(P[B_+0], P[B_+1]), a1 = cvtpk(P[B_+2], P[B_+3]);                          \
        unsigned b0 = cvtpk(P[B_+4], P[B_+5]), b1 = cvtpk(P[B_+6], P[B_+7]);                                             \
        auto r0 = __builtin_amdgcn_permlane32_swap(a0, b0, false, false); auto r1 = __builtin_amdgcn_permlane32_swap(a1, b1, false, false); \
        u32x4 w = {r0[0], r1[0], r0[1], r1[1]}; OUT = *reinterpret_cast<bf16x8*>(&w); } while (0)
__device__ __forceinline__ void finishSM(f32x16& p0, f32x16& p1, float alpha, float& l_reg, bf16x8& pa0, bf16x8& pa1, bf16x8& pa2, bf16x8& pa3) {
    for (int r = 0; r < 16; ++r) p1[r] = __builtin_amdgcn_exp2f(p1[r]);
    float ps = 0; for (int r = 0; r < 16; ++r) ps += p0[r]; for (int r = 0; r < 16; ++r) ps += p1[r];
    { auto rr = __builtin_amdgcn_permlane32_swap(__float_as_uint(ps), __float_as_uint(ps), false, false);
      ps = __uint_as_float(rr[0]) + __uint_as_float(rr[1]); }
    l_reg = l_reg * alpha + ps;
    ATT_PK4(p0, 0, pa0); ATT_PK4(p0, 8, pa1); ATT_PK4(p1, 0, pa2); ATT_PK4(p1, 8, pa3);
}
__device__ __forceinline__ void partialLin(f32x16& p0, f32x16& p1, float f) {
    for (int r = 0; r < 16; ++r) { p0[r] *= f; p1[r] *= f; }
}
__device__ __forceinline__ void finishLin(f32x16& p0, f32x16& p1, float& den, bf16x8& pa0, bf16x8& pa1, bf16x8& pa2, bf16x8& pa3) {
    float ps = 0; for (int r = 0; r < 16; ++r) ps += p0[r]; for (int r = 0; r < 16; ++r) ps += p1[r];
    den += ps;
    ATT_PK4(p0, 0, pa0); ATT_PK4(p0, 8, pa1); ATT_PK4(p1, 0, pa2); ATT_PK4(p1, 8, pa3);
}
template <int KB, bool QL>
__device__ __forceinline__ void qkt(f32x16& p0, f32x16& p1, const char* K_lds, int r32, int hi, const bf16x8* qr, const char* qlds) {
    p0 = f32x16{}; p1 = f32x16{};
    const char* kb[4];
#pragma unroll
    for (int dd = 0; dd < 4; ++dd) kb[dd] = K_lds + KB * SHM_K + KSWZ(r32, (dd * 16 + hi * 8) * 2);
#pragma unroll
    for (int d0 = 0; d0 < 8; ++d0) { const char* a = kb[d0 & 3] + (d0 >> 2) * 128;
        bf16x8 b0 = *reinterpret_cast<const bf16x8*>(a);
        bf16x8 b1 = *reinterpret_cast<const bf16x8*>(a + 32 * 256);
        bf16x8 qf; if constexpr (QL) qf = *reinterpret_cast<const bf16x8*>(qlds + d0 * 1024); else qf = qr[d0];
        p0 = __builtin_amdgcn_mfma_f32_32x32x16_bf16(b0, qf, p0, 0, 0, 0);
        p1 = __builtin_amdgcn_mfma_f32_32x32x16_bf16(b1, qf, p1, 0, 0, 0); }
}
template <int VB>
__device__ __forceinline__ void pv_tile(f32x16* o, int vb0, bf16x8 pa0, bf16x8 pa1, bf16x8 pa2, bf16x8 pa3) {
#define TRRD(dst, off) asm volatile("ds_read_b64_tr_b16 %0, %1 offset:%2" : "=&v"(dst) : "v"(vb0), "i"(off) : "memory")
#define PV_D0(d0) do { s16x4 l0, l1, l2, l3, h0, h1, h2, h3; constexpr int b_ = VB * SHM_V + v_rd_off(d0, 0, 0); \
        TRRD(l0, b_); TRRD(h0, b_ + 2048); TRRD(l1, b_ + 4096); TRRD(h1, b_ + 6144); TRRD(l2, b_ + 8192); TRRD(h2, b_ + 10240); TRRD(l3, b_ + 12288); TRRD(h3, b_ + 14336); \
        asm volatile("s_waitcnt lgkmcnt(0)" ::: "memory"); SBAR();   \
        o[d0] = __builtin_amdgcn_mfma_f32_32x32x16_bf16(pa0, (bf16x8){l0[0], l0[1], l0[2], l0[3], h0[0], h0[1], h0[2], h0[3]}, o[d0], 0, 0, 0);   \
        o[d0] = __builtin_amdgcn_mfma_f32_32x32x16_bf16(pa1, (bf16x8){l1[0], l1[1], l1[2], l1[3], h1[0], h1[1], h1[2], h1[3]}, o[d0], 0, 0, 0);   \
        o[d0] = __builtin_amdgcn_mfma_f32_32x32x16_bf16(pa2, (bf16x8){l2[0], l2[1], l2[2], l2[3], h2[0], h2[1], h2[2], h2[3]}, o[d0], 0, 0, 0);   \
        o[d0] = __builtin_amdgcn_mfma_f32_32x32x16_bf16(pa3, (bf16x8){l3[0], l3[1], l3[2], l3[3], h3[0], h3[1], h3[2], h3[3]}, o[d0], 0, 0, 0); } while (0)
    PV_D0(0); PV_D0(1); PV_D0(2); PV_D0(3);
#undef PV_D0
#undef TRRD
}

struct BlockRef { const bf16* Q; const bf16* K; const bf16* V; float* O; int P0; };
struct LinRef { const float* MT; const float* EMT; const float* REF; };
struct Seam { bf16x8 qr[8]; bf16x8 st_v0, st_v1, st_k0, st_k1; };

#define ATT_VMW() asm volatile("s_waitcnt vmcnt(0)" ::: "memory")
#define ATT_VMWN(n) asm volatile("s_waitcnt vmcnt(%0)" :: "i"(n) : "memory")
__device__ __forceinline__ bf16x8 load8o(const bf16* base, unsigned voff) { return *reinterpret_cast<const bf16x8*>(reinterpret_cast<const char*>(base) + voff); }
template <class T> __device__ __forceinline__ T* uni(T* p) {
    const unsigned long long u = (unsigned long long)p; const unsigned lo = __builtin_amdgcn_readfirstlane((unsigned)u), hi = __builtin_amdgcn_readfirstlane((unsigned)(u >> 32));
    return (T*)(((unsigned long long)hi << 32) | lo); }
#define ATT_SLOAD(Kp, Vp, k0) do { const bf16* vb_ = uni((Vp) + (size_t)(k0) * LDV); const bf16* kb_ = uni((Kp) + (size_t)(k0) * LDK);                                         \
                                   S.st_v0 = load8o(vb_, offV); S.st_v1 = load8o(vb_, offV + 32u * LDV * 2u);              \
                                   S.st_k0 = load8o(kb_, offK); S.st_k1 = load8o(kb_, offK + 32u * LDK * 2u); } while (0)
#define ATT_SWRITE_K(bf) do { *(bf16x8*)(K_lds + (bf) * SHM_K + kws) = S.st_k0; *(bf16x8*)(K_lds + (bf) * SHM_K + kws + 32 * 256) = S.st_k1; } while (0)
#define ATT_SWRITE_V(bf) do { *(bf16x8*)(V_lds + (bf) * SHM_V + vst0) = S.st_v0; *(bf16x8*)(V_lds + (bf) * SHM_V + vst1) = S.st_v1; } while (0)

template <int LDQ, int LDK, int LDV>
__device__ __forceinline__ void prime(const BlockRef& cur, char* lds, Seam& S, const int tid) {
    const int wid = __builtin_amdgcn_readfirstlane(tid >> 6), lane = tid & 63, r32 = lane & 31, hi = lane >> 5;
    const int sr = tid >> 4, sc = (tid & 15) * 8, kws = KSWZ(sr, sc * 2); char* K_lds = lds + 2 * SHM_V;
    const unsigned offV = (unsigned)(sr * LDV + sc) * 2u, offK = (unsigned)(sr * LDK + sc) * 2u, offQ = (unsigned)(r32 * LDQ + hi * 8) * 2u;
    { const bf16* qb_ = uni(cur.Q + (size_t)(wid * QBLK) * LDQ);
#pragma unroll
    for (int d0 = 0; d0 < 8; ++d0) S.qr[d0] = load8o(qb_, offQ + d0 * 32u); }
    ATT_SLOAD(cur.K, cur.V, 0); ATT_VMW(); ATT_SWRITE_K(0);
    __syncthreads();
}

__device__ __forceinline__ void put_next(char* lds, const BlockRef& nxt, const int tid) {
    if (tid == 0) { volatile unsigned long long* p = (volatile unsigned long long*)(lds + LDS_BYTES); p[0] = (unsigned long long)nxt.Q; p[1] = (unsigned long long)nxt.K; p[2] = (unsigned long long)nxt.V; }
}
__device__ __forceinline__ const bf16* get_next(char* lds, int k) {
    const volatile unsigned* p = (const volatile unsigned*)(lds + LDS_BYTES) + 2 * k; const unsigned lo = p[0], hi = p[1];
    return (const bf16*)(((unsigned long long)(unsigned)__builtin_amdgcn_readfirstlane(hi) << 32) | (unsigned)__builtin_amdgcn_readfirstlane(lo));
}
template <int LDQ, int LDK, int LDV, int LDO, int MODE>
__device__ __forceinline__ void block(const BlockRef& cur, char* lds, Seam& S, float lam, const LinRef& lr, const int tid) {
    constexpr bool LIN = (MODE == 2);
    const int wid = __builtin_amdgcn_readfirstlane(tid >> 6), lane = tid & 63, r32 = lane & 31, hi = lane >> 5;
    const int NT = cur.P0 / KVBLK + QB / KVBLK;
    const int qlo = cur.P0 + wid * QBLK, qm = qlo + r32 - 4 * hi;
    char* V_lds = lds; char* K_lds = lds + 2 * SHM_V;
    float* ws = (float*)(lds + 2 * SHM_V + 2 * SHM_K) + wid * 64; float* li_l = ws, * al_l = ws + 32;
    float m_reg = -1e30f, l_reg = 0; f32x16 o[4] = {};
    const int sr = tid >> 4, sc = (tid & 15) * 8, vst0 = v_st(sr, sc), vst1 = v_st(32 + sr, sc), kws = KSWZ(sr, sc * 2);
    const int vb0 = (int)(uintptr_t)V_lds + v_rd_base(lane);
    const bf16* Kh = cur.K; const bf16* Vh = cur.V;
    const unsigned offV = (unsigned)(sr * LDV + sc) * 2u, offK = (unsigned)(sr * LDK + sc) * 2u, offQ = (unsigned)(r32 * LDQ + hi * 8) * 2u;
    float Mt = 0.f; if constexpr (LIN) Mt = *reinterpret_cast<const float*>(reinterpret_cast<const char*>(uni(lr.MT + qlo)) + (unsigned)r32 * 4u);
#define ATT_RESC(a) do { if constexpr (!LIN) { if (__any((a) < 1.f)) { if (hi == 0) al_l[r32] = (a); asm volatile("s_waitcnt lgkmcnt(0)" ::: "memory");              \
                     for (int d_ = 0; d_ < 4; ++d_) for (int r = 0; r < 16; ++r) o[d_][r] *= al_l[crow(r, hi)]; } } } while (0)
#define ATT_KBASE(t) ((t) * KVBLK)
#define ATT_MASKT(P0_, P1_, t) do { const int kb_ = ATT_KBASE(t); if (kb_ + KVBLK - 1 > qlo) mask_tile<LIN>(P0_, P1_, qm - kb_); } while (0)
#define ATT_PSM(P0_, P1_, mnX, alX, t) do { if constexpr (LIN) { mnX = __builtin_amdgcn_exp2f((lr.REF[t] - Mt) * 1.4426950408889634f); } \
                                            else partialSM(P0_, P1_, m_reg, mnX, alX); } while (0)
#define ATT_FSM(P0_, P1_, alY, mnY) do { if constexpr (LIN) { partialLin(P0_, P1_, mnY); finishLin(P0_, P1_, l_reg, pa0, pa1, pa2, pa3); } else finishSM(P0_, P1_, alY, l_reg, pa0, pa1, pa2, pa3); } while (0)
#define ATT_SEAM_K0() do { ATT_VMW(); ATT_SWRITE_K(0); SBAR(); } while (0)
    f32x16 pA0, pA1, pB0, pB1; float mnA = 0.f, mnB = 0.f, alA = 1.f, alB = 1.f; bf16x8 pa0, pa1, pa2, pa3;
    ATT_SWRITE_V(0); SBAR();
    const char* qlds = lds + LDS_QIMG + wid * 8192 + lane * 16;
    if constexpr (LIN) {
#pragma unroll
        for (int d0 = 0; d0 < 8; ++d0) *reinterpret_cast<bf16x8*>(const_cast<char*>(qlds) + d0 * 1024) = S.qr[d0];
    }
    if (NT > 1) ATT_SLOAD(Kh, Vh, ATT_KBASE(1));
    SBAR(); qkt<0, LIN>(pA0, pA1, K_lds, r32, hi, S.qr, qlds);
    ATT_MASKT(pA0, pA1, 0); ATT_PSM(pA0, pA1, mnA, alA, 0);
    if (NT > 1) { ATT_VMW(); ATT_SWRITE_V(1); ATT_SWRITE_K(1); }
    __syncthreads();
#define ATT_HALF_STEP(PX0, PX1, mnX, alX, PY0, PY1, alY, mnY, t, KB, VB, SB) do {                                                      \
        SBAR(); qkt<KB, LIN>(PX0, PX1, K_lds, r32, hi, S.qr, qlds);                                             \
        ATT_FSM(PY0, PY1, alY, mnY); SBAR();                                                           \
        if ((t) + 1 < NT) { ATT_SLOAD(Kh, Vh, ATT_KBASE((t) + 1)); SBAR(); }                                               \
        pv_tile<VB>(o, vb0, pa0, pa1, pa2, pa3); ATT_MASKT(PX0, PX1, (t)); ATT_PSM(PX0, PX1, mnX, alX, (t));                                        \
        __syncthreads();                                                                                                      \
        if ((t) + 1 < NT) { ATT_VMW(); ATT_SWRITE_V(SB); ATT_SWRITE_K(SB); }                                                                          \
        ATT_RESC(alX); __syncthreads(); } while (0)
    for (int t = 1; t + 1 < NT; t += 2) {
        ATT_HALF_STEP(pB0, pB1, mnB, alB, pA0, pA1, alA, mnA, t, 1, 0, 0);
        ATT_HALF_STEP(pA0, pA1, mnA, alA, pB0, pB1, alB, mnB, t + 1, 0, 1, 1);
    }
    SBAR(); qkt<1, LIN>(pB0, pB1, K_lds, r32, hi, S.qr, qlds); SBAR();
    { const bf16* nK = get_next(lds, 1); const bf16* nV = get_next(lds, 2); ATT_SLOAD(nK, nV, 0); } SBAR();
    ATT_FSM(pA0, pA1, alA, mnA); SBAR();
    pv_tile<0>(o, vb0, pa0, pa1, pa2, pa3);
    ATT_MASKT(pB0, pB1, NT - 1); ATT_PSM(pB0, pB1, mnB, alB, NT - 1); __syncthreads(); ATT_RESC(alB);
    ATT_FSM(pB0, pB1, alB, mnB); SBAR(); pv_tile<1>(o, vb0, pa0, pa1, pa2, pa3);
    SBAR(); ATT_SEAM_K0();
    { const bf16* qb_ = uni(get_next(lds, 0) + (size_t)(wid * QBLK) * LDQ);
#pragma unroll
    for (int d0 = 0; d0 < 8; ++d0) S.qr[d0] = load8o(qb_, offQ + d0 * 32u); }
    SBAR();
    if constexpr (LIN) { auto rr = __builtin_amdgcn_permlane32_swap(__float_as_uint(l_reg), __float_as_uint(l_reg), false, false); l_reg = __uint_as_float(rr[0]) + __uint_as_float(rr[1]); }
    if (hi == 0) li_l[r32] = l_reg; asm volatile("s_waitcnt lgkmcnt(0)" ::: "memory");
    float rli[16];
    const float* emtp = LIN ? reinterpret_cast<const float*>(reinterpret_cast<const char*>(uni(lr.EMT + (cur.P0 + wid * QBLK))) + (unsigned)hi * 16u) : nullptr;
#pragma unroll
    for (int r = 0; r < 16; ++r) {
        const float lv = li_l[crow(r, hi)];
        if constexpr (LIN) { const float em = emtp[(r & 3) + 8 * (r >> 2)]; rli[r] = __builtin_amdgcn_rcpf(fmaxf(fabsf(lv), em)); }
        else rli[r] = __builtin_amdgcn_rcpf(lv);
    }
    char* Ow = reinterpret_cast<char*>(uni(cur.O + (size_t)(wid * QBLK) * LDO));
    const unsigned offO = (unsigned)(4 * hi * LDO + r32) * 4u;
#pragma unroll
    for (int r = 0; r < 16; ++r) {
#pragma unroll
        for (int d0 = 0; d0 < 4; ++d0) { const float v = o[d0][r] * rli[r];
            float* p = reinterpret_cast<float*>(Ow + (offO + (unsigned)((((r & 3) + 8 * (r >> 2)) * LDO + d0 * 32) * 4)));
            if constexpr (MODE == 1) { const float prev = *p; *p = prev - lam * v; }
            else *p = v; } }
    __syncthreads();
#undef ATT_RESC
#undef ATT_KBASE
#undef ATT_MASKT
#undef ATT_PSM
#undef ATT_FSM
#undef ATT_SEAM_K0
#undef ATT_HALF_STEP
}
#undef ATT_VMW
#undef ATT_VMWN
#undef ATT_SLOAD
#undef ATT_SWRITE_K
#undef ATT_SWRITE_V
#undef ATT_PK4
#undef KSWZ
#undef SBAR
}
constexpr int NWAVES = 8;
constexpr int DM = 2048, NB = 8, SEQ = 4096, DEPTH = 4, M = NB * SEQ;
constexpr int DIN = 13320, NP = 13312, DFF = 5632, NGU = 2 * DFF;
constexpr int KMRG = 3072;
constexpr int C_MQK = 0, C_MV = 1024, C_MO = 2048, C_AQ = 3072, C_AK = 5120, C_AV = 7168, C_GM = 9216, C_GA = 11264;
constexpr float EPS = 1e-6f;
#ifndef DBG
#define DBG 0
#endif

constexpr size_t MiB = 1u << 20;
constexpr size_t WS_CTL = 0, CTL_ZERO_BYTES = 1 * MiB;
constexpr size_t WS_ROPE = 2 * MiB;
constexpr size_t WS_LIF = 6 * MiB;
constexpr size_t WS_MT = 7 * MiB;
constexpr size_t WS_EMT = WS_MT + 512 * 1024;
constexpr size_t WS_KSC = 8 * MiB;
constexpr size_t WS_REF = WS_KSC + 512 * 1024;
constexpr size_t WS_WIN = 16 * MiB, WS_PM = 68 * MiB, WS_PA = 72 * MiB, WS_WO = 80 * MiB, WS_WGU = 88 * MiB, WS_WD = 132 * MiB;
constexpr size_t WS_HY = 154 * MiB;
constexpr size_t WS_QKM = 282 * MiB;
constexpr size_t WS_HT = 346 * MiB;
constexpr size_t WS_OST = 474 * MiB;
constexpr size_t WS_PROJ = 730 * MiB;
constexpr size_t WS_END = 1562 * MiB;
static_assert(WS_PROJ + (size_t)M * NP * 2 == WS_END, "ws map");
constexpr int CW_BAR = 4096;

constexpr int RING_OFF = 0, RING_BYTES = 135168;
constexpr int LDSCTL_OFF = RING_BYTES, MISC_OFF = LDSCTL_OFF + 320;
constexpr int LDS_BYTES = 147456;

#define GAS __attribute__((address_space(1)))
#define LAS __attribute__((address_space(3)))
typedef unsigned short bf16;
typedef unsigned v4u __attribute__((ext_vector_type(4)));
typedef unsigned v2u __attribute__((ext_vector_type(2)));
typedef float f32x4 __attribute__((ext_vector_type(4)));
typedef GAS unsigned gu32;
#define LDS_WAIT() asm volatile("s_waitcnt lgkmcnt(0)" ::: "memory")
#define VM_WAIT() asm volatile("s_waitcnt vmcnt(0)" ::: "memory")
__device__ __forceinline__ unsigned f2bf(float f) { unsigned u = __builtin_bit_cast(unsigned, f); return (u + 0x7fffu + ((u >> 16) & 1u)) >> 16; }
__device__ __forceinline__ unsigned pk2(float lo, float hi) { return f2bf(lo) | (f2bf(hi) << 16); }
__device__ __forceinline__ float bflo(unsigned u) { return __uint_as_float(u << 16); }
__device__ __forceinline__ float bfhi(unsigned u) { return __uint_as_float(u & 0xffff0000u); }
__device__ __forceinline__ float bf2f(bf16 h) { return __uint_as_float((unsigned)h << 16); }
#define SWZ_XOR(v, o) __uint_as_float((unsigned)__builtin_amdgcn_ds_swizzle((int)__float_as_uint(v), ((o) << 10) | 0x1f))
__device__ __forceinline__ float xhalf(float v, bool is_max) { auto rr = __builtin_amdgcn_permlane32_swap(__float_as_uint(v), __float_as_uint(v), false, false);
    const float a = __uint_as_float(rr[0]), b = __uint_as_float(rr[1]); return is_max ? fmaxf(a, b) : a + b; }
__device__ __forceinline__ float wave_sum(float v) {
    v += SWZ_XOR(v, 1); v += SWZ_XOR(v, 2); v += SWZ_XOR(v, 4); v += SWZ_XOR(v, 8); v += SWZ_XOR(v, 16);
    return xhalf(v, false);
}
__device__ __forceinline__ float shfl_up_l(float v, int o, int lane) { return __uint_as_float((unsigned)__builtin_amdgcn_ds_bpermute(((lane - o) & 63) << 2, (int)__float_as_uint(v))); }
__device__ __forceinline__ float sigmoidf_(float x) { return 1.0f / (1.0f + __expf(-x)); }

#define XB_TMO      128
#define XB_XCNT(j)  (256  + 64 * (j))
#define XB_XSUB(j)  (1280 + 64 * (j))
#define XB_XGEN(j)  (2304 + 64 * (j))
#define XB_TOP      3328
#define XB_TOPGEN   3392
#define XCD_BAR_WORDS 3456
#define XB_SPIN_CAP (1u << 18)
__device__ __forceinline__ unsigned xb_ld(unsigned* p)              { return __hip_atomic_load(p, __ATOMIC_RELAXED, __HIP_MEMORY_SCOPE_AGENT); }
__device__ __forceinline__ unsigned xb_add(unsigned* p, unsigned v) { return __hip_atomic_fetch_add(p, v, __ATOMIC_RELAXED, __HIP_MEMORY_SCOPE_AGENT); }
__device__ __forceinline__ unsigned xb_xcc_id() { return (unsigned)__builtin_amdgcn_s_getreg((3 << 11) | 20) & 0xFu; }
#define XB_SPIN(cond, bar) do { unsigned _sp = 0; while (cond) { __builtin_amdgcn_s_sleep(1); \
    if ((++_sp & 255u) == 0u) { if (xb_ld(&(bar)[XB_TMO])) break; if (_sp > XB_SPIN_CAP) { atomicAdd(&(bar)[XB_TMO], 1u); break; } } } } while (0)
struct XcdBarrier { unsigned* bar; unsigned x; volatile LAS unsigned* st; };
__device__ __forceinline__ XcdBarrier xcd_barrier_post(unsigned* bar, volatile LAS unsigned* st) {
    XcdBarrier b; b.bar = bar; b.x = xb_xcc_id(); b.st = st;
    if (threadIdx.x == 0) (void)xb_add(&bar[XB_XCNT(b.x)], 1u);
    return b;
}
__device__ __forceinline__ void xcd_barrier_complete(unsigned* bar, unsigned x, unsigned& nloc, unsigned& nx) {
    const unsigned G = gridDim.x * gridDim.y * gridDim.z;
    unsigned sum, cnt, mine, sp = 0u;
    for (;;) {
        sum = 0u; cnt = 0u; mine = 0u;
#pragma unroll
        for (unsigned j = 0; j < 16; ++j) { const unsigned c = xb_ld(&bar[XB_XCNT(j)]); sum += c; cnt += (c > 0u) ? 1u : 0u; mine = (j == x) ? c : mine; }
        if (sum == G) break;
        __builtin_amdgcn_s_sleep(1);
        if ((++sp & 255u) == 0u) { if (xb_ld(&bar[XB_TMO])) break; if (sp > XB_SPIN_CAP) { atomicAdd(&bar[XB_TMO], 1u); break; } }
    }
    nloc = mine > 0u ? mine : 1u; nx = cnt > 0u ? cnt : 1u;
}
__device__ __forceinline__ void xcd_barrier(const XcdBarrier& b) {
    asm volatile("s_waitcnt vmcnt(0)" ::: "memory");
    __syncthreads();
    if (threadIdx.x == 0) {
        unsigned* bar = b.bar;
        __builtin_amdgcn_s_waitcnt(0);
        unsigned nloc = b.st[0], nx = b.st[1];
        if (nloc == 0u) { xcd_barrier_complete(bar, b.x, nloc, nx); b.st[0] = nloc; b.st[1] = nx; }
        const unsigned old = xb_add(&bar[XB_XSUB(b.x)], 1u);
        const unsigned gen = old / nloc;
        if (old + 1u == (gen + 1u) * nloc) {
            __builtin_amdgcn_fence(__ATOMIC_RELEASE, "agent");
            asm volatile("s_waitcnt vmcnt(0)" ::: "memory");
            const unsigned og = xb_add(&bar[XB_TOP], 1u);
            const unsigned tg = og / nx;
            if (og + 1u == (tg + 1u) * nx) xb_add(&bar[XB_TOPGEN], 1u);
            else XB_SPIN(xb_ld(&bar[XB_TOPGEN]) == tg, bar);
            __builtin_amdgcn_fence(__ATOMIC_ACQUIRE, "agent");
            xb_add(&bar[XB_XGEN(b.x)], 1u);
            asm volatile("s_waitcnt vmcnt(0)" ::: "memory");
        } else {
            XB_SPIN(xb_ld(&bar[XB_XGEN(b.x)]) == gen, bar);
            __builtin_amdgcn_fence(__ATOMIC_ACQUIRE, "agent");
            asm volatile("s_waitcnt vmcnt(0)" ::: "memory");
        }
    }
    __syncthreads();
}

__device__ const double ROPE_INV[16] = {1.0, 0.44036660267178046, 0.19392274474868576, 0.08539710028576561, 0.03760603093086393, 0.016560440080994446, 0.007292664737217109, 0.003211445994752591,
    0.001414213562373095, 0.000622772421914596, 0.0002742481756762073, 0.00012076973741146504, 5.318295896944988e-05, 2.341999896140934e-05, 1.031338537721246e-05, 4.5416704806078695e-06};

__device__ __forceinline__ void rope_table_phase(const int* pos, float* rope, int gtid, int gthreads) {
    for (int idx = gtid; idx < M * 16; idx += gthreads) {
        const int row = idx >> 4, i = idx & 15;
        const float angf = (float)pos[row] * (float)ROPE_INV[i];
        const double rev = (double)angf * 0.15915494309189535;
        const float fr = (float)(rev - __builtin_rint(rev));
        rope[(size_t)row * 32 + i] = __builtin_amdgcn_cosf(fr);
        rope[(size_t)row * 32 + 16 + i] = __builtin_amdgcn_sinf(fr);
    }
}

__device__ __forceinline__ void tr_item64(const float* W, int ldw, int ldk, bf16* WT, int k0, int k0d, int n0d, int n0s, bool ropeperm, LAS float* scr, int lane) {
    const int c = lane & 15, rr = lane >> 4;
    f32x4 v[16];
    const float* src = W + (size_t)(k0 + rr) * ldw + n0s + 4 * c;
#pragma unroll
    for (int i = 0; i < 16; ++i) v[i] = *(const GAS f32x4*)(src + (size_t)(4 * i) * ldw);
#pragma unroll
    for (int i = 0; i < 16; ++i) { LAS float* d = scr + (4 * c) * 65 + 4 * i + rr; d[0] = v[i].x; d[65] = v[i].y; d[130] = v[i].z; d[195] = v[i].w; }
    LDS_WAIT(); asm volatile("" ::: "memory");
    const int c8 = lane & 7;
#pragma unroll
    for (int j = 0; j < 8; ++j) { const int n = 8 * j + (lane >> 3); const int ns = (ropeperm && n < 32) ? ((n >> 1) + 16 * (n & 1)) : n; const LAS float* s = scr + ns * 65 + 8 * c8;
        v4u o; o.x = pk2(s[0], s[1]); o.y = pk2(s[2], s[3]); o.z = pk2(s[4], s[5]); o.w = pk2(s[6], s[7]);
        *(GAS v4u*)(WT + (size_t)(n0d + n) * ldk + k0d + 8 * c8) = o; }
    LDS_WAIT(); asm volatile("" ::: "memory");
}

__device__ __forceinline__ void convert_weights_phase(int l, const float* w_in, const float* p_m, const float* p_a, const float* w_out, const float* w_gate, const float* w_up, const float* w_down,
                                                      unsigned char* ws, LAS float* scr, int gw, int ngw, int lane) {
    constexpr int I1 = (DM / 64) * (NP / 64), I2 = (1024 / 64) * (DM / 64), I3 = (DM / 64) * (DM / 64), I4 = I3, I5 = (DM / 64) * (NGU / 64), I6 = (DFF / 64) * (DM / 64);
    constexpr int NIT = I1 + I2 + I3 + I4 + I5 + I6;
    for (int it = gw; it < NIT; it += ngw) {
        int r = it; const float* W; int ldw, K, nblk, koff = 0; size_t wsoff; int mode;
        if (r < I1) { W = w_in + (size_t)l * DM * DIN; ldw = DIN; K = DM; nblk = NP / 64; wsoff = WS_WIN; mode = 1; }
        else if ((r -= I1) < I2) { W = p_m + (size_t)l * 1024 * DM; ldw = DM; K = KMRG; nblk = DM / 64; wsoff = WS_PM; mode = 0; }
        else if ((r -= I2) < I3) { W = p_a + (size_t)l * DM * DM; ldw = DM; K = KMRG; koff = 1024; nblk = DM / 64; wsoff = WS_PM; mode = 0; }
        else if ((r -= I3) < I4) { W = w_out + (size_t)l * DM * DM; ldw = DM; K = DM; nblk = DM / 64; wsoff = WS_WO; mode = 0; }
        else if ((r -= I4) < I5) { W = nullptr; ldw = DFF; K = DM; nblk = NGU / 64; wsoff = WS_WGU; mode = 2; }
        else { r -= I5; W = w_down + (size_t)l * DFF * DM; ldw = DM; K = DFF; nblk = DM / 64; wsoff = WS_WD; mode = 0; }
        const int kb = r / nblk, nb = r % nblk, n0d = nb * 64; int n0s = n0d; bool rp = false;
        if (mode == 1) { n0s = n0d < 3072 ? n0d : n0d + 8; rp = (n0d >= C_AQ && n0d < C_AV && (n0d & 127) == 0); }
        if (mode == 2) { const int pn = n0d >> 8, r0 = n0d & 255; W = (r0 < 128 ? w_gate : w_up) + (size_t)l * DM * DFF; n0s = pn * 128 + (r0 & 127); }
        tr_item64(W, ldw, K, (bf16*)(ws + wsoff), kb * 64, koff + kb * 64, n0d, n0s, rp, scr, lane);
    }
}

__device__ __forceinline__ void norm_row(const float* xrow, const float* g, bf16* orow, int lane, f32x4 (&v)[8]) {
    const GAS f32x4* xr = (const GAS f32x4*)xrow + lane; const GAS f32x4* gr = (const GAS f32x4*)g + lane;
    float s = 0.f;
#pragma unroll
    for (int j = 0; j < 8; ++j) { v[j] = xr[64 * j]; s += (v[j].x * v[j].x + v[j].y * v[j].y) + (v[j].z * v[j].z + v[j].w * v[j].w); }
    const float rstd = 1.0f / sqrtf(wave_sum(s) * (1.f / DM) + EPS);
    GAS unsigned long long* o8 = (GAS unsigned long long*)orow + lane;
#pragma unroll
    for (int j = 0; j < 8; ++j) { const f32x4 gg = gr[64 * j]; v[j] = v[j] * rstd * gg;
        o8[64 * j] = (unsigned long long)pk2(v[j].x, v[j].y) | ((unsigned long long)pk2(v[j].z, v[j].w) << 32); }
}

__device__ __forceinline__ void mlstm_scan(int b, int h, const float* LIF, float* KSC, float* MT, float* EMT, float* REF, LAS float* sm, int tid) {
    const int lane = tid & 63, wave = tid >> 6;
    const float* base = LIF + (size_t)(b * SEQ) * 8;
    float li[8], c[8]; float run = 0.f;
#pragma unroll
    for (int j = 0; j < 8; ++j) { const int s = 8 * tid + j; li[j] = base[(size_t)s * 8 + h]; run += base[(size_t)s * 8 + 4 + h]; c[j] = run; }
    float inc = run;
#pragma unroll
    for (int o = 1; o < 64; o <<= 1) { const float vv = shfl_up_l(inc, o, lane); if (lane >= o) inc += vv; }
    if (lane == 63) sm[wave] = inc;
    __syncthreads();
    float woff = 0.f; for (int w = 0; w < wave; ++w) woff += sm[w];
    const float excl = woff + inc - run;
    float a[8], bs[8]; float lmax = -__builtin_inff();
#pragma unroll
    for (int j = 0; j < 8; ++j) { bs[j] = excl + c[j]; a[j] = li[j] - bs[j]; lmax = fmaxf(lmax, a[j]); }
    float tmax = lmax; tmax = fmaxf(tmax, SWZ_XOR(tmax, 1)); tmax = fmaxf(tmax, SWZ_XOR(tmax, 2)); tmax = fmaxf(tmax, SWZ_XOR(tmax, 4));
    float pm = lmax;
#pragma unroll
    for (int o = 1; o < 64; o <<= 1) { const float vv = shfl_up_l(pm, o, lane); if (lane >= o) pm = fmaxf(pm, vv); }
    if (lane == 63) sm[8 + wave] = pm;
    __syncthreads();
    float wpm = -__builtin_inff(); for (int w = 0; w < wave; ++w) wpm = fmaxf(wpm, sm[8 + w]);
    float prevl = shfl_up_l(pm, 1, lane); if (lane == 0) prevl = -__builtin_inff();
    float rmax = fmaxf(0.f, fmaxf(wpm, prevl));
    const size_t o0 = (size_t)(b * 4 + h) * SEQ + 8 * tid;
#pragma unroll
    for (int j = 0; j < 8; ++j) { rmax = fmaxf(rmax, a[j]); MT[o0 + j] = rmax; EMT[o0 + j] = __expf(-(bs[j] + rmax)); KSC[o0 + j] = __expf(a[j] - tmax); }
    if ((tid & 7) == 0) REF[(b * 4 + h) * 64 + (tid >> 3)] = tmax;
    __syncthreads();
}

__device__ __forceinline__ void mprep_strip(int strip, const bf16* PROJ, const float* cw, const float* cb, const float* KSC, bf16* QKM, int lane) {
    const int m0 = strip * 16, b = m0 / SEQ, s0 = m0 % SEQ, hh = lane >> 4;
    float w[4][16], bias[16];
#pragma unroll
    for (int j = 0; j < 4; ++j) {
#pragma unroll
        for (int e = 0; e < 8; ++e) { w[j][e] = cw[j * 1024 + 8 * lane + e]; w[j][8 + e] = cw[j * 1024 + 512 + 8 * lane + e]; } }
#pragma unroll
    for (int e = 0; e < 8; ++e) { bias[e] = cb[8 * lane + e]; bias[8 + e] = cb[512 + 8 * lane + e]; }
    float x0[16], x1[16], x2[16], x3[16];
#define LDROW(dst, s_) do { if ((s_) >= 0) { const bf16* rp = PROJ + (size_t)(b * SEQ + (s_)) * NP + C_MQK; const v4u q4 = *(const GAS v4u*)(rp + 8 * lane); const v4u k4 = *(const GAS v4u*)(rp + 512 + 8 * lane); \
            dst[0] = bflo(q4.x); dst[1] = bfhi(q4.x); dst[2] = bflo(q4.y); dst[3] = bfhi(q4.y); dst[4] = bflo(q4.z); dst[5] = bfhi(q4.z); dst[6] = bflo(q4.w); dst[7] = bfhi(q4.w); \
            dst[8] = bflo(k4.x); dst[9] = bfhi(k4.x); dst[10] = bflo(k4.y); dst[11] = bfhi(k4.y); dst[12] = bflo(k4.z); dst[13] = bfhi(k4.z); dst[14] = bflo(k4.w); dst[15] = bfhi(k4.w); } \
        else { _Pragma("unroll") for (int e_ = 0; e_ < 16; ++e_) dst[e_] = 0.f; } } while (0)
    LDROW(x0, s0 - 3); LDROW(x1, s0 - 2); LDROW(x2, s0 - 1);
    for (int i = 0; i < 16; ++i) {
        const int s = s0 + i;
        LDROW(x3, s);
        const float ksc = KSC[(size_t)(b * 4 + hh) * SEQ + s] * 0.08838834764831845f;
        float y[16];
#pragma unroll
        for (int e = 0; e < 16; ++e) { float t = bias[e] + w[0][e] * x0[e] + w[1][e] * x1[e] + w[2][e] * x2[e] + w[3][e] * x3[e]; t = t * sigmoidf_(t); y[e] = (e < 8) ? t : t * ksc; }
        v4u oq, ok; oq.x = pk2(y[0], y[1]); oq.y = pk2(y[2], y[3]); oq.z = pk2(y[4], y[5]); oq.w = pk2(y[6], y[7]);
        ok.x = pk2(y[8], y[9]); ok.y = pk2(y[10], y[11]); ok.z = pk2(y[12], y[13]); ok.w = pk2(y[14], y[15]);
        bf16* op = QKM + (size_t)(m0 + i) * 1024;
        *(GAS v4u*)(op + 8 * lane) = oq; *(GAS v4u*)(op + 512 + 8 * lane) = ok;
#pragma unroll
        for (int e = 0; e < 16; ++e) { x0[e] = x1[e]; x1[e] = x2[e]; x2[e] = x3[e]; }
    }
#undef LDROW
}

__device__ __forceinline__ void finish_row(int row, const float* HT, const float* OST, bf16* PROJ, const float* g_mhead, const float* g_sub, float one_m_laminit, int lane) {
    bf16* prow = PROJ + (size_t)row * NP;
#pragma unroll
    for (int hh = 0; hh < 4; ++hh) {
        const f32x4 v = *(const GAS f32x4*)(HT + (size_t)row * 1024 + hh * 256 + 4 * lane);
        const float ss = wave_sum((v.x * v.x + v.y * v.y) + (v.z * v.z + v.w * v.w));
        const float rstd = 1.0f / sqrtf(ss * (1.f / 256.f) + EPS);
        const f32x4 g = *(const GAS f32x4*)(g_mhead + hh * 256 + 4 * lane);
        const v2u so = *(const GAS v2u*)(prow + C_MO + hh * 256 + 4 * lane);
        const float o0 = bflo(so.x) * (v.x * rstd * g.x), o1 = bfhi(so.x) * (v.y * rstd * g.y), o2 = bflo(so.y) * (v.z * rstd * g.z), o3 = bfhi(so.y) * (v.w * rstd * g.w);
        v2u w; w.x = pk2(o0, o1); w.y = pk2(o2, o3);
        *(GAS v2u*)(prow + C_MO + hh * 256 + 4 * lane) = w;
    }
    const f32x4 gs = *(const GAS f32x4*)(g_sub + 4 * lane);
#pragma unroll
    for (int hh = 0; hh < 8; ++hh) {
        const f32x4 v = *(const GAS f32x4*)(OST + (size_t)row * 2048 + hh * 256 + 4 * lane);
        const float ss = wave_sum((v.x * v.x + v.y * v.y) + (v.z * v.z + v.w * v.w));
        const float rstd = 1.0f / sqrtf(ss * (1.f / 256.f) + EPS) * one_m_laminit;
        v2u w; w.x = pk2(v.x * rstd * gs.x, v.y * rstd * gs.y); w.y = pk2(v.z * rstd * gs.z, v.w * rstd * gs.w);
        *(GAS v2u*)(prow + C_AQ + hh * 256 + 4 * lane) = w;
    }
}
struct Args { const void* in[22]; float* out; unsigned char* ws; int stop_layer; int stop_phase; };

constexpr int PT_OFF = MISC_OFF + 128;
constexpr int PT_OUT = 22, PT_WS = 23;
static_assert(PT_OFF + 24 * 8 <= LDS_BYTES, "LDS map");
__device__ __forceinline__ const void* ldp(LAS unsigned char* ldsA, int k) {
    const volatile LAS unsigned* p = (const volatile LAS unsigned*)(ldsA + PT_OFF) + 2 * k; const unsigned lo = p[0], hi = p[1];
    return (const void*)(((unsigned long long)(unsigned)__builtin_amdgcn_readfirstlane(hi) << 32) | (unsigned)__builtin_amdgcn_readfirstlane(lo));
}
#define LDPF(k) ((const float*)ldp(ldsA, (k)))

__global__ void __launch_bounds__(NWAVES * 64, 2) hybrid_fwd(Args args) {
    extern __shared__ __attribute__((aligned(16))) unsigned char lds[];
    LAS unsigned char* ldsA0 = (LAS unsigned char*)lds;
    const int tid0 = threadIdx.x;
    const int wave0 = __builtin_amdgcn_readfirstlane(tid0 >> 6);
    const int G0 = gridDim.x; const int bx0 = blockIdx.x;
    const int vcu0 = (G0 % 8 == 0) ? (bx0 % 8) * (G0 / 8) + bx0 / 8 : bx0;
#define PHASE_IDS() int tid = wave0 * 64 + (int)__builtin_amdgcn_mbcnt_hi(~0u, __builtin_amdgcn_mbcnt_lo(~0u, 0u)); asm volatile("" : "+v"(tid)); int lz_ = 0; asm volatile("" : "+s"(lz_)); \
    const int lane = tid & 63, wave = __builtin_amdgcn_readfirstlane(tid >> 6), G = G0 + lz_, bx = bx0 + lz_, vcu = vcu0 + lz_, NGW = G * NWAVES, gw = vcu * NWAVES + wave; \
    LAS unsigned char* ldsA = ldsA0 + lz_; char* ldsG = (char*)lds + lz_; (void)lane; (void)gw; (void)bx; (void)NGW; (void)ldsG
    for (int u = tid0; u < (LDS_BYTES - LDSCTL_OFF) / 4; u += NWAVES * 64) ((LAS unsigned*)(ldsA0 + LDSCTL_OFF))[u] = 0u;
    __syncthreads();
    if (tid0 < 24) { const unsigned long long v = (tid0 < 22) ? (unsigned long long)args.in[tid0] : (tid0 == 22 ? (unsigned long long)args.out : (unsigned long long)args.ws);
        ((volatile LAS unsigned long long*)(ldsA0 + PT_OFF))[tid0] = v; }
    __syncthreads();
    { XcdBarrier b0_ = xcd_barrier_post((unsigned*)((unsigned char*)ldp(ldsA0, PT_WS) + WS_CTL) + CW_BAR, (volatile LAS unsigned*)(ldsA0 + MISC_OFF) + 8); (void)b0_; }
#define GRID_BAR() do { int lzb_ = 0; asm volatile("" : "+s"(lzb_)); XcdBarrier b_; b_.bar = (unsigned*)((unsigned char*)ldp(ldsA0 + lzb_, PT_WS) + WS_CTL) + CW_BAR; b_.x = xb_xcc_id(); \
        b_.st = (volatile LAS unsigned*)(ldsA0 + lzb_ + MISC_OFF) + 8; xcd_barrier(b_); } while (0)
    const int stop_layer = args.stop_layer, stop_phase = args.stop_phase;

    { PHASE_IDS(); unsigned char* ws = (unsigned char*)ldp(ldsA, PT_WS); rope_table_phase((const int*)ldp(ldsA, 1), (float*)(ws + WS_ROPE), gw * 64 + lane, NGW * 64); }

#define STOP_AT(ph) do { if (DBG && l == stop_layer && stop_phase == (ph)) return; } while (0)
    for (int l = 0; l < DEPTH; ++l) {
        for (int rep_ = 0; rep_ < REPS(0); ++rep_)
        {
            PHASE_IDS();
            unsigned char* ws = (unsigned char*)ldp(ldsA, PT_WS);
            const float* w_in = LDPF(3);
            convert_weights_phase(l, w_in, LDPF(14), LDPF(15), LDPF(16), LDPF(18), LDPF(19), LDPF(20), ws, (LAS float*)(ldsA + RING_OFF + wave * 16640), gw, NGW, lane);
            __syncthreads();
            LAS float* wgT = (LAS float*)(ldsA + RING_OFF);
            for (int k = tid; k < DM; k += NWAVES * 64) {
                const float* src = w_in + (size_t)l * DM * DIN + (size_t)k * DIN + 3072;
                const f32x4 a = *(const GAS f32x4*)src, b2 = *(const GAS f32x4*)(src + 4);
                wgT[0 * DM + k] = a.x; wgT[1 * DM + k] = a.y; wgT[2 * DM + k] = a.z; wgT[3 * DM + k] = a.w;
                wgT[4 * DM + k] = b2.x; wgT[5 * DM + k] = b2.y; wgT[6 * DM + k] = b2.z; wgT[7 * DM + k] = b2.w;
            }
            __syncthreads();
            const float* resid_in = (l == 0) ? LDPF(0) : LDPF(PT_OUT);
            const float* g_mix = LDPF(2) + (size_t)l * DM; const float* i_bias = LDPF(6) + l * 4; const float* f_bias = LDPF(7) + l * 4;
            bf16* HY = (bf16*)(ws + WS_HY); float* LIF = (float*)(ws + WS_LIF);
            for (int m = gw; m < M; m += NGW) {
                f32x4 v[8];
                norm_row(resid_in + (size_t)m * DM, g_mix, HY + (size_t)m * DM, lane, v);
                float ga[8];
#pragma unroll
                for (int c = 0; c < 8; ++c) { float s = 0.f;
#pragma unroll
                    for (int j = 0; j < 8; ++j) { const f32x4 wv = *(const LAS f32x4*)(wgT + c * DM + 256 * j + 4 * lane); s += (v[j].x * wv.x + v[j].y * wv.y) + (v[j].z * wv.z + v[j].w * wv.w); }
                    ga[c] = wave_sum(s); }
                if (lane < 8) {
                    float val = 0.f;
#pragma unroll
                    for (int c = 0; c < 8; ++c) if (lane == c) val = ga[c];
                    if (lane < 4) val += i_bias[lane];
                    else { const float z = val + f_bias[lane - 4]; const float e = __expf(-fabsf(z)), u = 1.0f + e, d = u - 1.0f; val = fminf(z, 0.f) - ((d == 0.f) ? e : __logf(u) * (e / d)); }
                    LIF[(size_t)m * 8 + lane] = val;
                }
            }
        }
        GRID_BAR(); STOP_AT(0);
        for (int rep_ = 0; rep_ < REPS(1); ++rep_)
        {
            PHASE_IDS();
            unsigned char* ws = (unsigned char*)ldp(ldsA, PT_WS);
            {
                float* LIF = (float*)(ws + WS_LIF); float* MT = (float*)(ws + WS_MT); float* EMT = (float*)(ws + WS_EMT); float* KSC = (float*)(ws + WS_KSC); float* REF = (float*)(ws + WS_REF);
                for (int id = vcu; id < NB * 4; id += G) mlstm_scan(id >> 2, id & 3, LIF, KSC, MT, EMT, REF, (LAS float*)(ldsA + RING_OFF), tid);
            }
            pg8::Gemm g{(const bf16*)(ws + WS_HY), (const bf16*)(ws + WS_WIN), DM, DM}; pg8::StaticOrder S; S.init(M, NP, G, bx);
            pg8::EpiProj E{(bf16*)(ws + WS_PROJ), NP, (const float*)(ws + WS_ROPE)};
            pg8::gemm_phase<pg8::EpiProj, true>(ldsA + RING_OFF, g, S, E, tid);
        }
        GRID_BAR(); STOP_AT(1);
        for (int rep_ = 0; rep_ < REPS(2); ++rep_)
        {
            PHASE_IDS();
            unsigned char* ws = (unsigned char*)ldp(ldsA, PT_WS);
            const float* cw = LDPF(4) + (size_t)l * 4 * 1024; const float* cb = LDPF(5) + (size_t)l * 1024;
            for (int st = gw; st < M / 16; st += NGW) mprep_strip(st, (const bf16*)(ws + WS_PROJ), cw, cb, (const float*)(ws + WS_KSC), (bf16*)(ws + WS_QKM), lane);
        }
        GRID_BAR(); STOP_AT(2);
        for (int rep_ = 0; rep_ < REPS(3); ++rep_)
        {
            PHASE_IDS();
            unsigned char* ws = (unsigned char*)ldp(ldsA, PT_WS);
            char* albs = ldsG + RING_OFF;
            att::Seam S;
            {
                constexpr int NIT = NB * 4 * 2 * 8; const int cnt = (NIT + G - 1) / G; const int id0 = vcu * cnt; int nitems = NIT - id0; nitems = nitems < 0 ? 0 : (nitems > cnt ? cnt : nitems);
                const int nblk = 2 * nitems;
                bf16* QKM = (bf16*)(ws + WS_QKM); bf16* PROJ = (bf16*)(ws + WS_PROJ); float* HT = (float*)(ws + WS_HT);
                const float* MT = (const float*)(ws + WS_MT); const float* EMT = (const float*)(ws + WS_EMT); const float* REF = (const float*)(ws + WS_REF);
#define MREF(s_, R, L) do { const int id_ = id0 + ((s_) >> 1), bh_ = id_ >> 4, r_ = id_ & 15, j_ = r_ >> 3, p_ = r_ & 7, qb_ = ((s_) & 1) ? 15 - p_ : p_, b_ = bh_ >> 2, hm_ = bh_ & 3; \
                    R.Q = QKM + (size_t)(b_ * SEQ + qb_ * 256) * 1024 + hm_ * 128; R.K = QKM + (size_t)(b_ * SEQ) * 1024 + 512 + hm_ * 128; \
                    R.V = PROJ + (size_t)(b_ * SEQ) * NP + C_MV + hm_ * 256 + j_ * 128; R.O = HT + (size_t)(b_ * SEQ + qb_ * 256) * 1024 + hm_ * 256 + j_ * 128; R.P0 = qb_ * 256; \
                    L.MT = MT + (size_t)bh_ * SEQ; L.EMT = EMT + (size_t)bh_ * SEQ; L.REF = REF + bh_ * 64; } while (0)
                if (nblk > 0) {
                    { att::BlockRef cur; att::LinRef lc; MREF(0, cur, lc); att::prime<1024, 1024, NP>(cur, albs, S, tid); }
                    for (int s = 0; s < nblk; ++s) {
                        { att::BlockRef nxt; att::LinRef ln; const int sn = (s + 1 < nblk) ? s + 1 : s; MREF(sn, nxt, ln); att::put_next(albs, nxt, tid); }
                        att::BlockRef cur; att::LinRef lc; MREF(s, cur, lc);
                        { int t2 = tid; asm volatile("" : "+v"(t2)); att::block<1024, 1024, NP, 1024, 2>(cur, albs, S, 0.f, lc, t2); }
                    }
                }
#undef MREF
            }
            {
                float lam;
                { const float* lq1 = LDPF(9) + l * 128; const float* lk1 = LDPF(10) + l * 128; const float* lq2 = LDPF(11) + l * 128; const float* lk2 = LDPF(12) + l * 128;
                  const float a1 = lq1[lane] * lk1[lane] + lq1[64 + lane] * lk1[64 + lane];
                  const float a2 = lq2[lane] * lk2[lane] + lq2[64 + lane] * lk2[64 + lane];
                  const float lam_init = 0.8f - 0.6f * __expf(-0.3f * (float)l);
                  lam = __expf(wave_sum(a1)) - __expf(wave_sum(a2)) + lam_init; }
                constexpr int NIT = NB * 8 * 2 * 8; const int cnt = (NIT + G - 1) / G; const int id0 = vcu * cnt; int nitems = NIT - id0; nitems = nitems < 0 ? 0 : (nitems > cnt ? cnt : nitems);
                const int nps = 2 * nitems;
                bf16* PROJ = (bf16*)(ws + WS_PROJ); float* OST = (float*)(ws + WS_OST);
                att::LinRef lr0{nullptr, nullptr, nullptr};
#define AREF(ps_, c_, R) do { const int id_ = id0 + ((ps_) >> 1), bh_ = id_ >> 4, r_ = id_ & 15, j_ = r_ >> 3, p_ = r_ & 7, qb_ = ((ps_) & 1) ? 15 - p_ : p_, b_ = bh_ >> 3, h_ = bh_ & 7; \
                    R.Q = PROJ + (size_t)(b_ * SEQ + qb_ * 256) * NP + C_AQ + h_ * 256 + (c_) * 128; R.K = PROJ + (size_t)(b_ * SEQ) * NP + C_AK + h_ * 256 + (c_) * 128; \
                    R.V = PROJ + (size_t)(b_ * SEQ) * NP + C_AV + h_ * 256 + j_ * 128; R.O = OST + (size_t)(b_ * SEQ + qb_ * 256) * 2048 + h_ * 256 + j_ * 128; R.P0 = qb_ * 256; } while (0)
                if (nps > 0) {
                    { att::BlockRef c0; AREF(0, 0, c0); att::prime<NP, NP, NP>(c0, albs, S, tid); }
                    for (int ps = 0; ps < nps; ++ps) {
                        { att::BlockRef nx; AREF(ps, 1, nx); att::put_next(albs, nx, tid); }
                        { att::BlockRef c0; AREF(ps, 0, c0); int t2 = tid; asm volatile("" : "+v"(t2)); att::block<NP, NP, NP, 2048, 0>(c0, albs, S, lam, lr0, t2); }
                        { att::BlockRef nx; if (ps + 1 < nps) AREF(ps + 1, 0, nx); else AREF(ps, 1, nx); att::put_next(albs, nx, tid); }
                        { att::BlockRef c1; AREF(ps, 1, c1); int t2 = tid; asm volatile("" : "+v"(t2)); att::block<NP, NP, NP, 2048, 1>(c1, albs, S, lam, lr0, t2); }
                    }
                }
#undef AREF
            }
        }
        GRID_BAR(); STOP_AT(3);
        for (int rep_ = 0; rep_ < REPS(4); ++rep_)
        {
            PHASE_IDS();
            unsigned char* ws = (unsigned char*)ldp(ldsA, PT_WS);
            const float oml = 1.0f - (0.8f - 0.6f * __expf(-0.3f * (float)l));
            const float* gmh = LDPF(8) + (size_t)l * 1024; const float* gsub = LDPF(13) + (size_t)l * 256;
            for (int m = gw; m < M; m += NGW) finish_row(m, (const float*)(ws + WS_HT), (const float*)(ws + WS_OST), (bf16*)(ws + WS_PROJ), gmh, gsub, oml, lane);
        }
        GRID_BAR(); STOP_AT(4);
        for (int rep_ = 0; rep_ < REPS(5); ++rep_)
        {
            PHASE_IDS();
            unsigned char* ws = (unsigned char*)ldp(ldsA, PT_WS);
            bf16* PROJ = (bf16*)(ws + WS_PROJ);
            pg8::StaticOrder S; S.init(M, DM, G, bx);
            pg8::Gemm g{PROJ + C_MO, (const bf16*)(ws + WS_PM), NP, KMRG}; pg8::EpiMerge E{PROJ + C_GM, PROJ + C_GA, NP, (bf16*)(ws + WS_HY), DM};
            pg8::gemm_phase<pg8::EpiMerge, true, 16>(ldsA + RING_OFF, g, S, E, tid);
        }
        GRID_BAR(); STOP_AT(5);
        {
            PHASE_IDS();
            unsigned char* ws = (unsigned char*)ldp(ldsA, PT_WS);
            float* out = (float*)ldp(ldsA, PT_OUT);
            const float* resid_in = (l == 0) ? LDPF(0) : (const float*)out;
            pg8::StaticOrder S; S.init(M, DM, G, bx);
            pg8::Gemm g{(const bf16*)(ws + WS_HY), (const bf16*)(ws + WS_WO), DM, DM}; pg8::EpiRes E{resid_in, out, DM};
            pg8::gemm_phase<pg8::EpiRes, true>(ldsA + RING_OFF, g, S, E, tid);
        }
        GRID_BAR(); STOP_AT(6);
        for (int rep_ = 0; rep_ < REPS(7); ++rep_)
        {
            PHASE_IDS();
            unsigned char* ws = (unsigned char*)ldp(ldsA, PT_WS);
            const float* out = LDPF(PT_OUT); const float* g_ffn = LDPF(17) + (size_t)l * DM; bf16* HY = (bf16*)(ws + WS_HY);
            for (int m = gw; m < M; m += NGW) { f32x4 v[8]; norm_row(out + (size_t)m * DM, g_ffn, HY + (size_t)m * DM, lane, v); }
        }
        GRID_BAR(); STOP_AT(7);
        for (int rep_ = 0; rep_ < REPS(8); ++rep_)
        {
            PHASE_IDS();
            unsigned char* ws = (unsigned char*)ldp(ldsA, PT_WS);
            pg8::StaticOrder S; S.init(M, NGU, G, bx);
            pg8::Gemm g{(const bf16*)(ws + WS_HY), (const bf16*)(ws + WS_WGU), DM, DM}; pg8::EpiSwiglu E{(bf16*)(ws + WS_PROJ), DFF};
            pg8::gemm_phase<pg8::EpiSwiglu, true>(ldsA + RING_OFF, g, S, E, tid);
        }
        GRID_BAR(); STOP_AT(8);
        {
            PHASE_IDS();
            unsigned char* ws = (unsigned char*)ldp(ldsA, PT_WS);
            float* out = (float*)ldp(ldsA, PT_OUT);
            pg8::StaticOrder S; S.init(M, DM, G, bx);
            pg8::Gemm g{(const bf16*)(ws + WS_PROJ), (const bf16*)(ws + WS_WD), DFF, DFF};
            pg8::EpiRes E{out, (DBG && l == stop_layer && stop_phase == 9) ? (float*)(ws + WS_OST) : out, DM};
            pg8::gemm_phase<pg8::EpiRes, true>(ldsA + RING_OFF, g, S, E, tid);
        }
        GRID_BAR(); STOP_AT(9);
    }
    {
        PHASE_IDS();
        float* out = (float*)ldp(ldsA, PT_OUT); const float* g_final = LDPF(21);
        for (int m = gw; m < M; m += NGW) {
            GAS f32x4* xr = (GAS f32x4*)(out + (size_t)m * DM) + lane; const GAS f32x4* gr = (const GAS f32x4*)g_final + lane;
            f32x4 v[8]; float s = 0.f;
#pragma unroll
            for (int j = 0; j < 8; ++j) { v[j] = xr[64 * j]; s += (v[j].x * v[j].x + v[j].y * v[j].y) + (v[j].z * v[j].z + v[j].w * v[j].w); }
            const float rstd = 1.0f / sqrtf(wave_sum(s) * (1.f / DM) + EPS);
#pragma unroll
            for (int j = 0; j < 8; ++j) xr[64 * j] = v[j] * rstd * gr[64 * j];
        }
    }
#undef GRID_BAR
#undef STOP_AT
}
extern "C" void kernel_launch(void* const* d_in, const int* in_sizes, int n_in, void* d_out, int out_size, void* d_ws, size_t ws_size, hipStream_t stream) {
    static int grid = 0;
    if (grid == 0) {
        if (n_in != 22 || in_sizes[0] != M * DM || out_size != M * DM || ws_size < WS_END) {
            fprintf(stderr, "kernel_launch: shape mismatch (n_in %d, in0 %d, out %d, ws %zu < %zu); nothing launched\n", n_in, n_in > 0 ? in_sizes[0] : -1, out_size, ws_size, (size_t)WS_END); grid = -1; return; }
        int dev = 0, cus = 0, per_cu = 0;
        if (hipGetDevice(&dev) != hipSuccess || hipDeviceGetAttribute(&cus, hipDeviceAttributeMultiprocessorCount, dev) != hipSuccess) { grid = -1; return; }
        if (hipFuncSetAttribute((const void*)hybrid_fwd, hipFuncAttributeMaxDynamicSharedMemorySize, LDS_BYTES) != hipSuccess) { fprintf(stderr, "kernel_launch: hipFuncSetAttribute failed\n"); grid = -1; return; }
        if (hipOccupancyMaxActiveBlocksPerMultiprocessor(&per_cu, (const void*)hybrid_fwd, NWAVES * 64, LDS_BYTES) != hipSuccess || per_cu < 1)
            fprintf(stderr, "kernel_launch: note: occupancy query reports %d workgroups per CU\n", per_cu);
        (void)hipGetLastError();
        grid = cus;
    }
    if (grid < 0) return;
    if (hipMemsetAsync((char*)d_ws + WS_CTL, 0, CTL_ZERO_BYTES, stream) != hipSuccess) return;
    Args a{};
    for (int i = 0; i < 22; ++i) a.in[i] = d_in[i];
    a.out = (float*)d_out; a.ws = (unsigned char*)d_ws;
    a.stop_layer = DBG ? DBG_STOP_LAYER : -1; a.stop_phase = DBG ? DBG_STOP_PHASE : -1;
    hipLaunchKernelGGL(hybrid_fwd, dim3(grid), dim3(NWAVES * 64), LDS_BYTES, stream, a);
#if DBG
    dbg_checks(d_in, (float*)d_out, (unsigned char*)d_ws, stream);
#endif
}
```

```cpp
#include <hip/hip_runtime.h>
#include <cstdio>
#include <cstdint>
#define DBG 0
#define DBG_STOP_LAYER 0
#define DBG_STOP_PHASE 3
#define PROBE_PHASE -1
#define REPS(k) ((PROBE_PHASE == (k)) ? 2 : 1)
namespace pg8 {
#define PG8_LAS __attribute__((address_space(3)))
typedef unsigned short bf16_t;
typedef short bf16x8 __attribute__((ext_vector_type(8)));
typedef float f32x4 __attribute__((ext_vector_type(4)));
typedef unsigned u32x4 __attribute__((ext_vector_type(4)));
constexpr int BM = 256, BK = 64, HALF = 128, HTB = HALF * BK * 2  , STAGE_BYTES = 8 * HTB, NXCD = 8, WGM = 8;

__host__ __device__ __forceinline__ int lds_byte(int r, int c) { const int st = (r >> 4) * 2 + (c >> 5), rr = r & 15, cc = c & 31, ob = rr * 64 + cc * 2; return st * 1024 + (ob ^ (((ob >> 9) & 1) << 5)); }
__host__ __device__ __forceinline__ void stage_rc(int b, int& R, int& C) { const int st = b / 1024, sb = b % 1024, swz = sb ^ (((sb >> 9) & 1) << 5); R = (st >> 1) * 16 + swz / 64; C = (st & 1) * 32 + (swz % 64) / 2; }
__host__ __device__ __forceinline__ int perm32(int rho) { const int n = rho >> 4, i = rho & 15; return 8 * (i >> 2) + 4 * n + (i & 3); }

struct Unit { int pm, pn; };
struct Gemm { const bf16_t* A; const bf16_t* Bt; int lda; int K; };

struct StaticOrder {
    int nM, nN, nwg, G, c;
    __host__ __device__ void init(int M, int N, int G_, int c_) { nM = M / BM; nN = N / BM; nwg = nM * nN; G = G_; c = c_; }
    __host__ __device__ bool next(int i, Unit& u) const {
        const long L = (long)i * G + c; if (L >= nwg) return false;
        int wgid = (int)L; { const int q = nwg / NXCD, r = nwg % NXCD, xcd = wgid % NXCD, off = wgid / NXCD; wgid = (xcd < r ? xcd * (q + 1) : r * (q + 1) + (xcd - r) * q) + off; }
        const int nig = WGM * nN, gid = wgid / nig, fm = gid * WGM, gsz = (nM - fm) < WGM ? (nM - fm) : WGM;
        u.pm = fm + ((wgid % nig) % gsz); u.pn = (wgid % nig) / gsz; return true;
    }
};

__device__ __forceinline__ unsigned cvt_pk_bf16(float lo, float hi) { unsigned r; asm volatile("v_cvt_pk_bf16_f32 %0, %1, %2" : "=v"(r) : "v"(lo), "v"(hi)); return r; }
__device__ __forceinline__ float bf_lo(unsigned u) { return __uint_as_float(u << 16); }
__device__ __forceinline__ float bf_hi(unsigned u) { return __uint_as_float(u & 0xffff0000u); }
__device__ __forceinline__ float sigm(float x) { return __builtin_amdgcn_rcpf(1.0f + __builtin_amdgcn_exp2f(-1.4426950408889634f * x)); }
__device__ __forceinline__ u32x4 pack8f(f32x4 a, f32x4 b) { u32x4 w; w.x = cvt_pk_bf16(a[0], a[1]); w.y = cvt_pk_bf16(a[2], a[3]); w.z = cvt_pk_bf16(b[0], b[1]); w.w = cvt_pk_bf16(b[2], b[3]); return w; }

struct EpiProj {
    static constexpr bool PERM = true;
    bf16_t* O; int ldc; const float* rope;
    __device__ __forceinline__ void operator()(const f32x4 (&acc)[2][2][4][2], const Unit& u, int wr, int wc, int fr, int fq) const {
        const int row0 = u.pm * BM + wr * 64 + fr, col0 = u.pn * BM + wc * 32 + 8 * fq;
        const int pn = u.pn;
        const bool is_sig = (pn >= 8 && pn < 12) || pn >= 36;
        const bool is_rope = (pn >= 12 && pn < 28) && (wc == 0);
#pragma unroll
        for (int ai = 0; ai < 2; ++ai)
#pragma unroll
            for (int m = 0; m < 4; ++m) {
                const int row = row0 + ai * HALF + m * 16;
                bf16_t* rowp = O + (size_t)row * ldc + col0;
                f32x4 cs = (f32x4){1.f, 1.f, 1.f, 1.f}, sn = (f32x4){0.f, 0.f, 0.f, 0.f};
                if (is_rope) { cs = *(const f32x4*)(rope + (size_t)row * 32 + 4 * fq); sn = *(const f32x4*)(rope + (size_t)row * 32 + 16 + 4 * fq); }
#pragma unroll
                for (int bj = 0; bj < 2; ++bj) {
                    f32x4 v0 = acc[ai][bj][m][0], v1 = acc[ai][bj][m][1];
                    if (is_sig) {
#pragma unroll
                        for (int e = 0; e < 4; ++e) { v0[e] = sigm(v0[e]); v1[e] = sigm(v1[e]); }
                    }
                    if (is_rope) {
                        f32x4 a0, a1;
                        a0[0] = v0[0] * cs[0] - v0[1] * sn[0]; a0[1] = v0[1] * cs[0] + v0[0] * sn[0];
                        a0[2] = v0[2] * cs[1] - v0[3] * sn[1]; a0[3] = v0[3] * cs[1] + v0[2] * sn[1];
                        a1[0] = v1[0] * cs[2] - v1[1] * sn[2]; a1[1] = v1[1] * cs[2] + v1[0] * sn[2];
                        a1[2] = v1[2] * cs[3] - v1[3] * sn[3]; a1[3] = v1[3] * cs[3] + v1[2] * sn[3];
                        v0 = a0; v1 = a1;
                    }
                    *(u32x4*)(rowp + bj * HALF) = pack8f(v0, v1);
                }
            }
    }
};
struct EpiMerge {
    static constexpr bool PERM = true;
    const bf16_t* GM; const bf16_t* GA; int ldg; bf16_t* Y; int ldy;
    __device__ __forceinline__ void hook(f32x4 (&acc)[2][2][4][2], const Unit& u, int wr, int wc, int fr, int fq) const {
        int z_ = 0; asm volatile("" : "+v"(z_));
        const int row0 = u.pm * BM + wr * 64 + fr + z_, col0 = u.pn * BM + wc * 32 + 8 * fq;
#pragma unroll
        for (int ai = 0; ai < 2; ++ai)
#pragma unroll
            for (int m = 0; m < 4; ++m) {
                const int row = row0 + ai * HALF + m * 16;
#pragma unroll
                for (int bj = 0; bj < 2; ++bj) {
                    const size_t off = (size_t)row * ldg + col0 + bj * HALF;
                    const u32x4 a = *(const u32x4*)(GM + off), b = *(const u32x4*)(GA + off);
                    f32x4& v0 = acc[ai][bj][m][0]; f32x4& v1 = acc[ai][bj][m][1];
#define RQ(x, y) ((x) * __builtin_amdgcn_rcpf(fmaxf((y), 1e-30f)))
                    v0[0] *= RQ(bf_lo(a.x), bf_lo(b.x)); v0[1] *= RQ(bf_hi(a.x), bf_hi(b.x)); v0[2] *= RQ(bf_lo(a.y), bf_lo(b.y)); v0[3] *= RQ(bf_hi(a.y), bf_hi(b.y));
                    v1[0] *= RQ(bf_lo(a.z), bf_lo(b.z)); v1[1] *= RQ(bf_hi(a.z), bf_hi(b.z)); v1[2] *= RQ(bf_lo(a.w), bf_lo(b.w)); v1[3] *= RQ(bf_hi(a.w), bf_hi(b.w));
#undef RQ
                }
                if (m == 3) asm volatile("" ::: "memory");
            }
    }
    __device__ __forceinline__ void operator()(const f32x4 (&acc)[2][2][4][2], const Unit& u, int wr, int wc, int fr, int fq) const {
        const int row0 = u.pm * BM + wr * 64 + fr, col0 = u.pn * BM + wc * 32 + 8 * fq;
#pragma unroll
        for (int ai = 0; ai < 2; ++ai)
#pragma unroll
            for (int m = 0; m < 4; ++m) {
                const int row = row0 + ai * HALF + m * 16;
#pragma unroll
                for (int bj = 0; bj < 2; ++bj) {
                    const int col = col0 + bj * HALF;
                    const u32x4 g = *(const u32x4*)(GA + (size_t)row * ldg + col);
                    const f32x4 v0 = acc[ai][bj][m][0], v1 = acc[ai][bj][m][1];
                    f32x4 o0, o1;
                    o0[0] = bf_lo(g.x) * v0[0]; o0[1] = bf_hi(g.x) * v0[1]; o0[2] = bf_lo(g.y) * v0[2]; o0[3] = bf_hi(g.y) * v0[3];
                    o1[0] = bf_lo(g.z) * v1[0]; o1[1] = bf_hi(g.z) * v1[1]; o1[2] = bf_lo(g.w) * v1[2]; o1[3] = bf_hi(g.w) * v1[3];
                    *(u32x4*)(Y + (size_t)row * ldy + col) = pack8f(o0, o1);
                }
                if (m == 3) asm volatile("" ::: "memory");
            }
    }
};
struct EpiRes {
    static constexpr bool PERM = false;
    const float* res; float* out; int ldc;
    __device__ __forceinline__ void operator()(const f32x4 (&acc)[2][2][4][2], const Unit& u, int wr, int wc, int fr, int fq) const {
        const int row0 = u.pm * BM + wr * 64 + fr, col0 = u.pn * BM + wc * 32 + 4 * fq;
#pragma unroll
        for (int ai = 0; ai < 2; ++ai)
#pragma unroll
            for (int m = 0; m < 4; ++m) {
                const size_t off = (size_t)(row0 + ai * HALF + m * 16) * ldc + col0;
#pragma unroll
                for (int bj = 0; bj < 2; ++bj)
#pragma unroll
                    for (int n = 0; n < 2; ++n) { const f32x4 r = *(const f32x4*)(res + off + bj * HALF + n * 16); *(f32x4*)(out + off + bj * HALF + n * 16) = r + acc[ai][bj][m][n]; }
            }
    }
};
struct EpiSwiglu {
    static constexpr bool PERM = true;
    bf16_t* H; int ldh;
    __device__ __forceinline__ void operator()(const f32x4 (&acc)[2][2][4][2], const Unit& u, int wr, int wc, int fr, int fq) const {
        const int row0 = u.pm * BM + wr * 64 + fr, col0 = u.pn * HALF + wc * 32 + 8 * fq;
#pragma unroll
        for (int ai = 0; ai < 2; ++ai)
#pragma unroll
            for (int m = 0; m < 4; ++m) {
                const int row = row0 + ai * HALF + m * 16;
                f32x4 o0, o1;
#pragma unroll
                for (int e = 0; e < 4; ++e) { const float g0 = acc[ai][0][m][0][e], g1 = acc[ai][0][m][1][e];
                    o0[e] = g0 * sigm(g0) * acc[ai][1][m][0][e]; o1[e] = g1 * sigm(g1) * acc[ai][1][m][1][e]; }
                *(u32x4*)(H + (size_t)row * ldh + col0) = pack8f(o0, o1);
            }
    }
};

template <class Epi, bool ALIGN_EPI, int HOOKT = 0>
__device__ __forceinline__ void gemm_phase(PG8_LAS unsigned char* lds, const Gemm g, const StaticOrder& S, const Epi& E, const int tid) {
    const int wid = __builtin_amdgcn_readfirstlane(tid >> 6), lane = tid & 63, wr = wid >> 2, wc = wid & 3, fr = lane & 15, fq = lane >> 4;
    const int K = g.K, nt = K / BK, lda = g.lda;
    unsigned voffA[2], voffB[2];
#pragma unroll
    for (int i = 0; i < 2; ++i) { int R, C; stage_rc(tid * 16 + i * 8192, R, C); const int Rb = Epi::PERM ? ((R & ~31) + perm32(R & 31)) : R;
        voffA[i] = (unsigned)(R * lda + C) * 2u; voffB[i] = (unsigned)(Rb * K + C) * 2u; }
    const size_t kstep = (size_t)(BK * 2);
    const size_t hstepA = (size_t)HALF * lda * 2, hstepB = (size_t)HALF * K * 2;
    const size_t tstepA = 2 * hstepA, tstepB = 2 * hstepB;
    const unsigned ldsw = (unsigned)wid * 1024u;
    const int aoff = lds_byte(wr * 64 + fr, fq * 8), boff = lds_byte(wc * 32 + fr, fq * 8);
#define PG8_SA(b, h) (((b) * 2 + (h)) * HTB)
#define PG8_SB(b, h) ((4 + (b) * 2 + (h)) * HTB)
#define PG8_STAGE(bufoff, gbase, voff) do { _Pragma("unroll") for (int _i = 0; _i < 2; ++_i) \
        __builtin_amdgcn_global_load_lds((const unsigned*)((const char*)(gbase) + (voff)[_i]), (PG8_LAS unsigned*)(lds + (bufoff) + ldsw + _i * 8192), 16, 0, 0); } while (0)
#define PG8_LDA(dst, b, h) do { _Pragma("unroll") for (int m = 0; m < 4; ++m) _Pragma("unroll") for (int k = 0; k < 2; ++k) dst[m][k] = *(const PG8_LAS bf16x8*)(lds + PG8_SA(b, h) + aoff + m * 2048 + k * 1024); } while (0)
#define PG8_LDB(dst, b, h) do { _Pragma("unroll") for (int n = 0; n < 2; ++n) _Pragma("unroll") for (int k = 0; k < 2; ++k) dst[n][k] = *(const PG8_LAS bf16x8*)(lds + PG8_SB(b, h) + boff + n * 2048 + k * 1024); } while (0)
#define PG8_MMA(ai, bj, At, Bt) do { __builtin_amdgcn_s_setprio(1); _Pragma("unroll") for (int m = 0; m < 4; ++m) _Pragma("unroll") for (int n = 0; n < 2; ++n) _Pragma("unroll") for (int k = 0; k < 2; ++k) \
        acc[ai][bj][m][n] = __builtin_amdgcn_mfma_f32_16x16x32_bf16(Bt[n][k], At[m][k], acc[ai][bj][m][n], 0, 0, 0); __builtin_amdgcn_s_setprio(0); } while (0)
#define PG8_WAIT_V(n) asm volatile("s_waitcnt vmcnt(" #n ")" ::: "memory")
#define PG8_WAIT_L(n) asm volatile("s_waitcnt lgkmcnt(" #n ")" ::: "memory")
#define PG8_BAR __builtin_amdgcn_s_barrier()
#define PG8_SCHED __builtin_amdgcn_sched_barrier(0)
    Unit cur, nxt; int ui = 0;
    if (!S.next(0, cur)) return;
    f32x4 acc[2][2][4][2];
#pragma unroll
    for (int a = 0; a < 2; ++a)
#pragma unroll
        for (int b = 0; b < 2; ++b)
#pragma unroll
            for (int m = 0; m < 4; ++m)
#pragma unroll
                for (int n = 0; n < 2; ++n) acc[a][b][m][n] = (f32x4){0.f, 0.f, 0.f, 0.f};
    bf16x8 At[4][2], B0[2][2], B1[2][2];
    const char* cA = (const char*)g.A + (size_t)cur.pm * tstepA; const char* cB = (const char*)g.Bt + (size_t)cur.pn * tstepB;
    PG8_STAGE(PG8_SB(0, 0), cB, voffB); PG8_STAGE(PG8_SB(0, 1), cB + hstepB, voffB); PG8_STAGE(PG8_SA(0, 0), cA, voffA); PG8_STAGE(PG8_SA(0, 1), cA + hstepA, voffA);
    if (wr == 1) PG8_BAR;
    PG8_WAIT_V(2); PG8_BAR;
    PG8_STAGE(PG8_SB(1, 0), cB + kstep, voffB); PG8_STAGE(PG8_SA(1, 0), cA + kstep, voffA); PG8_STAGE(PG8_SB(1, 1), cB + hstepB + kstep, voffB);
    PG8_WAIT_V(6); PG8_BAR;
    for (;;) {
        const bool has_next = S.next(ui + 1, nxt);
        const char* nA = has_next ? (const char*)g.A + (size_t)nxt.pm * tstepA : cA; const char* nB = has_next ? (const char*)g.Bt + (size_t)nxt.pn * tstepB : cB;
        for (int t = 0; t < nt; t += 2) {
            if constexpr (HOOKT > 0) { if (t == HOOKT) { E.hook(acc, cur, wr, wc, fr, fq); PG8_SCHED; } }
            const bool last = (t == nt - 2);
            const char* a1 = cA + (size_t)(t + 1) * kstep;
            const char* a2 = last ? nA : cA + (size_t)(t + 2) * kstep; const char* b2 = last ? nB : cB + (size_t)(t + 2) * kstep;
            const char* a3 = a2 + kstep; const char* b3 = b2 + kstep;
            PG8_LDB(B0, 0, 0); PG8_LDB(B1, 0, 1); PG8_SCHED; PG8_LDA(At, 0, 0); PG8_STAGE(PG8_SA(1, 1), a1 + hstepA, voffA);
            PG8_WAIT_V(8); PG8_WAIT_L(0); PG8_BAR; PG8_MMA(0, 0, At, B0); PG8_MMA(0, 1, At, B1); PG8_BAR; PG8_SCHED;
            PG8_LDA(At, 0, 1); PG8_STAGE(PG8_SB(0, 0), b2, voffB); PG8_STAGE(PG8_SB(0, 1), b2 + hstepB, voffB); PG8_STAGE(PG8_SA(0, 0), a2, voffA);
            PG8_WAIT_V(8); PG8_WAIT_L(0); PG8_BAR; PG8_MMA(1, 0, At, B0); PG8_MMA(1, 1, At, B1); PG8_BAR; PG8_SCHED;
            PG8_LDB(B0, 1, 0); PG8_LDB(B1, 1, 1); PG8_SCHED; PG8_LDA(At, 1, 0); PG8_STAGE(PG8_SA(0, 1), a2 + hstepA, voffA);
            PG8_WAIT_V(8); PG8_WAIT_L(0); PG8_BAR; PG8_MMA(0, 0, At, B0); PG8_MMA(0, 1, At, B1); PG8_BAR; PG8_SCHED;
            PG8_LDA(At, 1, 1); PG8_STAGE(PG8_SB(1, 0), b3, voffB); PG8_STAGE(PG8_SB(1, 1), b3 + hstepB, voffB); PG8_STAGE(PG8_SA(1, 0), a3, voffA);
            PG8_WAIT_V(8); PG8_WAIT_L(0); PG8_BAR; PG8_MMA(1, 0, At, B0); PG8_MMA(1, 1, At, B1); PG8_BAR; PG8_SCHED;
        }
        if constexpr (ALIGN_EPI) { if (wr == 0) PG8_BAR; }
        E(acc, cur, wr, wc, fr, fq);
        if (!has_next) break;
#pragma unroll
        for (int a = 0; a < 2; ++a)
#pragma unroll
            for (int b = 0; b < 2; ++b)
#pragma unroll
                for (int m = 0; m < 4; ++m)
#pragma unroll
                    for (int n = 0; n < 2; ++n) acc[a][b][m][n] = (f32x4){0.f, 0.f, 0.f, 0.f};
        cur = nxt; cA = nA; cB = nB; ++ui;
        if constexpr (ALIGN_EPI) { if (wr == 1) PG8_BAR; }
    }
    PG8_WAIT_V(0);
    if constexpr (!ALIGN_EPI) { if (wr == 0) PG8_BAR; }
    PG8_BAR;
#undef PG8_SA
#undef PG8_SB
#undef PG8_STAGE
#undef PG8_LDA
#undef PG8_LDB
#undef PG8_MMA
#undef PG8_WAIT_V
#undef PG8_WAIT_L
#undef PG8_BAR
#undef PG8_SCHED
}
}
namespace att {
typedef unsigned short bf16;
typedef short bf16x8 __attribute__((ext_vector_type(8)));
typedef short s16x4 __attribute__((ext_vector_type(4)));
typedef float f32x16 __attribute__((ext_vector_type(16)));
typedef float f32x4 __attribute__((ext_vector_type(4)));
typedef unsigned u32x4 __attribute__((ext_vector_type(4)));
constexpr int D = 128;
constexpr float SCALE = 0.08838834764831845f;
constexpr float THR = 8.f;
constexpr int NW = 8, QBLK = 32, KVBLK = 64, QB = NW * QBLK;
constexpr int SHM_V = KVBLK * D * 2, SHM_K = KVBLK * D * 2;
constexpr int LDS_BYTES = 2 * SHM_V + 2 * SHM_K + NW * 64 * 4;
constexpr int LDS_QIMG = LDS_BYTES + 32, LDS_TOTAL = LDS_QIMG + NW * 8192;

#define KSWZ(row, colB) ((row) * 256 + ((colB) ^ (((row) & 7) << 4)))
#define SBAR() __builtin_amdgcn_sched_barrier(0)
__device__ __forceinline__ int v_st(int k, int c) { const int kk = (k & ~0xC) | ((k & 4) << 1) | ((k & 8) >> 1); return ((kk >> 3) * 4 + (c >> 5)) * 512 + ((kk & 7) * 32 + (c & 31)) * 2; }
__device__ __forceinline__ int v_rd_base(int lane) { return ((lane & 3) << 3) | (((lane >> 2) & 3) << 6) | (((lane >> 4) & 1) << 5) | (((lane >> 5) & 1) << 8); }
constexpr int v_rd_off(int d0, int ks, int half) { return d0 * 512 + ks * 4096 + half * 2048; }
__device__ __forceinline__ int crow(int r, int hi) { return (r & 3) + 8 * (r >> 2) + 4 * hi; }
__device__ __forceinline__ unsigned cvtpk(float lo, float hi) { unsigned r; asm volatile("v_cvt_pk_bf16_f32 %0, %1, %2" : "=v"(r) : "v"(lo), "v"(hi)); return r; }
__device__ __forceinline__ bf16x8 load8(const bf16* p) { return *reinterpret_cast<const bf16x8*>(p); }
template <bool ZERO>
__device__ __forceinline__ void mask_tile(f32x16& p0, f32x16& p1, int dq) {
    const float NEG = ZERO ? 0.f : -__builtin_inff();
#pragma unroll
    for (int r = 0; r < 16; ++r) {
        const int c = (r & 3) + 8 * (r >> 2);
        if (dq - c < 0) p0[r] = NEG;
        if (dq - c - 32 < 0) p1[r] = NEG;
    }
}
__device__ __forceinline__ void partialSM(f32x16& p0, f32x16& p1, float& m_reg, float& mn, float& alpha) {
    float pmax = p0[0]; for (int r = 1; r < 16; ++r) pmax = fmaxf(pmax, p0[r]); for (int r = 0; r < 16; ++r) pmax = fmaxf(pmax, p1[r]);
    { auto rr = __builtin_amdgcn_permlane32_swap(__float_as_uint(pmax), __float_as_uint(pmax), false, false);
      pmax = fmaxf(__uint_as_float(rr[0]), __uint_as_float(rr[1])); }
    constexpr float C2 = 1.4426950408889634f * SCALE;
    if (__builtin_expect(__all((pmax - m_reg) * SCALE <= THR), 1)) { mn = m_reg; alpha = 1.f; }
    else { mn = fmaxf(m_reg, pmax); alpha = __builtin_amdgcn_exp2f((m_reg - mn) * C2); m_reg = mn; }
    const float mnL = -mn * C2;
    for (int r = 0; r < 16; ++r) p0[r] = fmaf(p0[r], C2, mnL); for (int r = 0; r < 16; ++r) p1[r] = fmaf(p1[r], C2, mnL);
    for (int r = 0; r < 16; ++r) p0[r] = __builtin_amdgcn_exp2f(p0[r]);
}
#define ATT_PK4(P, B_, OUT) do { unsigned a0 = cvtpk(P[B_+0], P[B_+1]), a1 = cvtpk(P[B_+2], P[B_+3]);                          \
        unsigned b0 = cvtpk(P[B_+4], P[B_+5]), b1 = cvtpk(P[B_+6], P[B_+7]);                                             \
        auto r0 = __builtin_amdgcn_permlane32_swap(a0, b0, false, false); auto r1 = __builtin_amdgcn_permlane32_swap(a1, b1, false, false); \
        u32x4 w = {r0[0], r1[0], r0[1], r1[1]}; OUT = *reinterpret_cast<bf16x8*>(&w); } while (0)
__device__ __forceinline__ void finishSM(f32x16& p0, f32x16& p1, float alpha, float& l_reg, bf16x8& pa0, bf16x8& pa1, bf16x8& pa2, bf16x8& pa3) {
    for (int r = 0; r < 16; ++r) p1[r] = __builtin_amdgcn_exp2f(p1[r]);
    float ps = 0; for (int r = 0; r < 16; ++r) ps += p0[r]; for (int r = 0; r < 16; ++r) ps += p1[r];
    { auto rr = __builtin_amdgcn_permlane32_swap(__float_as_uint(ps), __float_as_uint(ps), false, false);
      ps = __uint_as_float(rr[0]) + __uint_as_float(rr[1]); }
    l_reg = l_reg * alpha + ps;
    ATT_PK4(p0, 0, pa0); ATT_PK4(p0, 8, pa1); ATT_PK4(p1, 0, pa2); ATT_PK4(p1, 8, pa3);
}
__device__ __forceinline__ void partialLin(f32x16& p0, f32x16& p1, float f) {
    for (int r = 0; r < 16; ++r) { p0[r] *= f; p1[r] *= f; }
}
__device__ __forceinline__ void finishLin(f32x16& p0, f32x16& p1, float& den, bf16x8& pa0, bf16x8& pa1, bf16x8& pa2, bf16x8& pa3) {
    float ps = 0; for (int r = 0; r < 16; ++r) ps += p0[r]; for (int r = 0; r < 16; ++r) ps += p1[r];
    den += ps;
    ATT_PK4(p0, 0, pa0); ATT_PK4(p0, 8, pa1); ATT_PK4(p1, 0, pa2); ATT_PK4(p1, 8, pa3);
}
template <int KB, bool QL>
__device__ __forceinline__ void qkt(f32x16& p0, f32x16& p1, const char* K_lds, int r32, int hi, const bf16x8* qr, const char* qlds) {
    p0 = f32x16{}; p1 = f32x16{};
    const char* kb[4];
#pragma unroll
    for (int dd = 0; dd < 4; ++dd) kb[dd] = K_lds + KB * SHM_K + KSWZ(r32, (dd * 16 + hi * 8) * 2);
#pragma unroll
    for (int d0 = 0; d0 < 8; ++d0) { const char* a = kb[d0 & 3] + (d0 >> 2) * 128;
        bf16x8 b0 = *reinterpret_cast<const bf16x8*>(a);
        bf16x8 b1 = *reinterpret_cast<const bf16x8*>(a + 32 * 256);
        bf16x8 qf; if constexpr (QL) qf = *reinterpret_cast<const bf16x8*>(qlds + d0 * 1024); else qf = qr[d0];
        p0 = __builtin_amdgcn_mfma_f32_32x32x16_bf16(b0, qf, p0, 0, 0, 0);
        p1 = __builtin_amdgcn_mfma_f32_32x32x16_bf16(b1, qf, p1, 0, 0, 0); }
}
template <int VB>
__device__ __forceinline__ void pv_tile(f32x16* o, int vb0, bf16x8 pa0, bf16x8 pa1, bf16x8 pa2, bf16x8 pa3) {
#define TRRD(dst, off) asm volatile("ds_read_b64_tr_b16 %0, %1 offset:%2" : "=&v"(dst) : "v"(vb0), "i"(off) : "memory")
#define PV_D0(d0) do { s16x4 l0, l1, l2, l3, h0, h1, h2, h3; constexpr int b_ = VB * SHM_V + v_rd_off(d0, 0, 0); \
        TRRD(l0, b_); TRRD(h0, b_ + 2048); TRRD(l1, b_ + 4096); TRRD(h1, b_ + 6144); TRRD(l2, b_ + 8192); TRRD(h2, b_ + 10240); TRRD(l3, b_ + 12288); TRRD(h3, b_ + 14336); \
        asm volatile("s_waitcnt lgkmcnt(0)" ::: "memory"); SBAR();   \
        o[d0] = __builtin_amdgcn_mfma_f32_32x32x16_bf16(pa0, (bf16x8){l0[0], l0[1], l0[2], l0[3], h0[0], h0[1], h0[2], h0[3]}, o[d0], 0, 0, 0);   \
        o[d0] = __builtin_amdgcn_mfma_f32_32x32x16_bf16(pa1, (bf16x8){l1[0], l1[1], l1[2], l1[3], h1[0], h1[1], h1[2], h1[3]}, o[d0], 0, 0, 0);   \
        o[d0] = __builtin_amdgcn_mfma_f32_32x32x16_bf16(pa2, (bf16x8){l2[0], l2[1], l2[2], l2[3], h2[0], h2[1], h2[2], h2[3]}, o[d0], 0, 0, 0);   \
        o[d0] = __builtin_amdgcn_mfma_f32_32x32x16_bf16(pa3, (bf16x8){l3[0], l3[1], l3[2], l3[3], h3[0], h3[1], h3[2], h3[3]}, o[d0], 0, 0, 0); } while (0)
    PV_D0(0); PV_D0(1); PV_D0(2); PV_D0(3);
#undef PV_D0
#undef TRRD
}

struct BlockRef { const bf16* Q; const bf16* K; const bf16* V; float* O; int P0; };
struct LinRef { const float* MT; const float* EMT; const float* REF; };
struct Seam { bf16x8 qr[8]; bf16x8 st_v0, st_v1, st_k0, st_k1; };

#define ATT_VMW() asm volatile("s_waitcnt vmcnt(0)" ::: "memory")
#define ATT_VMWN(n) asm volatile("s_waitcnt vmcnt(%0)" :: "i"(n) : "memory")
__device__ __forceinline__ bf16x8 load8o(const bf16* base, unsigned voff) { return *reinterpret_cast<const bf16x8*>(reinterpret_cast<const char*>(base) + voff); }
template <class T> __device__ __forceinline__ T* uni(T* p) {
    const unsigned long long u = (unsigned long long)p; const unsigned lo = __builtin_amdgcn_readfirstlane((unsigned)u), hi = __builtin_amdgcn_readfirstlane((unsigned)(u >> 32));
    return (T*)(((unsigned long long)hi << 32) | lo); }
#define ATT_SLOAD(Kp, Vp, k0) do { const bf16* vb_ = uni((Vp) + (size_t)(k0) * LDV); const bf16* kb_ = uni((Kp) + (size_t)(k0) * LDK);                                         \
                                   S.st_v0 = load8o(vb_, offV); S.st_v1 = load8o(vb_, offV + 32u * LDV * 2u);              \
                                   S.st_k0 = load8o(kb_, offK); S.st_k1 = load8o(kb_, offK + 32u * LDK * 2u); } while (0)
#define ATT_SWRITE_K(bf) do { *(bf16x8*)(K_lds + (bf) * SHM_K + kws) = S.st_k0; *(bf16x8*)(K_lds + (bf) * SHM_K + kws + 32 * 256) = S.st_k1; } while (0)
#define ATT_SWRITE_V(bf) do { *(bf16x8*)(V_lds + (bf) * SHM_V + vst0) = S.st_v0; *(bf16x8*)(V_lds + (bf) * SHM_V + vst1) = S.st_v1; } while (0)

template <int LDQ, int LDK, int LDV>
__device__ __forceinline__ void prime(const BlockRef& cur, char* lds, Seam& S, const int tid) {
    const int wid = __builtin_amdgcn_readfirstlane(tid >> 6), lane = tid & 63, r32 = lane & 31, hi = lane >> 5;
    const int sr = tid >> 4, sc = (tid & 15) * 8, kws = KSWZ(sr, sc * 2); char* K_lds = lds + 2 * SHM_V;
    const unsigned offV = (unsigned)(sr * LDV + sc) * 2u, offK = (unsigned)(sr * LDK + sc) * 2u, offQ = (unsigned)(r32 * LDQ + hi * 8) * 2u;
    { const bf16* qb_ = uni(cur.Q + (size_t)(wid * QBLK) * LDQ);
#pragma unroll
    for (int d0 = 0; d0 < 8; ++d0) S.qr[d0] = load8o(qb_, offQ + d0 * 32u); }
    ATT_SLOAD(cur.K, cur.V, 0); ATT_VMW(); ATT_SWRITE_K(0);
    __syncthreads();
}

__device__ __forceinline__ void put_next(char* lds, const BlockRef& nxt, const int tid) {
    if (tid == 0) { volatile unsigned long long* p = (volatile unsigned long long*)(lds + LDS_BYTES); p[0] = (unsigned long long)nxt.Q; p[1] = (unsigned long long)nxt.K; p[2] = (unsigned long long)nxt.V; }
}
__device__ __forceinline__ const bf16* get_next(char* lds, int k) {
    const volatile unsigned* p = (const volatile unsigned*)(lds + LDS_BYTES) + 2 * k; const unsigned lo = p[0], hi = p[1];
    return (const bf16*)(((unsigned long long)(unsigned)__builtin_amdgcn_readfirstlane(hi) << 32) | (unsigned)__builtin_amdgcn_readfirstlane(lo));
}
template <int LDQ, int LDK, int LDV, int LDO, int MODE>
__device__ __forceinline__ void block(const BlockRef& cur, char* lds, Seam& S, float lam, const LinRef& lr, const int tid) {
    constexpr bool LIN = (MODE == 2);
    const int wid = __builtin_amdgcn_readfirstlane(tid >> 6), lane = tid & 63, r32 = lane & 31, hi = lane >> 5;
    const int NT = cur.P0 / KVBLK + QB / KVBLK;
    const int qlo = cur.P0 + wid * QBLK, qm = qlo + r32 - 4 * hi;
    char* V_lds = lds; char* K_lds = lds + 2 * SHM_V;
    float* ws = (float*)(lds + 2 * SHM_V + 2 * SHM_K) + wid * 64; float* li_l = ws, * al_l = ws + 32;
    float m_reg = -1e30f, l_reg = 0; f32x16 o[4] = {};
    const int sr = tid >> 4, sc = (tid & 15) * 8, vst0 = v_st(sr, sc), vst1 = v_st(32 + sr, sc), kws = KSWZ(sr, sc * 2);
    const int vb0 = (int)(uintptr_t)V_lds + v_rd_base(lane);
    const bf16* Kh = cur.K; const bf16* Vh = cur.V;
    const unsigned offV = (unsigned)(sr * LDV + sc) * 2u, offK = (unsigned)(sr * LDK + sc) * 2u, offQ = (unsigned)(r32 * LDQ + hi * 8) * 2u;
    float Mt = 0.f; if constexpr (LIN) Mt = *reinterpret_cast<const float*>(reinterpret_cast<const char*>(uni(lr.MT + qlo)) + (unsigned)r32 * 4u);
#define ATT_RESC(a) do { if constexpr (!LIN) { if (__any((a) < 1.f)) { if (hi == 0) al_l[r32] = (a); asm volatile("s_waitcnt lgkmcnt(0)" ::: "memory");              \
                     for (int d_ = 0; d_ < 4; ++d_) for (int r = 0; r < 16; ++r) o[d_][r] *= al_l[crow(r, hi)]; } } } while (0)
#define ATT_KBASE(t) ((t) * KVBLK)
#define ATT_MASKT(P0_, P1_, t) do { const int kb_ = ATT_KBASE(t); if (kb_ + KVBLK - 1 > qlo) mask_tile<LIN>(P0_, P1_, qm - kb_); } while (0)
#define ATT_PSM(P0_, P1_, mnX, alX, t) do { if constexpr (LIN) { mnX = __builtin_amdgcn_exp2f((lr.REF[t] - Mt) * 1.4426950408889634f); } \
                                            else partialSM(P0_, P1_, m_reg, mnX, alX); } while (0)
#define ATT_FSM(P0_, P1_, alY, mnY) do { if constexpr (LIN) { partialLin(P0_, P1_, mnY); finishLin(P0_, P1_, l_reg, pa0, pa1, pa2, pa3); } else finishSM(P0_, P1_, alY, l_reg, pa0, pa1, pa2, pa3); } while (0)
#define ATT_SEAM_K0() do { ATT_VMW(); ATT_SWRITE_K(0); SBAR(); } while (0)
    f32x16 pA0, pA1, pB0, pB1; float mnA = 0.f, mnB = 0.f, alA = 1.f, alB = 1.f; bf16x8 pa0, pa1, pa2, pa3;
    ATT_SWRITE_V(0); SBAR();
    const char* qlds = lds + LDS_QIMG + wid * 8192 + lane * 16;
    if constexpr (LIN) {
#pragma unroll
        for (int d0 = 0; d0 < 8; ++d0) *reinterpret_cast<bf16x8*>(const_cast<char*>(qlds) + d0 * 1024) = S.qr[d0];
    }
    if (NT > 1) ATT_SLOAD(Kh, Vh, ATT_KBASE(1));
    SBAR(); qkt<0, LIN>(pA0, pA1, K_lds, r32, hi, S.qr, qlds);
    ATT_MASKT(pA0, pA1, 0); ATT_PSM(pA0, pA1, mnA, alA, 0);
    if (NT > 1) { ATT_VMW(); ATT_SWRITE_V(1); ATT_SWRITE_K(1); }
    __syncthreads();
#define ATT_HALF_STEP(PX0, PX1, mnX, alX, PY0, PY1, alY, mnY, t, KB, VB, SB) do {                                                      \
        SBAR(); qkt<KB, LIN>(PX0, PX1, K_lds, r32, hi, S.qr, qlds);                                             \
        ATT_FSM(PY0, PY1, alY, mnY); SBAR();                                                           \
        if ((t) + 1 < NT) { ATT_SLOAD(Kh, Vh, ATT_KBASE((t) + 1)); SBAR(); }                                               \
        pv_tile<VB>(o, vb0, pa0, pa1, pa2, pa3); ATT_MASKT(PX0, PX1, (t)); ATT_PSM(PX0, PX1, mnX, alX, (t));                                        \
        __syncthreads();                                                                                                      \
        if ((t) + 1 < NT) { ATT_VMW(); ATT_SWRITE_V(SB); ATT_SWRITE_K(SB); }                                                                          \
        ATT_RESC(alX); __syncthreads(); } while (0)
    for (int t = 1; t + 1 < NT; t += 2) {
        ATT_HALF_STEP(pB0, pB1, mnB, alB, pA0, pA1, alA, mnA, t, 1, 0, 0);
        ATT_HALF_STEP(pA0, pA1, mnA, alA, pB0, pB1, alB, mnB, t + 1, 0, 1, 1);
    }
    SBAR(); qkt<1, LIN>(pB0, pB1, K_lds, r32, hi, S.qr, qlds); SBAR();
    { const bf16* nK = get_next(lds, 1); const bf16* nV = get_next(lds, 2); ATT_SLOAD(nK, nV, 0); } SBAR();
    ATT_FSM(pA0, pA1, alA, mnA); SBAR();
    pv_tile<0>(o, vb0, pa0, pa1, pa2, pa3);
    ATT_MASKT(pB0, pB1, NT - 1); ATT_PSM(pB0, pB1, mnB, alB, NT - 1); __syncthreads(); ATT_RESC(alB);
    ATT_FSM(pB0, pB1, alB, mnB); SBAR(); pv_tile<1>(o, vb0, pa0, pa1, pa2, pa3);
    SBAR(); ATT_SEAM_K0();
    { const bf16* qb_ = uni(get_next(lds, 0) + (size_t)(wid * QBLK) * LDQ);
#pragma unroll
    for (int d0 = 0; d0 < 8; ++d0) S.qr[d0] = load8o(qb_, offQ + d0 * 32u); }
    SBAR();
    if constexpr (LIN) { auto rr = __builtin_amdgcn_permlane32_swap(__float_as_uint(l_reg), __float_as_uint(l_reg), false, false); l_reg = __uint_as_float(rr[0]) + __uint_as_float(rr[1]); }
    if (hi == 0) li_l[r32] = l_reg; asm volatile("s_waitcnt lgkmcnt(0)" ::: "memory");
    float rli[16];
    const float* emtp = LIN ? reinterpret_cast<const float*>(reinterpret_cast<const char*>(uni(lr.EMT + (cur.P0 + wid * QBLK))) + (unsigned)hi * 16u) : nullptr;
#pragma unroll
    for (int r = 0; r < 16; ++r) {
        const float lv = li_l[crow(r, hi)];
        if constexpr (LIN) { const float em = emtp[(r & 3) + 8 * (r >> 2)]; rli[r] = __builtin_amdgcn_rcpf(fmaxf(fabsf(lv), em)); }
        else rli[r] = __builtin_amdgcn_rcpf(lv);
    }
    char* Ow = reinterpret_cast<char*>(uni(cur.O + (size_t)(wid * QBLK) * LDO));
    const unsigned offO = (unsigned)(4 * hi * LDO + r32) * 4u;
#pragma unroll
    for (int r = 0; r < 16; ++r) {
#pragma unroll
        for (int d0 = 0; d0 < 4; ++d0) { const float v = o[d0][r] * rli[r];
            float* p = reinterpret_cast<float*>(Ow + (offO + (unsigned)((((r & 3) + 8 * (r >> 2)) * LDO + d0 * 32) * 4)));
            if constexpr (MODE == 1) { const float prev = *p; *p = prev - lam * v; }
            else *p = v; } }
    __syncthreads();
#undef ATT_RESC
#undef ATT_KBASE
#undef ATT_MASKT
#undef ATT_PSM
#undef ATT_FSM
#undef ATT_SEAM_K0
#undef ATT_HALF_STEP
}
#undef ATT_VMW
#undef ATT_VMWN
#undef ATT_SLOAD
#undef ATT_SWRITE_K
#undef ATT_SWRITE_V
#undef ATT_PK4
#undef KSWZ
#undef SBAR
}
constexpr int NWAVES = 8;
constexpr int DM = 2048, NB = 8, SEQ = 4096, DEPTH = 4, M = NB * SEQ;
constexpr int DIN = 13320, NP = 13312, DFF = 5632, NGU = 2 * DFF;
constexpr int KMRG = 3072;
constexpr int C_MQK = 0, C_MV = 1024, C_MO = 2048, C_AQ = 3072, C_AK = 5120, C_AV = 7168, C_GM = 9216, C_GA = 11264;
constexpr float EPS = 1e-6f;
#ifndef DBG
#define DBG 0
#endif

constexpr size_t MiB = 1u << 20;
constexpr size_t WS_CTL = 0, CTL_ZERO_BYTES = 1 * MiB;
constexpr size_t WS_ROPE = 2 * MiB;
constexpr size_t WS_LIF = 6 * MiB;
constexpr size_t WS_MT = 7 * MiB;
constexpr size_t WS_EMT = WS_MT + 512 * 1024;
constexpr size_t WS_KSC = 8 * MiB;
constexpr size_t WS_REF = WS_KSC + 512 * 1024;
constexpr size_t WS_WIN = 16 * MiB, WS_PM = 68 * MiB, WS_PA = 72 * MiB, WS_WO = 80 * MiB, WS_WGU = 88 * MiB, WS_WD = 132 * MiB;
constexpr size_t WS_HY = 154 * MiB;
constexpr size_t WS_QKM = 282 * MiB;
constexpr size_t WS_HT = 346 * MiB;
constexpr size_t WS_OST = 474 * MiB;
constexpr size_t WS_PROJ = 730 * MiB;
constexpr size_t WS_END = 1562 * MiB;
static_assert(WS_PROJ + (size_t)M * NP * 2 == WS_END, "ws map");
constexpr int CW_BAR = 4096;

constexpr int RING_OFF = 0, RING_BYTES = 135168;
constexpr int LDSCTL_OFF = RING_BYTES, MISC_OFF = LDSCTL_OFF + 320;
constexpr int LDS_BYTES = 147456;

#define GAS __attribute__((address_space(1)))
#define LAS __attribute__((address_space(3)))
typedef unsigned short bf16;
typedef unsigned v4u __attribute__((ext_vector_type(4)));
typedef unsigned v2u __attribute__((ext_vector_type(2)));
typedef float f32x4 __attribute__((ext_vector_type(4)));
typedef GAS unsigned gu32;
#define LDS_WAIT() asm volatile("s_waitcnt lgkmcnt(0)" ::: "memory")
#define VM_WAIT() asm volatile("s_waitcnt vmcnt(0)" ::: "memory")
__device__ __forceinline__ unsigned f2bf(float f) { unsigned u = __builtin_bit_cast(unsigned, f); return (u + 0x7fffu + ((u >> 16) & 1u)) >> 16; }
__device__ __forceinline__ unsigned pk2(float lo, float hi) { return f2bf(lo) | (f2bf(hi) << 16); }
__device__ __forceinline__ float bflo(unsigned u) { return __uint_as_float(u << 16); }
__device__ __forceinline__ float bfhi(unsigned u) { return __uint_as_float(u & 0xffff0000u); }
__device__ __forceinline__ float bf2f(bf16 h) { return __uint_as_float((unsigned)h << 16); }
#define SWZ_XOR(v, o) __uint_as_float((unsigned)__builtin_amdgcn_ds_swizzle((int)__float_as_uint(v), ((o) << 10) | 0x1f))
__device__ __forceinline__ float xhalf(float v, bool is_max) { auto rr = __builtin_amdgcn_permlane32_swap(__float_as_uint(v), __float_as_uint(v), false, false);
    const float a = __uint_as_float(rr[0]), b = __uint_as_float(rr[1]); return is_max ? fmaxf(a, b) : a + b; }
__device__ __forceinline__ float wave_sum(float v) {
    v += SWZ_XOR(v, 1); v += SWZ_XOR(v, 2); v += SWZ_XOR(v, 4); v += SWZ_XOR(v, 8); v += SWZ_XOR(v, 16);
    return xhalf(v, false);
}
__device__ __forceinline__ float shfl_up_l(float v, int o, int lane) { return __uint_as_float((unsigned)__builtin_amdgcn_ds_bpermute(((lane - o) & 63) << 2, (int)__float_as_uint(v))); }
__device__ __forceinline__ float sigmoidf_(float x) { return 1.0f / (1.0f + __expf(-x)); }

#define XB_TMO      128
#define XB_XCNT(j)  (256  + 64 * (j))
#define XB_XSUB(j)  (1280 + 64 * (j))
#define XB_XGEN(j)  (2304 + 64 * (j))
#define XB_TOP      3328
#define XB_TOPGEN   3392
#define XCD_BAR_WORDS 3456
#define XB_SPIN_CAP (1u << 18)
__device__ __forceinline__ unsigned xb_ld(unsigned* p)              { return __hip_atomic_load(p, __ATOMIC_RELAXED, __HIP_MEMORY_SCOPE_AGENT); }
__device__ __forceinline__ unsigned xb_add(unsigned* p, unsigned v) { return __hip_atomic_fetch_add(p, v, __ATOMIC_RELAXED, __HIP_MEMORY_SCOPE_AGENT); }
__device__ __forceinline__ unsigned xb_xcc_id() { return (unsigned)__builtin_amdgcn_s_getreg((3 << 11) | 20) & 0xFu; }
#define XB_SPIN(cond, bar) do { unsigned _sp = 0; while (cond) { __builtin_amdgcn_s_sleep(1); \
    if ((++_sp & 255u) == 0u) { if (xb_ld(&(bar)[XB_TMO])) break; if (_sp > XB_SPIN_CAP) { atomicAdd(&(bar)[XB_TMO], 1u); break; } } } } while (0)
struct XcdBarrier { unsigned* bar; unsigned x; volatile LAS unsigned* st; };
__device__ __forceinline__ XcdBarrier xcd_barrier_post(unsigned* bar, volatile LAS unsigned* st) {
    XcdBarrier b; b.bar = bar; b.x = xb_xcc_id(); b.st = st;
    if (threadIdx.x == 0) (void)xb_add(&bar[XB_XCNT(b.x)], 1u);
    return b;
}
__device__ __forceinline__ void xcd_barrier_complete(unsigned* bar, unsigned x, unsigned& nloc, unsigned& nx) {
    const unsigned G = gridDim.x * gridDim.y * gridDim.z;
    unsigned sum, cnt, mine, sp = 0u;
    for (;;) {
        sum = 0u; cnt = 0u; mine = 0u;
#pragma unroll
        for (unsigned j = 0; j < 16; ++j) { const unsigned c = xb_ld(&bar[XB_XCNT(j)]); sum += c; cnt += (c > 0u) ? 1u : 0u; mine = (j == x) ? c : mine; }
        if (sum == G) break;
        __builtin_amdgcn_s_sleep(1);
        if ((++sp & 255u) == 0u) { if (xb_ld(&bar[XB_TMO])) break; if (sp > XB_SPIN_CAP) { atomicAdd(&bar[XB_TMO], 1u); break; } }
    }
    nloc = mine > 0u ? mine : 1u; nx = cnt > 0u ? cnt : 1u;
}
__device__ __forceinline__ void xcd_barrier(const XcdBarrier& b) {
    asm volatile("s_waitcnt vmcnt(0)" ::: "memory");
    __syncthreads();
    if (threadIdx.x == 0) {
        unsigned* bar = b.bar;
        __builtin_amdgcn_s_waitcnt(0);
        unsigned nloc = b.st[0], nx = b.st[1];
        if (nloc == 0u) { xcd_barrier_complete(bar, b.x, nloc, nx); b.st[0] = nloc; b.st[1] = nx; }
        const unsigned old = xb_add(&bar[XB_XSUB(b.x)], 1u);
        const unsigned gen = old / nloc;
        if (old + 1u == (gen + 1u) * nloc) {
            __builtin_amdgcn_fence(__ATOMIC_RELEASE, "agent");
            asm volatile("s_waitcnt vmcnt(0)" ::: "memory");
            const unsigned og = xb_add(&bar[XB_TOP], 1u);
            const unsigned tg = og / nx;
            if (og + 1u == (tg + 1u) * nx) xb_add(&bar[XB_TOPGEN], 1u);
            else XB_SPIN(xb_ld(&bar[XB_TOPGEN]) == tg, bar);
            __builtin_amdgcn_fence(__ATOMIC_ACQUIRE, "agent");
            xb_add(&bar[XB_XGEN(b.x)], 1u);
            asm volatile("s_waitcnt vmcnt(0)" ::: "memory");
        } else {
            XB_SPIN(xb_ld(&bar[XB_XGEN(b.x)]) == gen, bar);
            __builtin_amdgcn_fence(__ATOMIC_ACQUIRE, "agent");
            asm volatile("s_waitcnt vmcnt(0)" ::: "memory");
        }
    }
    __syncthreads();
}

__device__ const double ROPE_INV[16] = {1.0, 0.44036660267178046, 0.19392274474868576, 0.08539710028576561, 0.03760603093086393, 0.016560440080994446, 0.007292664737217109, 0.003211445994752591,
    0.001414213562373095, 0.000622772421914596, 0.0002742481756762073, 0.00012076973741146504, 5.318295896944988e-05, 2.341999896140934e-05, 1.031338537721246e-05, 4.5416704806078695e-06};

__device__ __forceinline__ void rope_table_phase(const int* pos, float* rope, int gtid, int gthreads) {
    for (int idx = gtid; idx < M * 16; idx += gthreads) {
        const int row = idx >> 4, i = idx & 15;
        const float angf = (float)pos[row] * (float)ROPE_INV[i];
        const double rev = (double)angf * 0.15915494309189535;
        const float fr = (float)(rev - __builtin_rint(rev));
        rope[(size_t)row * 32 + i] = __builtin_amdgcn_cosf(fr);
        rope[(size_t)row * 32 + 16 + i] = __builtin_amdgcn_sinf(fr);
    }
}

__device__ __forceinline__ void tr_item64(const float* W, int ldw, int ldk, bf16* WT, int k0, int k0d, int n0d, int n0s, bool ropeperm, LAS float* scr, int lane) {
    const int c = lane & 15, rr = lane >> 4;
    f32x4 v[16];
    const float* src = W + (size_t)(k0 + rr) * ldw + n0s + 4 * c;
#pragma unroll
    for (int i = 0; i < 16; ++i) v[i] = *(const GAS f32x4*)(src + (size_t)(4 * i) * ldw);
#pragma unroll
    for (int i = 0; i < 16; ++i) { LAS float* d = scr + (4 * c) * 65 + 4 * i + rr; d[0] = v[i].x; d[65] = v[i].y; d[130] = v[i].z; d[195] = v[i].w; }
    LDS_WAIT(); asm volatile("" ::: "memory");
    const int c8 = lane & 7;
#pragma unroll
    for (int j = 0; j < 8; ++j) { const int n = 8 * j + (lane >> 3); const int ns = (ropeperm && n < 32) ? ((n >> 1) + 16 * (n & 1)) : n; const LAS float* s = scr + ns * 65 + 8 * c8;
        v4u o; o.x = pk2(s[0], s[1]); o.y = pk2(s[2], s[3]); o.z = pk2(s[4], s[5]); o.w = pk2(s[6], s[7]);
        *(GAS v4u*)(WT + (size_t)(n0d + n) * ldk + k0d + 8 * c8) = o; }
    LDS_WAIT(); asm volatile("" ::: "memory");
}

__device__ __forceinline__ void convert_weights_phase(int l, const float* w_in, const float* p_m, const float* p_a, const float* w_out, const float* w_gate, const float* w_up, const float* w_down,
                                                      unsigned char* ws, LAS float* scr, int gw, int ngw, int lane) {
    constexpr int I1 = (DM / 64) * (NP / 64), I2 = (1024 / 64) * (DM / 64), I3 = (DM / 64) * (DM / 64), I4 = I3, I5 = (DM / 64) * (NGU / 64), I6 = (DFF / 64) * (DM / 64);
    constexpr int NIT = I1 + I2 + I3 + I4 + I5 + I6;
    for (int it = gw; it < NIT; it += ngw) {
        int r = it; const float* W; int ldw, K, nblk, koff = 0; size_t wsoff; int mode;
        if (r < I1) { W = w_in + (size_t)l * DM * DIN; ldw = DIN; K = DM; nblk = NP / 64; wsoff = WS_WIN; mode = 1; }
        else if ((r -= I1) < I2) { W = p_m + (size_t)l * 1024 * DM; ldw = DM; K = KMRG; nblk = DM / 64; wsoff = WS_PM; mode = 0; }
        else if ((r -= I2) < I3) { W = p_a + (size_t)l * DM * DM; ldw = DM; K = KMRG; koff = 1024; nblk = DM / 64; wsoff = WS_PM; mode = 0; }
        else if ((r -= I3) < I4) { W = w_out + (size_t)l * DM * DM; ldw = DM; K = DM; nblk = DM / 64; wsoff = WS_WO; mode = 0; }
        else if ((r -= I4) < I5) { W = nullptr; ldw = DFF; K = DM; nblk = NGU / 64; wsoff = WS_WGU; mode = 2; }
        else { r -= I5; W = w_down + (size_t)l * DFF * DM; ldw = DM; K = DFF; nblk = DM / 64; wsoff = WS_WD; mode = 0; }
        const int kb = r / nblk, nb = r % nblk, n0d = nb * 64; int n0s = n0d; bool rp = false;
        if (mode == 1) { n0s = n0d < 3072 ? n0d : n0d + 8; rp = (n0d >= C_AQ && n0d < C_AV && (n0d & 127) == 0); }
        if (mode == 2) { const int pn = n0d >> 8, r0 = n0d & 255; W = (r0 < 128 ? w_gate : w_up) + (size_t)l * DM * DFF; n0s = pn * 128 + (r0 & 127); }
        tr_item64(W, ldw, K, (bf16*)(ws + wsoff), kb * 64, koff + kb * 64, n0d, n0s, rp, scr, lane);
    }
}

__device__ __forceinline__ void norm_row(const float* xrow, const float* g, bf16* orow, int lane, f32x4 (&v)[8]) {
    const GAS f32x4* xr = (const GAS f32x4*)xrow + lane; const GAS f32x4* gr = (const GAS f32x4*)g + lane;
    float s = 0.f;
#pragma unroll
    for (int j = 0; j < 8; ++j) { v[j] = xr[64 * j]; s += (v[j].x * v[j].x + v[j].y * v[j].y) + (v[j].z * v[j].z + v[j].w * v[j].w); }
    const float rstd = 1.0f / sqrtf(wave_sum(s) * (1.f / DM) + EPS);
    GAS unsigned long long* o8 = (GAS unsigned long long*)orow + lane;
#pragma unroll
    for (int j = 0; j < 8; ++j) { const f32x4 gg = gr[64 * j]; v[j] = v[j] * rstd * gg;
        o8[64 * j] = (unsigned long long)pk2(v[j].x, v[j].y) | ((unsigned long long)pk2(v[j].z, v[j].w) << 32); }
}

__device__ __forceinline__ void mlstm_scan(int b, int h, const float* LIF, float* KSC, float* MT, float* EMT, float* REF, LAS float* sm, int tid) {
    const int lane = tid & 63, wave = tid >> 6;
    const float* base = LIF + (size_t)(b * SEQ) * 8;
    float li[8], c[8]; float run = 0.f;
#pragma unroll
    for (int j = 0; j < 8; ++j) { const int s = 8 * tid + j; li[j] = base[(size_t)s * 8 + h]; run += base[(size_t)s * 8 + 4 + h]; c[j] = run; }
    float inc = run;
#pragma unroll
    for (int o = 1; o < 64; o <<= 1) { const float vv = shfl_up_l(inc, o, lane); if (lane >= o) inc += vv; }
    if (lane == 63) sm[wave] = inc;
    __syncthreads();
    float woff = 0.f; for (int w = 0; w < wave; ++w) woff += sm[w];
    const float excl = woff + inc - run;
    float a[8], bs[8]; float lmax = -__builtin_inff();
#pragma unroll
    for (int j = 0; j < 8; ++j) { bs[j] = excl + c[j]; a[j] = li[j] - bs[j]; lmax = fmaxf(lmax, a[j]); }
    float tmax = lmax; tmax = fmaxf(tmax, SWZ_XOR(tmax, 1)); tmax = fmaxf(tmax, SWZ_XOR(tmax, 2)); tmax = fmaxf(tmax, SWZ_XOR(tmax, 4));
    float pm = lmax;
#pragma unroll
    for (int o = 1; o < 64; o <<= 1) { const float vv = shfl_up_l(pm, o, lane); if (lane >= o) pm = fmaxf(pm, vv); }
    if (lane == 63) sm[8 + wave] = pm;
    __syncthreads();
    float wpm = -__builtin_inff(); for (int w = 0; w < wave; ++w) wpm = fmaxf(wpm, sm[8 + w]);
    float prevl = shfl_up_l(pm, 1, lane); if (lane == 0) prevl = -__builtin_inff();
    float rmax = fmaxf(0.f, fmaxf(wpm, prevl));
    const size_t o0 = (size_t)(b * 4 + h) * SEQ + 8 * tid;
#pragma unroll
    for (int j = 0; j < 8; ++j) { rmax = fmaxf(rmax, a[j]); MT[o0 + j] = rmax; EMT[o0 + j] = __expf(-(bs[j] + rmax)); KSC[o0 + j] = __expf(a[j] - tmax); }
    if ((tid & 7) == 0) REF[(b * 4 + h) * 64 + (tid >> 3)] = tmax;
    __syncthreads();
}

__device__ __forceinline__ void mprep_strip(int strip, const bf16* PROJ, const float* cw, const float* cb, const float* KSC, bf16* QKM, int lane) {
    const int m0 = strip * 16, b = m0 / SEQ, s0 = m0 % SEQ, hh = lane >> 4;
    float w[4][16], bias[16];
#pragma unroll
    for (int j = 0; j < 4; ++j) {
#pragma unroll
        for (int e = 0; e < 8; ++e) { w[j][e] = cw[j * 1024 + 8 * lane + e]; w[j][8 + e] = cw[j * 1024 + 512 + 8 * lane + e]; } }
#pragma unroll
    for (int e = 0; e < 8; ++e) { bias[e] = cb[8 * lane + e]; bias[8 + e] = cb[512 + 8 * lane + e]; }
    float x0[16], x1[16], x2[16], x3[16];
#define LDROW(dst, s_) do { if ((s_) >= 0) { const bf16* rp = PROJ + (size_t)(b * SEQ + (s_)) * NP + C_MQK; const v4u q4 = *(const GAS v4u*)(rp + 8 * lane); const v4u k4 = *(const GAS v4u*)(rp + 512 + 8 * lane); \
            dst[0] = bflo(q4.x); dst[1] = bfhi(q4.x); dst[2] = bflo(q4.y); dst[3] = bfhi(q4.y); dst[4] = bflo(q4.z); dst[5] = bfhi(q4.z); dst[6] = bflo(q4.w); dst[7] = bfhi(q4.w); \
            dst[8] = bflo(k4.x); dst[9] = bfhi(k4.x); dst[10] = bflo(k4.y); dst[11] = bfhi(k4.y); dst[12] = bflo(k4.z); dst[13] = bfhi(k4.z); dst[14] = bflo(k4.w); dst[15] = bfhi(k4.w); } \
        else { _Pragma("unroll") for (int e_ = 0; e_ < 16; ++e_) dst[e_] = 0.f; } } while (0)
    LDROW(x0, s0 - 3); LDROW(x1, s0 - 2); LDROW(x2, s0 - 1);
    for (int i = 0; i < 16; ++i) {
        const int s = s0 + i;
        LDROW(x3, s);
        const float ksc = KSC[(size_t)(b * 4 + hh) * SEQ + s] * 0.08838834764831845f;
        float y[16];
#pragma unroll
        for (int e = 0; e < 16; ++e) { float t = bias[e] + w[0][e] * x0[e] + w[1][e] * x1[e] + w[2][e] * x2[e] + w[3][e] * x3[e]; t = t * sigmoidf_(t); y[e] = (e < 8) ? t : t * ksc; }
        v4u oq, ok; oq.x = pk2(y[0], y[1]); oq.y = pk2(y[2], y[3]); oq.z = pk2(y[4], y[5]); oq.w = pk2(y[6], y[7]);
        ok.x = pk2(y[8], y[9]); ok.y = pk2(y[10], y[11]); ok.z = pk2(y[12], y[13]); ok.w = pk2(y[14], y[15]);
        bf16* op = QKM + (size_t)(m0 + i) * 1024;
        *(GAS v4u*)(op + 8 * lane) = oq; *(GAS v4u*)(op + 512 + 8 * lane) = ok;
#pragma unroll
        for (int e = 0; e < 16; ++e) { x0[e] = x1[e]; x1[e] = x2[e]; x2[e] = x3[e]; }
    }
#undef LDROW
}

__device__ __forceinline__ void finish_row(int row, const float* HT, const float* OST, bf16* PROJ, const float* g_mhead, const float* g_sub, float one_m_laminit, int lane) {
    bf16* prow = PROJ + (size_t)row * NP;
#pragma unroll
    for (int hh = 0; hh < 4; ++hh) {
        const f32x4 v = *(const GAS f32x4*)(HT + (size_t)row * 1024 + hh * 256 + 4 * lane);
        const float ss = wave_sum((v.x * v.x + v.y * v.y) + (v.z * v.z + v.w * v.w));
        const float rstd = 1.0f / sqrtf(ss * (1.f / 256.f) + EPS);
        const f32x4 g = *(const GAS f32x4*)(g_mhead + hh * 256 + 4 * lane);
        const v2u so = *(const GAS v2u*)(prow + C_MO + hh * 256 + 4 * lane);
        const float o0 = bflo(so.x) * (v.x * rstd * g.x), o1 = bfhi(so.x) * (v.y * rstd * g.y), o2 = bflo(so.y) * (v.z * rstd * g.z), o3 = bfhi(so.y) * (v.w * rstd * g.w);
        v2u w; w.x = pk2(o0, o1); w.y = pk2(o2, o3);
        *(GAS v2u*)(prow + C_MO + hh * 256 + 4 * lane) = w;
    }
    const f32x4 gs = *(const GAS f32x4*)(g_sub + 4 * lane);
#pragma unroll
    for (int hh = 0; hh < 8; ++hh) {
        const f32x4 v = *(const GAS f32x4*)(OST + (size_t)row * 2048 + hh * 256 + 4 * lane);
        const float ss = wave_sum((v.x * v.x + v.y * v.y) + (v.z * v.z + v.w * v.w));
        const float rstd = 1.0f / sqrtf(ss * (1.f / 256.f) + EPS) * one_m_laminit;
        v2u w; w.x = pk2(v.x * rstd * gs.x, v.y * rstd * gs.y); w.y = pk2(v.z * rstd * gs.z, v.w * rstd * gs.w);
        *(GAS v2u*)(prow + C_AQ + hh * 256 + 4 * lane) = w;
    }
}
struct Args { const void* in[22]; float* out; unsigned char* ws; int stop_layer; int stop_phase; };

constexpr int PT_OFF = MISC_OFF + 128;
constexpr int PT_OUT = 22, PT_WS = 23;
static_assert(PT_OFF + 24 * 8 <= LDS_BYTES, "LDS map");
__device__ __forceinline__ const void* ldp(LAS unsigned char* ldsA, int k) {
    const volatile LAS unsigned* p = (const volatile LAS unsigned*)(ldsA + PT_OFF) + 2 * k; const unsigned lo = p[0], hi = p[1];
    return (const void*)(((unsigned long long)(unsigned)__builtin_amdgcn_readfirstlane(hi) << 32) | (unsigned)__builtin_amdgcn_readfirstlane(lo));
}
#define LDPF(k) ((const float*)ldp(ldsA, (k)))

__global__ void __launch_bounds__(NWAVES * 64, 2) hybrid_fwd(Args args) {
    extern __shared__ __attribute__((aligned(16))) unsigned char lds[];
    LAS unsigned char* ldsA0 = (LAS unsigned char*)lds;
    const int tid0 = threadIdx.x;
    const int wave0 = __builtin_amdgcn_readfirstlane(tid0 >> 6);
    const int G0 = gridDim.x; const int bx0 = blockIdx.x;
    const int vcu0 = (G0 % 8 == 0) ? (bx0 % 8) * (G0 / 8) + bx0 / 8 : bx0;
#define PHASE_IDS() int tid = wave0 * 64 + (int)__builtin_amdgcn_mbcnt_hi(~0u, __builtin_amdgcn_mbcnt_lo(~0u, 0u)); asm volatile("" : "+v"(tid)); int lz_ = 0; asm volatile("" : "+s"(lz_)); \
    const int lane = tid & 63, wave = __builtin_amdgcn_readfirstlane(tid >> 6), G = G0 + lz_, bx = bx0 + lz_, vcu = vcu0 + lz_, NGW = G * NWAVES, gw = vcu * NWAVES + wave; \
    LAS unsigned char* ldsA = ldsA0 + lz_; char* ldsG = (char*)lds + lz_; (void)lane; (void)gw; (void)bx; (void)NGW; (void)ldsG
    for (int u = tid0; u < (LDS_BYTES - LDSCTL_OFF) / 4; u += NWAVES * 64) ((LAS unsigned*)(ldsA0 + LDSCTL_OFF))[u] = 0u;
    __syncthreads();
    if (tid0 < 24) { const unsigned long long v = (tid0 < 22) ? (unsigned long long)args.in[tid0] : (tid0 == 22 ? (unsigned long long)args.out : (unsigned long long)args.ws);
        ((volatile LAS unsigned long long*)(ldsA0 + PT_OFF))[tid0] = v; }
    __syncthreads();
    { XcdBarrier b0_ = xcd_barrier_post((unsigned*)((unsigned char*)ldp(ldsA0, PT_WS) + WS_CTL) + CW_BAR, (volatile LAS unsigned*)(ldsA0 + MISC_OFF) + 8); (void)b0_; }
#define GRID_BAR() do { int lzb_ = 0; asm volatile("" : "+s"(lzb_)); XcdBarrier b_; b_.bar = (unsigned*)((unsigned char*)ldp(ldsA0 + lzb_, PT_WS) + WS_CTL) + CW_BAR; b_.x = xb_xcc_id(); \
        b_.st = (volatile LAS unsigned*)(ldsA0 + lzb_ + MISC_OFF) + 8; xcd_barrier(b_); } while (0)
    const int stop_layer = args.stop_layer, stop_phase = args.stop_phase;

    { PHASE_IDS(); unsigned char* ws = (unsigned char*)ldp(ldsA, PT_WS); rope_table_phase((const int*)ldp(ldsA, 1), (float*)(ws + WS_ROPE), gw * 64 + lane, NGW * 64); }

#define STOP_AT(ph) do { if (DBG && l == stop_layer && stop_phase == (ph)) return; } while (0)
    for (int l = 0; l < DEPTH; ++l) {
        for (int rep_ = 0; rep_ < REPS(0); ++rep_)
        {
            PHASE_IDS();
            unsigned char* ws = (unsigned char*)ldp(ldsA, PT_WS);
            const float* w_in = LDPF(3);
            convert_weights_phase(l, w_in, LDPF(14), LDPF(15), LDPF(16), LDPF(18), LDPF(19), LDPF(20), ws, (LAS float*)(ldsA + RING_OFF + wave * 16640), gw, NGW, lane);
            __syncthreads();
            LAS float* wgT = (LAS float*)(ldsA + RING_OFF);
            for (int k = tid; k < DM; k += NWAVES * 64) {
                const float* src = w_in + (size_t)l * DM * DIN + (size_t)k * DIN + 3072;
                const f32x4 a = *(const GAS f32x4*)src, b2 = *(const GAS f32x4*)(src + 4);
                wgT[0 * DM + k] = a.x; wgT[1 * DM + k] = a.y; wgT[2 * DM + k] = a.z; wgT[3 * DM + k] = a.w;
                wgT[4 * DM + k] = b2.x; wgT[5 * DM + k] = b2.y; wgT[6 * DM + k] = b2.z; wgT[7 * DM + k] = b2.w;
            }
            __syncthreads();
            const float* resid_in = (l == 0) ? LDPF(0) : LDPF(PT_OUT);
            const float* g_mix = LDPF(2) + (size_t)l * DM; const float* i_bias = LDPF(6) + l * 4; const float* f_bias = LDPF(7) + l * 4;
            bf16* HY = (bf16*)(ws + WS_HY); float* LIF = (float*)(ws + WS_LIF);
            for (int m = gw; m < M; m += NGW) {
                f32x4 v[8];
                norm_row(resid_in + (size_t)m * DM, g_mix, HY + (size_t)m * DM, lane, v);
                float ga[8];
#pragma unroll
                for (int c = 0; c < 8; ++c) { float s = 0.f;
#pragma unroll
                    for (int j = 0; j < 8; ++j) { const f32x4 wv = *(const LAS f32x4*)(wgT + c * DM + 256 * j + 4 * lane); s += (v[j].x * wv.x + v[j].y * wv.y) + (v[j].z * wv.z + v[j].w * wv.w); }
                    ga[c] = wave_sum(s); }
                if (lane < 8) {
                    float val = 0.f;
#pragma unroll
                    for (int c = 0; c < 8; ++c) if (lane == c) val = ga[c];
                    if (lane < 4) val += i_bias[lane];
                    else { const float z = val + f_bias[lane - 4]; const float e = __expf(-fabsf(z)), u = 1.0f + e, d = u - 1.0f; val = fminf(z, 0.f) - ((d == 0.f) ? e : __logf(u) * (e / d)); }
                    LIF[(size_t)m * 8 + lane] = val;
                }
            }
        }
        GRID_BAR(); STOP_AT(0);
        for (int rep_ = 0; rep_ < REPS(1); ++rep_)
        {
            PHASE_IDS();
            unsigned char* ws = (unsigned char*)ldp(ldsA, PT_WS);
            {
                float* LIF = (float*)(ws + WS_LIF); float* MT = (float*)(ws + WS_MT); float* EMT = (float*)(ws + WS_EMT); float* KSC = (float*)(ws + WS_KSC); float* REF = (float*)(ws + WS_REF);
                for (int id = vcu; id < NB * 4; id += G) mlstm_scan(id >> 2, id & 3, LIF, KSC, MT, EMT, REF, (LAS float*)(ldsA + RING_OFF), tid);
            }
            pg8::Gemm g{(const bf16*)(ws + WS_HY), (const bf16*)(ws + WS_WIN), DM, DM}; pg8::StaticOrder S; S.init(M, NP, G, bx);
            pg8::EpiProj E{(bf16*)(ws + WS_PROJ), NP, (const float*)(ws + WS_ROPE)};
            pg8::gemm_phase<pg8::EpiProj, true>(ldsA + RING_OFF, g, S, E, tid);
        }
        GRID_BAR(); STOP_AT(1);
        for (int rep_ = 0; rep_ < REPS(2); ++rep_)
        {
            PHASE_IDS();
            unsigned char* ws = (unsigned char*)ldp(ldsA, PT_WS);
            const float* cw = LDPF(4) + (size_t)l * 4 * 1024; const float* cb = LDPF(5) + (size_t)l * 1024;
            for (int st = gw; st < M / 16; st += NGW) mprep_strip(st, (const bf16*)(ws + WS_PROJ), cw, cb, (const float*)(ws + WS_KSC), (bf16*)(ws + WS_QKM), lane);
        }
        GRID_BAR(); STOP_AT(2);
        for (int rep_ = 0; rep_ < REPS(3); ++rep_)
        {
            PHASE_IDS();
            unsigned char* ws = (unsigned char*)ldp(ldsA, PT_WS);
            char* albs = ldsG + RING_OFF;
            att::Seam S;
            {
                constexpr int NIT = NB * 4 * 2 * 8; const int cnt = (NIT + G - 1) / G; const int id0 = vcu * cnt; int nitems = NIT - id0; nitems = nitems < 0 ? 0 : (nitems > cnt ? cnt : nitems);
                const int nblk = 2 * nitems;
                bf16* QKM = (bf16*)(ws + WS_QKM); bf16* PROJ = (bf16*)(ws + WS_PROJ); float* HT = (float*)(ws + WS_HT);
                const float* MT = (const float*)(ws + WS_MT); const float* EMT = (const float*)(ws + WS_EMT); const float* REF = (const float*)(ws + WS_REF);
#define MREF(s_, R, L) do { const int id_ = id0 + ((s_) >> 1), bh_ = id_ >> 4, r_ = id_ & 15, j_ = r_ >> 3, p_ = r_ & 7, qb_ = ((s_) & 1) ? 15 - p_ : p_, b_ = bh_ >> 2, hm_ = bh_ & 3; \
                    R.Q = QKM + (size_t)(b_ * SEQ + qb_ * 256) * 1024 + hm_ * 128; R.K = QKM + (size_t)(b_ * SEQ) * 1024 + 512 + hm_ * 128; \
                    R.V = PROJ + (size_t)(b_ * SEQ) * NP + C_MV + hm_ * 256 + j_ * 128; R.O = HT + (size_t)(b_ * SEQ + qb_ * 256) * 1024 + hm_ * 256 + j_ * 128; R.P0 = qb_ * 256; \
                    L.MT = MT + (size_t)bh_ * SEQ; L.EMT = EMT + (size_t)bh_ * SEQ; L.REF = REF + bh_ * 64; } while (0)
                if (nblk > 0) {
                    { att::BlockRef cur; att::LinRef lc; MREF(0, cur, lc); att::prime<1024, 1024, NP>(cur, albs, S, tid); }
                    for (int s = 0; s < nblk; ++s) {
                        { att::BlockRef nxt; att::LinRef ln; const int sn = (s + 1 < nblk) ? s + 1 : s; MREF(sn, nxt, ln); att::put_next(albs, nxt, tid); }
                        att::BlockRef cur; att::LinRef lc; MREF(s, cur, lc);
                        { int t2 = tid; asm volatile("" : "+v"(t2)); att::block<1024, 1024, NP, 1024, 2>(cur, albs, S, 0.f, lc, t2); }
                    }
                }
#undef MREF
            }
            {
                float lam;
                { const float* lq1 = LDPF(9) + l * 128; const float* lk1 = LDPF(10) + l * 128; const float* lq2 = LDPF(11) + l * 128; const float* lk2 = LDPF(12) + l * 128;
                  const float a1 = lq1[lane] * lk1[lane] + lq1[64 + lane] * lk1[64 + lane];
                  const float a2 = lq2[lane] * lk2[lane] + lq2[64 + lane] * lk2[64 + lane];
                  const float lam_init = 0.8f - 0.6f * __expf(-0.3f * (float)l);
                  lam = __expf(wave_sum(a1)) - __expf(wave_sum(a2)) + lam_init; }
                constexpr int NIT = NB * 8 * 2 * 8; const int cnt = (NIT + G - 1) / G; const int id0 = vcu * cnt; int nitems = NIT - id0; nitems = nitems < 0 ? 0 : (nitems > cnt ? cnt : nitems);
                const int nps = 2 * nitems;
                bf16* PROJ = (bf16*)(ws + WS_PROJ); float* OST = (float*)(ws + WS_OST);
                att::LinRef lr0{nullptr, nullptr, nullptr};
#define AREF(ps_, c_, R) do { const int id_ = id0 + ((ps_) >> 1), bh_ = id_ >> 4, r_ = id_ & 15, j_ = r_ >> 3, p_ = r_ & 7, qb_ = ((ps_) & 1) ? 15 - p_ : p_, b_ = bh_ >> 3, h_ = bh_ & 7; \
                    R.Q = PROJ + (size_t)(b_ * SEQ + qb_ * 256) * NP + C_AQ + h_ * 256 + (c_) * 128; R.K = PROJ + (size_t)(b_ * SEQ) * NP + C_AK + h_ * 256 + (c_) * 128; \
                    R.V = PROJ + (size_t)(b_ * SEQ) * NP + C_AV + h_ * 256 + j_ * 128; R.O = OST + (size_t)(b_ * SEQ + qb_ * 256) * 2048 + h_ * 256 + j_ * 128; R.P0 = qb_ * 256; } while (0)
                if (nps > 0) {
                    { att::BlockRef c0; AREF(0, 0, c0); att::prime<NP, NP, NP>(c0, albs, S, tid); }
                    for (int ps = 0; ps < nps; ++ps) {
                        { att::BlockRef nx; AREF(ps, 1, nx); att::put_next(albs, nx, tid); }
                        { att::BlockRef c0; AREF(ps, 0, c0); int t2 = tid; asm volatile("" : "+v"(t2)); att::block<NP, NP, NP, 2048, 0>(c0, albs, S, lam, lr0, t2); }
                        { att::BlockRef nx; if (ps + 1 < nps) AREF(ps + 1, 0, nx); else AREF(ps, 1, nx); att::put_next(albs, nx, tid); }
                        { att::BlockRef c1; AREF(ps, 1, c1); int t2 = tid; asm volatile("" : "+v"(t2)); att::block<NP, NP, NP, 2048, 1>(c1, albs, S, lam, lr0, t2); }
                    }
                }
#undef AREF
            }
        }
        GRID_BAR(); STOP_AT(3);
        for (int rep_ = 0; rep_ < REPS(4); ++rep_)
        {
            PHASE_IDS();
            unsigned char* ws = (unsigned char*)ldp(ldsA, PT_WS);
            const float oml = 1.0f - (0.8f - 0.6f * __expf(-0.3f * (float)l));
            const float* gmh = LDPF(8) + (size_t)l * 1024; const float* gsub = LDPF(13) + (size_t)l * 256;
            for (int m = gw; m < M; m += NGW) finish_row(m, (const float*)(ws + WS_HT), (const float*)(ws + WS_OST), (bf16*)(ws + WS_PROJ), gmh, gsub, oml, lane);
        }
        GRID_BAR(); STOP_AT(4);
        for (int rep_ = 0; rep_ < REPS(5); ++rep_)
        {
            PHASE_IDS();
            unsigned char* ws = (unsigned char*)ldp(ldsA, PT_WS);
            bf16* PROJ = (bf16*)(ws + WS_PROJ);
            pg8::StaticOrder S; S.init(M, DM, G, bx);
            pg8::Gemm g{PROJ + C_MO, (const bf16*)(ws + WS_PM), NP, KMRG}; pg8::EpiMerge E{PROJ + C_GM, PROJ + C_GA, NP, (bf16*)(ws + WS_HY), DM};
            pg8::gemm_phase<pg8::EpiMerge, true, 16>(ldsA + RING_OFF, g, S, E, tid);
        }
        GRID_BAR(); STOP_AT(5);
        {
            PHASE_IDS();
            unsigned char* ws = (unsigned char*)ldp(ldsA, PT_WS);
            float* out = (float*)ldp(ldsA, PT_OUT);
            const float* resid_in = (l == 0) ? LDPF(0) : (const float*)out;
            pg8::StaticOrder S; S.init(M, DM, G, bx);
            pg8::Gemm g{(const bf16*)(ws + WS_HY), (const bf16*)(ws + WS_WO), DM, DM}; pg8::EpiRes E{resid_in, out, DM};
            pg8::gemm_phase<pg8::EpiRes, true>(ldsA + RING_OFF, g, S, E, tid);
        }
        GRID_BAR(); STOP_AT(6);
        for (int rep_ = 0; rep_ < REPS(7); ++rep_)
        {
            PHASE_IDS();
            unsigned char* ws = (unsigned char*)ldp(ldsA, PT_WS);
            const float* out = LDPF(PT_OUT); const float* g_ffn = LDPF(17) + (size_t)l * DM; bf16* HY = (bf16*)(ws + WS_HY);
            for (int m = gw; m < M; m += NGW) { f32x4 v[8]; norm_row(out + (size_t)m * DM, g_ffn, HY + (size_t)m * DM, lane, v); }
        }
        GRID_BAR(); STOP_AT(7);
        for (int rep_ = 0; rep_ < REPS(8); ++rep_)
        {
            PHASE_IDS();
            unsigned char* ws = (unsigned char*)ldp(ldsA, PT_WS);
            pg8::StaticOrder S; S.init(M, NGU, G, bx);
            pg8::Gemm g{(const bf16*)(ws + WS_HY), (const bf16*)(ws + WS_WGU), DM, DM}; pg8::EpiSwiglu E{(bf16*)(ws + WS_PROJ), DFF};
            pg8::gemm_phase<pg8::EpiSwiglu, true>(ldsA + RING_OFF, g, S, E, tid);
        }
        GRID_BAR(); STOP_AT(8);
        {
            PHASE_IDS();
            unsigned char* ws = (unsigned char*)ldp(ldsA, PT_WS);
            float* out = (float*)ldp(ldsA, PT_OUT);
            pg8::StaticOrder S; S.init(M, DM, G, bx);
            pg8::Gemm g{(const bf16*)(ws + WS_PROJ), (const bf16*)(ws + WS_WD), DFF, DFF};
            pg8::EpiRes E{out, (DBG && l == stop_layer && stop_phase == 9) ? (float*)(ws + WS_OST) : out, DM};
            pg8::gemm_phase<pg8::EpiRes, true>(ldsA + RING_OFF, g, S, E, tid);
        }
        GRID_BAR(); STOP_AT(9);
    }
    {
        PHASE_IDS();
        float* out = (float*)ldp(ldsA, PT_OUT); const float* g_final = LDPF(21);
        for (int m = gw; m < M; m += NGW) {
            GAS f32x4* xr = (GAS f32x4*)(out + (size_t)m * DM) + lane; const GAS f32x4* gr = (const GAS f32x4*)g_final + lane;
            f32x4 v[8]; float s = 0.f;
#pragma unroll
            for (int j = 0; j < 8; ++j) { v[j] = xr[64 * j]; s += (v[j].x * v[j].x + v[j].y * v[j].y) + (v[j].z * v[j].z + v[j].w * v[j].w); }
            const float rstd = 1.0f / sqrtf(wave_sum(s) * (1.f / DM) + EPS);
#pragma unroll
            for (int j = 0; j < 8; ++j) xr[64 * j] = v[j] * rstd * gr[64 * j];
        }
    }
#undef GRID_BAR
#undef STOP_AT
}
extern "C" void kernel_launch(void* const* d_in, const int* in_sizes, int n_in, void* d_out, int out_size, void* d_ws, size_t ws_size, hipStream_t stream) {
    static int grid = 0;
    if (grid == 0) {
        if (n_in != 22 || in_sizes[0] != M * DM || out_size != M * DM || ws_size < WS_END) {
            fprintf(stderr, "kernel_launch: shape mismatch (n_in %d, in0 %d, out %d, ws %zu < %zu); nothing launched\n", n_in, n_in > 0 ? in_sizes[0] : -1, out_size, ws_size, (size_t)WS_END); grid = -1; return; }
        int dev = 0, cus = 0, per_cu = 0;
        if (hipGetDevice(&dev) != hipSuccess || hipDeviceGetAttribute(&cus, hipDeviceAttributeMultiprocessorCount, dev) != hipSuccess) { grid = -1; return; }
        if (hipFuncSetAttribute((const void*)hybrid_fwd, hipFuncAttributeMaxDynamicSharedMemorySize, LDS_BYTES) != hipSuccess) { fprintf(stderr, "kernel_launch: hipFuncSetAttribute failed\n"); grid = -1; return; }
        if (hipOccupancyMaxActiveBlocksPerMultiprocessor(&per_cu, (const void*)hybrid_fwd, NWAVES * 64, LDS_BYTES) != hipSuccess || per_cu < 1)
            fprintf(stderr, "kernel_launch: note: occupancy query reports %d workgroups per CU\n", per_cu);
        (void)hipGetLastError();
        grid = cus;
    }
    if (grid < 0) return;
    if (hipMemsetAsync((char*)d_ws + WS_CTL, 0, CTL_ZERO_BYTES, stream) != hipSuccess) return;
    Args a{};
    for (int i = 0; i < 22; ++i) a.in[i] = d_in[i];
    a.out = (float*)d_out; a.ws = (unsigned char*)d_ws;
    a.stop_layer = DBG ? DBG_STOP_LAYER : -1; a.stop_phase = DBG ? DBG_STOP_PHASE : -1;
    hipLaunchKernelGGL(hybrid_fwd, dim3(grid), dim3(NWAVES * 64), LDS_BYTES, stream, a);
#if DBG
    dbg_checks(d_in, (float*)d_out, (unsigned char*)d_ws, stream);
#endif
}
```

```cpp
#include <hip/hip_runtime.h>
#include <cstdio>
#include <cstdint>
#define DBG 0
#define DBG_STOP_LAYER 0
#define DBG_STOP_PHASE 3
#define PROBE_PHASE -1
#define REPS(k) ((PROBE_PHASE == (k)) ? 2 : 1)
namespace pg8 {
#define PG8_LAS __attribute__((address_space(3)))
typedef unsigned short bf16_t;
typedef short bf16x8 __attribute__((ext_vector_type(8)));
typedef float f32x4 __attribute__((ext_vector_type(4)));
typedef unsigned u32x4 __attribute__((ext_vector_type(4)));
constexpr int BM = 256, BK = 64, HALF = 128, HTB = HALF * BK * 2  , STAGE_BYTES = 8 * HTB, NXCD = 8, WGM = 8;

__host__ __device__ __forceinline__ int lds_byte(int r, int c) { const int st = (r >> 4) * 2 + (c >> 5), rr = r & 15, cc = c & 31, ob = rr * 64 + cc * 2; return st * 1024 + (ob ^ (((ob >> 9) & 1) << 5)); }
__host__ __device__ __forceinline__ void stage_rc(int b, int& R, int& C) { const int st = b / 1024, sb = b % 1024, swz = sb ^ (((sb >> 9) & 1) << 5); R = (st >> 1) * 16 + swz / 64; C = (st & 1) * 32 + (swz % 64) / 2; }
__host__ __device__ __forceinline__ int perm32(int rho) { const int n = rho >> 4, i = rho & 15; return 8 * (i >> 2) + 4 * n + (i & 3); }

struct Unit { int pm, pn; };
struct Gemm { const bf16_t* A; const bf16_t* Bt; int lda; int K; };

struct StaticOrder {
    int nM, nN, nwg, G, c;
    __host__ __device__ void init(int M, int N, int G_, int c_) { nM = M / BM; nN = N / BM; nwg = nM * nN; G = G_; c = c_; }
    __host__ __device__ bool next(int i, Unit& u) const {
        const long L = (long)i * G + c; if (L >= nwg) return false;
        int wgid = (int)L; { const int q = nwg / NXCD, r = nwg % NXCD, xcd = wgid % NXCD, off = wgid / NXCD; wgid = (xcd < r ? xcd * (q + 1) : r * (q + 1) + (xcd - r) * q) + off; }
        const int nig = WGM * nN, gid = wgid / nig, fm = gid * WGM, gsz = (nM - fm) < WGM ? (nM - fm) : WGM;
        u.pm = fm + ((wgid % nig) % gsz); u.pn = (wgid % nig) / gsz; return true;
    }
};

__device__ __forceinline__ unsigned cvt_pk_bf16(float lo, float hi) { unsigned r; asm volatile("v_cvt_pk_bf16_f32 %0, %1, %2" : "=v"(r) : "v"(lo), "v"(hi)); return r; }
__device__ __forceinline__ float bf_lo(unsigned u) { return __uint_as_float(u << 16); }
__device__ __forceinline__ float bf_hi(unsigned u) { return __uint_as_float(u & 0xffff0000u); }
__device__ __forceinline__ float sigm(float x) { return __builtin_amdgcn_rcpf(1.0f + __builtin_amdgcn_exp2f(-1.4426950408889634f * x)); }
__device__ __forceinline__ u32x4 pack8f(f32x4 a, f32x4 b) { u32x4 w; w.x = cvt_pk_bf16(a[0], a[1]); w.y = cvt_pk_bf16(a[2], a[3]); w.z = cvt_pk_bf16(b[0], b[1]); w.w = cvt_pk_bf16(b[2], b[3]); return w; }

struct EpiProj {
    static constexpr bool PERM = true;
    bf16_t* O; int ldc; const float* rope;
    __device__ __forceinline__ void operator()(const f32x4 (&acc)[2][2][4][2], const Unit& u, int wr, int wc, int fr, int fq) const {
        const int row0 = u.pm * BM + wr * 64 + fr, col0 = u.pn * BM + wc * 32 + 8 * fq;
        const int pn = u.pn;
        const bool is_sig = (pn >= 8 && pn < 12) || pn >= 36;
        const bool is_rope = (pn >= 12 && pn < 28) && (wc == 0);
#pragma unroll
        for (int ai = 0; ai < 2; ++ai)
#pragma unroll
            for (int m = 0; m < 4; ++m) {
                const int row = row0 + ai * HALF + m * 16;
                bf16_t* rowp = O + (size_t)row * ldc + col0;
                f32x4 cs = (f32x4){1.f, 1.f, 1.f, 1.f}, sn = (f32x4){0.f, 0.f, 0.f, 0.f};
                if (is_rope) { cs = *(const f32x4*)(rope + (size_t)row * 32 + 4 * fq); sn = *(const f32x4*)(rope + (size_t)row * 32 + 16 + 4 * fq); }
#pragma unroll
                for (int bj = 0; bj < 2; ++bj) {
                    f32x4 v0 = acc[ai][bj][m][0], v1 = acc[ai][bj][m][1];
                    if (is_sig) {
#pragma unroll
                        for (int e = 0; e < 4; ++e) { v0[e] = sigm(v0[e]); v1[e] = sigm(v1[e]); }
                    }
                    if (is_rope) {
                        f32x4 a0, a1;
                        a0[0] = v0[0] * cs[0] - v0[1] * sn[0]; a0[1] = v0[1] * cs[0] + v0[0] * sn[0];
                        a0[2] = v0[2] * cs[1] - v0[3] * sn[1]; a0[3] = v0[3] * cs[1] + v0[2] * sn[1];
                        a1[0] = v1[0] * cs[2] - v1[1] * sn[2]; a1[1] = v1[1] * cs[2] + v1[0] * sn[2];
                        a1[2] = v1[2] * cs[3] - v1[3] * sn[3]; a1[3] = v1[3] * cs[3] + v1[2] * sn[3];
                        v0 = a0; v1 = a1;
                    }
                    *(u32x4*)(rowp + bj * HALF) = pack8f(v0, v1);
                }
            }
    }
};
struct EpiMerge {
    static constexpr bool PERM = true;
    const bf16_t* GM; const bf16_t* GA; int ldg; bf16_t* Y; int ldy;
    __device__ __forceinline__ void hook(f32x4 (&acc)[2][2][4][2], const Unit& u, int wr, int wc, int fr, int fq) const {
        int z_ = 0; asm volatile("" : "+v"(z_));
        const int row0 = u.pm * BM + wr * 64 + fr + z_, col0 = u.pn * BM + wc * 32 + 8 * fq;
#pragma unroll
        for (int ai = 0; ai < 2; ++ai)
#pragma unroll
            for (int m = 0; m < 4; ++m) {
                const int row = row0 + ai * HALF + m * 16;
#pragma unroll
                for (int bj = 0; bj < 2; ++bj) {
                    const size_t off = (size_t)row * ldg + col0 + bj * HALF;
                    const u32x4 a = *(const u32x4*)(GM + off), b = *(const u32x4*)(GA + off);
                    f32x4& v0 = acc[ai][bj][m][0]; f32x4& v1 = acc[ai][bj][m][1];
#define RQ(x, y) ((x) * __builtin_amdgcn_rcpf(fmaxf((y), 1e-30f)))
                    v0[0] *= RQ(bf_lo(a.x), bf_lo(b.x)); v0[1] *= RQ(bf_hi(a.x), bf_hi(b.x)); v0[2] *= RQ(bf_lo(a.y), bf_lo(b.y)); v0[3] *= RQ(bf_hi(a.y), bf_hi(b.y));
                    v1[0] *= RQ(bf_lo(a.z), bf_lo(b.z)); v1[1] *= RQ(bf_hi(a.z), bf_hi(b.z)); v1[2] *= RQ(bf_lo(a.w), bf_lo(b.w)); v1[3] *= RQ(bf_hi(a.w), bf_hi(b.w));
#undef RQ
                }
                if (m == 3) asm volatile("" ::: "memory");
            }
    }
    __device__ __forceinline__ void operator()(const f32x4 (&acc)[2][2][4][2], const Unit& u, int wr, int wc, int fr, int fq) const {
        const int row0 = u.pm * BM + wr * 64 + fr, col0 = u.pn * BM + wc * 32 + 8 * fq;
#pragma unroll
        for (int ai = 0; ai < 2; ++ai)
#pragma unroll
            for (int m = 0; m < 4; ++m) {
                const int row = row0 + ai * HALF + m * 16;
#pragma unroll
                for (int bj = 0; bj < 2; ++bj) {
                    const int col = col0 + bj * HALF;
                    const u32x4 g = *(const u32x4*)(GA + (size_t)row * ldg + col);
                    const f32x4 v0 = acc[ai][bj][m][0], v1 = acc[ai][bj][m][1];
                    f32x4 o0, o1;
                    o0[0] = bf_lo(g.x) * v0[0]; o0[1] = bf_hi(g.x) * v0[1]; o0[2] = bf_lo(g.y) * v0[2]; o0[3] = bf_hi(g.y) * v0[3];
                    o1[0] = bf_lo(g.z) * v1[0]; o1[1] = bf_hi(g.z) * v1[1]; o1[2] = bf_lo(g.w) * v1[2]; o1[3] = bf_hi(g.w) * v1[3];
                    *(u32x4*)(Y + (size_t)row * ldy + col) = pack8f(o0, o1);
                }
                if (m == 3) asm volatile("" ::: "memory");
            }
    }
};
struct EpiRes {
    static constexpr bool PERM = false;
    const float* res; float* out; int ldc;
    __device__ __forceinline__ void operator()(const f32x4 (&acc)[2][2][4][2], const Unit& u, int wr, int wc, int fr, int fq) const {
        const int row0 = u.pm * BM + wr * 64 + fr, col0 = u.pn * BM + wc * 32 + 4 * fq;
#pragma unroll
        for (int ai = 0; ai < 2; ++ai)
#pragma unroll
            for (int m = 0; m < 4; ++m) {
                const size_t off = (size_t)(row0 + ai * HALF + m * 16) * ldc + col0;
#pragma unroll
                for (int bj = 0; bj < 2; ++bj)
#pragma unroll
                    for (int n = 0; n < 2; ++n) { const f32x4 r = *(const f32x4*)(res + off + bj * HALF + n * 16); *(f32x4*)(out + off + bj * HALF + n * 16) = r + acc[ai][bj][m][n]; }
            }
    }
};
struct EpiSwiglu {
    static constexpr bool PERM = true;
    bf16_t* H; int ldh;
    __device__ __forceinline__ void operator()(const f32x4 (&acc)[2][2][4][2], const Unit& u, int wr, int wc, int fr, int fq) const {
        const int row0 = u.pm * BM + wr * 64 + fr, col0 = u.pn * HALF + wc * 32 + 8 * fq;
#pragma unroll
        for (int ai = 0; ai < 2; ++ai)
#pragma unroll
            for (int m = 0; m < 4; ++m) {
                const int row = row0 + ai * HALF + m * 16;
                f32x4 o0, o1;
#pragma unroll
                for (int e = 0; e < 4; ++e) { const float g0 = acc[ai][0][m][0][e], g1 = acc[ai][0][m][1][e];
                    o0[e] = g0 * sigm(g0) * acc[ai][1][m][0][e]; o1[e] = g1 * sigm(g1) * acc[ai][1][m][1][e]; }
                *(u32x4*)(H + (size_t)row * ldh + col0) = pack8f(o0, o1);
            }
    }
};

template <class Epi, bool ALIGN_EPI, int HOOKT = 0>
__device__ __forceinline__ void gemm_phase(PG8_LAS unsigned char* lds, const Gemm g, const StaticOrder& S, const Epi& E, const int tid) {
    const int wid = __builtin_amdgcn_readfirstlane(tid >> 6), lane = tid & 63, wr = wid >> 2, wc = wid & 3, fr = lane & 15, fq = lane >> 4;
    const int K = g.K, nt = K / BK, lda = g.lda;
    unsigned voffA[2], voffB[2];
#pragma unroll
    for (int i = 0; i < 2; ++i) { int R, C; stage_rc(tid * 16 + i * 8192, R, C); const int Rb = Epi::PERM ? ((R & ~31) + perm32(R & 31)) : R;
        voffA[i] = (unsigned)(R * lda + C) * 2u; voffB[i] = (unsigned)(Rb * K + C) * 2u; }
    const size_t kstep = (size_t)(BK * 2);
    const size_t hstepA = (size_t)HALF * lda * 2, hstepB = (size_t)HALF * K * 2;
    const size_t tstepA = 2 * hstepA, tstepB = 2 * hstepB;
    const unsigned ldsw = (unsigned)wid * 1024u;
    const int aoff = lds_byte(wr * 64 + fr, fq * 8), boff = lds_byte(wc * 32 + fr, fq * 8);
#define PG8_SA(b, h) (((b) * 2 + (h)) * HTB)
#define PG8_SB(b, h) ((4 + (b) * 2 + (h)) * HTB)
#define PG8_STAGE(bufoff, gbase, voff) do { _Pragma("unroll") for (int _i = 0; _i < 2; ++_i) \
        __builtin_amdgcn_global_load_lds((const unsigned*)((const char*)(gbase) + (voff)[_i]), (PG8_LAS unsigned*)(lds + (bufoff) + ldsw + _i * 8192), 16, 0, 0); } while (0)
#define PG8_LDA(dst, b, h) do { _Pragma("unroll") for (int m = 0; m < 4; ++m) _Pragma("unroll") for (int k = 0; k < 2; ++k) dst[m][k] = *(const PG8_LAS bf16x8*)(lds + PG8_SA(b, h) + aoff + m * 2048 + k * 1024); } while (0)
#define PG8_LDB(dst, b, h) do { _Pragma("unroll") for (int n = 0; n < 2; ++n) _Pragma("unroll") for (int k = 0; k < 2; ++k) dst[n][k] = *(const PG8_LAS bf16x8*)(lds + PG8_SB(b, h) + boff + n * 2048 + k * 1024); } while (0)
#define PG8_MMA(ai, bj, At, Bt) do { __builtin_amdgcn_s_setprio(1); _Pragma("unroll") for (int m = 0; m < 4; ++m) _Pragma("unroll") for (int n = 0; n < 2; ++n) _Pragma("unroll") for (int k = 0; k < 2; ++k) \
        acc[ai][bj][m][n] = __builtin_amdgcn_mfma_f32_16x16x32_bf16(Bt[n][k], At[m][k], acc[ai][bj][m][n], 0, 0, 0); __builtin_amdgcn_s_setprio(0); } while (0)
#define PG8_WAIT_V(n) asm volatile("s_waitcnt vmcnt(" #n ")" ::: "memory")
#define PG8_WAIT_L(n) asm volatile("s_waitcnt lgkmcnt(" #n ")" ::: "memory")
#define PG8_BAR __builtin_amdgcn_s_barrier()
#define PG8_SCHED __builtin_amdgcn_sched_barrier(0)
    Unit cur, nxt; int ui = 0;
    if (!S.next(0, cur)) return;
    f32x4 acc[2][2][4][2];
#pragma unroll
    for (int a = 0; a < 2; ++a)
#pragma unroll
        for (int b = 0; b < 2; ++b)
#pragma unroll
            for (int m = 0; m < 4; ++m)
#pragma unroll
                for (int n = 0; n < 2; ++n) acc[a][b][m][n] = (f32x4){0.f, 0.f, 0.f, 0.f};
    bf16x8 At[4][2], B0[2][2], B1[2][2];
    const char* cA = (const char*)g.A + (size_t)cur.pm * tstepA; const char* cB = (const char*)g.Bt + (size_t)cur.pn * tstepB;
    PG8_STAGE(PG8_SB(0, 0), cB, voffB); PG8_STAGE(PG8_SB(0, 1), cB + hstepB, voffB); PG8_STAGE(PG8_SA(0, 0), cA, voffA); PG8_STAGE(PG8_SA(0, 1), cA + hstepA, voffA);
    if (wr == 1) PG8_BAR;
    PG8_WAIT_V(2); PG8_BAR;
    PG8_STAGE(PG8_SB(1, 0), cB + kstep, voffB); PG8_STAGE(PG8_SA(1, 0), cA + kstep, voffA); PG8_STAGE(PG8_SB(1, 1), cB + hstepB + kstep, voffB);
    PG8_WAIT_V(6); PG8_BAR;
    for (;;) {
        const bool has_next = S.next(ui + 1, nxt);
        const char* nA = has_next ? (const char*)g.A + (size_t)nxt.pm * tstepA : cA; const char* nB = has_next ? (const char*)g.Bt + (size_t)nxt.pn * tstepB : cB;
        for (int t = 0; t < nt; t += 2) {
            if constexpr (HOOKT > 0) { if (t == HOOKT) { E.hook(acc, cur, wr, wc, fr, fq); PG8_SCHED; } }
            const bool last = (t == nt - 2);
            const char* a1 = cA + (size_t)(t + 1) * kstep;
            const char* a2 = last ? nA : cA + (size_t)(t + 2) * kstep; const char* b2 = last ? nB : cB + (size_t)(t + 2) * kstep;
            const char* a3 = a2 + kstep; const char* b3 = b2 + kstep;
            PG8_LDB(B0, 0, 0); PG8_LDB(B1, 0, 1); PG8_SCHED; PG8_LDA(At, 0, 0); PG8_STAGE(PG8_SA(1, 1), a1 + hstepA, voffA);
            PG8_WAIT_V(8); PG8_WAIT_L(0); PG8_BAR; PG8_MMA(0, 0, At, B0); PG8_MMA(0, 1, At, B1); PG8_BAR; PG8_SCHED;
            PG8_LDA(At, 0, 1); PG8_STAGE(PG8_SB(0, 0), b2, voffB); PG8_STAGE(PG8_SB(0, 1), b2 + hstepB, voffB); PG8_STAGE(PG8_SA(0, 0), a2, voffA);
            PG8_WAIT_V(8); PG8_WAIT_L(0); PG8_BAR; PG8_MMA(1, 0, At, B0); PG8_MMA(1, 1, At, B1); PG8_BAR; PG8_SCHED;
            PG8_LDB(B0, 1, 0); PG8_LDB(B1, 1, 1); PG8_SCHED; PG8_LDA(At, 1, 0); PG8_STAGE(PG8_SA(0, 1), a2 + hstepA, voffA);
            PG8_WAIT_V(8); PG8_WAIT_L(0); PG8_BAR; PG8_MMA(0, 0, At, B0); PG8_MMA(0, 1, At, B1); PG8_BAR; PG8_SCHED;
            PG8_LDA(At, 1, 1); PG8_STAGE(PG8_SB(1, 0), b3, voffB); PG8_STAGE(PG8_SB(1, 1), b3 + hstepB, voffB); PG8_STAGE(PG8_SA(1, 0), a3, voffA);
            PG8_WAIT_V(8); PG8_WAIT_L(0); PG8_BAR; PG8_MMA(1, 0, At, B0); PG8_MMA(1, 1, At, B1); PG8_BAR; PG8_SCHED;
        }
        if constexpr (ALIGN_EPI) { if (wr == 0) PG8_BAR; }
        E(acc, cur, wr, wc, fr, fq);
        if (!has_next) break;
#pragma unroll
        for (int a = 0; a < 2; ++a)
#pragma unroll
            for (int b = 0; b < 2; ++b)
#pragma unroll
                for (int m = 0; m < 4; ++m)
#pragma unroll
                    for (int n = 0; n < 2; ++n) acc[a][b][m][n] = (f32x4){0.f, 0.f, 0.f, 0.f};
        cur = nxt; cA = nA; cB = nB; ++ui;
        if constexpr (ALIGN_EPI) { if (wr == 1) PG8_BAR; }
    }
    PG8_WAIT_V(0);
    if constexpr (!ALIGN_EPI) { if (wr == 0) PG8_BAR; }
    PG8_BAR;
#undef PG8_SA
#undef PG8_SB
#undef PG8_STAGE
#undef PG8_LDA
#undef PG8_LDB
#undef PG8_MMA
#undef PG8_WAIT_V
#undef PG8_WAIT_L
#undef PG8_BAR
#undef PG8_SCHED
}
}
namespace att {
typedef unsigned short bf16;
typedef short bf16x8 __attribute__((ext_vector_type(8)));
typedef short s16x4 __attribute__((ext_vector_type(4)));
typedef float f32x16 __attribute__((ext_vector_type(16)));
typedef float f32x4 __attribute__((ext_vector_type(4)));
typedef unsigned u32x4 __attribute__((ext_vector_type(4)));
constexpr int D = 128;
constexpr float SCALE = 0.08838834764831845f;
constexpr float THR = 8.f;
constexpr int NW = 8, QBLK = 32, KVBLK = 64, QB = NW * QBLK;
constexpr int SHM_V = KVBLK * D * 2, SHM_K = KVBLK * D * 2;
constexpr int LDS_BYTES = 2 * SHM_V + 2 * SHM_K + NW * 64 * 4;
constexpr int LDS_QIMG = LDS_BYTES + 32, LDS_TOTAL = LDS_QIMG + NW * 8192;

#define KSWZ(row, colB) ((row) * 256 + ((colB) ^ (((row) & 7) << 4)))
#define SBAR() __builtin_amdgcn_sched_barrier(0)
__device__ __forceinline__ int v_st(int k, int c) { const int kk = (k & ~0xC) | ((k & 4) << 1) | ((k & 8) >> 1); return ((kk >> 3) * 4 + (c >> 5)) * 512 + ((kk & 7) * 32 + (c & 31)) * 2; }
__device__ __forceinline__ int v_rd_base(int lane) { return ((lane & 3) << 3) | (((lane >> 2) & 3) << 6) | (((lane >> 4) & 1) << 5) | (((lane >> 5) & 1) << 8); }
constexpr int v_rd_off(int d0, int ks, int half) { return d0 * 512 + ks * 4096 + half * 2048; }
__device__ __forceinline__ int crow(int r, int hi) { return (r & 3) + 8 * (r >> 2) + 4 * hi; }
__device__ __forceinline__ unsigned cvtpk(float lo, float hi) { unsigned r; asm volatile("v_cvt_pk_bf16_f32 %0, %1, %2" : "=v"(r) : "v"(lo), "v"(hi)); return r; }
__device__ __forceinline__ bf16x8 load8(const bf16* p) { return *reinterpret_cast<const bf16x8*>(p); }
template <bool ZERO>
__device__ __forceinline__ void mask_tile(f32x16& p0, f32x16& p1, int dq) {
    const float NEG = ZERO ? 0.f : -__builtin_inff();
#pragma unroll
    for (int r = 0; r < 16; ++r) {
        const int c = (r & 3) + 8 * (r >> 2);
        if (dq - c < 0) p0[r] = NEG;
        if (dq - c - 32 < 0) p1[r] = NEG;
    }
}
__device__ __forceinline__ void partialSM(f32x16& p0, f32x16& p1, float& m_reg, float& mn, float& alpha) {
    float pmax = p0[0]; for (int r = 1; r < 16; ++r) pmax = fmaxf(pmax, p0[r]); for (int r = 0; r < 16; ++r) pmax = fmaxf(pmax, p1[r]);
    { auto rr = __builtin_amdgcn_permlane32_swap(__float_as_uint(pmax), __float_as_uint(pmax), false, false);
      pmax = fmaxf(__uint_as_float(rr[0]), __uint_as_float(rr[1])); }
    constexpr float C2 = 1.4426950408889634f * SCALE;
    if (__builtin_expect(__all((pmax - m_reg) * SCALE <= THR), 1)) { mn = m_reg; alpha = 1.f; }
    else { mn = fmaxf(m_reg, pmax); alpha = __builtin_amdgcn_exp2f((m_reg - mn) * C2); m_reg = mn; }
    const float mnL = -mn * C2;
    for (int r = 0; r < 16; ++r) p0[r] = fmaf(p0[r], C2, mnL); for (int r = 0; r < 16; ++r) p1[r] = fmaf(p1[r], C2, mnL);
    for (int r = 0; r < 16; ++r) p0[r] = __builtin_amdgcn_exp2f(p0[r]);
}
#define ATT_PK4(P, B_, OUT) do { unsigned a0 = cvtpk(P[B_+0], P[B_+1]), a1 = cvtpk(P[B_+2], P[B_+3]);                          \
        unsigned b0 = cvtpk(P[B_+4], P[B_+5]), b1 = cvtpk(P[B_+6], P[B_+7]);                                             \
        auto r0 = __builtin_amdgcn_permlane32_swap(a0, b0, false, false); auto r1 = __builtin_amdgcn_permlane32_swap(a1, b1, false, false); \
        u32x4 w = {r0[0], r1[0], r0[1], r1[1]}; OUT = *reinterpret_cast<bf16x8*>(&w); } while (0)
__device__ __forceinline__ void finishSM(f32x16& p0, f32x16& p1, float alpha, float& l_reg, bf16x8& pa0, bf16x8& pa1, bf16x8& pa2, bf16x8& pa3) {
    for (int r = 0; r < 16; ++r) p1[r] = __builtin_amdgcn_exp2f(p1[r]);
    float ps = 0; for (int r = 0; r < 16; ++r) ps += p0[r]; for (int r = 0; r < 16; ++r) ps += p1[r];
    { auto rr = __builtin_amdgcn_permlane32_swap(__float_as_uint(ps), __float_as_uint(ps), false, false);
      ps = __uint_as_float(rr[0]) + __uint_as_float(rr[1]); }
    l_reg = l_reg * alpha + ps;
    ATT_PK4(p0, 0, pa0); ATT_PK4(p0, 8, pa1); ATT_PK4(p1, 0, pa2); ATT_PK4(p1, 8, pa3);
}
__device__ __forceinline__ void partialLin(f32x16& p0, f32x16& p1, float f) {
    for (int r = 0; r < 16; ++r) { p0[r] *= f; p1[r] *= f; }
}
__device__ __forceinline__ void finishLin(f32x16& p0, f32x16& p1, float& den, bf16x8& pa0, bf16x8& pa1, bf16x8& pa2, bf16x8& pa3) {
    float ps = 0; for (int r = 0; r < 16; ++r) ps += p0[r]; for (int r = 0; r < 16; ++r) ps += p1[r];
    den += ps;
    ATT_PK4(p0, 0, pa0); ATT_PK4(p0, 8, pa1); ATT_PK4(p1, 0, pa2); ATT_PK4(p1, 8, pa3);
}
template <int KB, bool QL>
__device__ __forceinline__ void qkt(f32x16& p0, f32x16& p1, const char* K_lds, int r32, int hi, const bf16x8* qr, const char* qlds) {
    p0 = f32x16{}; p1 = f32x16{};
    const char* kb[4];
#pragma unroll
    for (int dd = 0; dd < 4; ++dd) kb[dd] = K_lds + KB * SHM_K + KSWZ(r32, (dd * 16 + hi * 8) * 2);
#pragma unroll
    for (int d0 = 0; d0 < 8; ++d0) { const char* a = kb[d0 & 3] + (d0 >> 2) * 128;
        bf16x8 b0 = *reinterpret_cast<const bf16x8*>(a);
        bf16x8 b1 = *reinterpret_cast<const bf16x8*>(a + 32 * 256);
        bf16x8 qf; if constexpr (QL) qf = *reinterpret_cast<const bf16x8*>(qlds + d0 * 1024); else qf = qr[d0];
        p0 = __builtin_amdgcn_mfma_f32_32x32x16_bf16(b0, qf, p0, 0, 0, 0);
        p1 = __builtin_amdgcn_mfma_f32_32x32x16_bf16(b1, qf, p1, 0, 0, 0); }
}
template <int VB>
__device__ __forceinline__ void pv_tile(f32x16* o, int vb0, bf16x8 pa0, bf16x8 pa1, bf16x8 pa2, bf16x8 pa3) {
#define TRRD(dst, off) asm volatile("ds_read_b64_tr_b16 %0, %1 offset:%2" : "=&v"(dst) : "v"(vb0), "i"(off) : "memory")
#define PV_D0(d0) do { s16x4 l0, l1, l2, l3, h0, h1, h2, h3; constexpr int b_ = VB * SHM_V + v_rd_off(d0, 0, 0); \
        TRRD(l0, b_); TRRD(h0, b_ + 2048); TRRD(l1, b_ + 4096); TRRD(h1, b_ + 6144); TRRD(l2, b_ + 8192); TRRD(h2, b_ + 10240); TRRD(l3, b_ + 12288); TRRD(h3, b_ + 14336); \
        asm volatile("s_waitcnt lgkmcnt(0)" ::: "memory"); SBAR();   \
        o[d0] = __builtin_amdgcn_mfma_f32_32x32x16_bf16(pa0, (bf16x8){l0[0], l0[1], l0[2], l0[3], h0[0], h0[1], h0[2], h0[3]}, o[d0], 0, 0, 0);   \
        o[d0] = __builtin_amdgcn_mfma_f32_32x32x16_bf16(pa1, (bf16x8){l1[0], l1[1], l1[2], l1[3], h1[0], h1[1], h1[2], h1[3]}, o[d0], 0, 0, 0);   \
        o[d0] = __builtin_amdgcn_mfma_f32_32x32x16_bf16(pa2, (bf16x8){l2[0], l2[1], l2[2], l2[3], h2[0], h2[1], h2[2], h2[3]}, o[d0], 0, 0, 0);   \
        o[d0] = __builtin_amdgcn_mfma_f32_32x32x16_bf16(pa3, (bf16x8){l3[0], l3[1], l3[2], l3[3], h3[0], h3[1], h3[2], h3[3]}, o[d0], 0, 0, 0); } while (0)
    PV_D0(0); PV_D0(1); PV_D0(2); PV_D0(3);
#undef PV_D0
#undef TRRD
}

struct BlockRef { const bf16* Q; const bf16* K; const bf16* V; float* O; int P0; };
struct LinRef { const float* MT; const float* EMT; const float* REF; };
struct Seam { bf16x8 qr[8]; bf16x8 st_v0, st_v1, st_k0, st_k1; };

#define ATT_VMW() asm volatile("s_waitcnt vmcnt(0)" ::: "memory")
#define ATT_VMWN(n) asm volatile("s_waitcnt vmcnt(%0)" :: "i"(n) : "memory")
__device__ __forceinline__ bf16x8 load8o(const bf16* base, unsigned voff) { return *reinterpret_cast<const bf16x8*>(reinterpret_cast<const char*>(base) + voff); }
template <class T> __device__ __forceinline__ T* uni(T* p) {
    const unsigned long long u = (unsigned long long)p; const unsigned lo = __builtin_amdgcn_readfirstlane((unsigned)u), hi = __builtin_amdgcn_readfirstlane((unsigned)(u >> 32));
    return (T*)(((unsigned long long)hi << 32) | lo); }
#define ATT_SLOAD(Kp, Vp, k0) do { const bf16* vb_ = uni((Vp) + (size_t)(k0) * LDV); const bf16* kb_ = uni((Kp) + (size_t)(k0) * LDK);                                         \
                                   S.st_v0 = load8o(vb_, offV); S.st_v1 = load8o(vb_, offV + 32u * LDV * 2u);              \
                                   S.st_k0 = load8o(kb_, offK); S.st_k1 = load8o(kb_, offK + 32u * LDK * 2u); } while (0)
#define ATT_SWRITE_K(bf) do { *(bf16x8*)(K_lds + (bf) * SHM_K + kws) = S.st_k0; *(bf16x8*)(K_lds + (bf) * SHM_K + kws + 32 * 256) = S.st_k1; } while (0)
#define ATT_SWRITE_V(bf) do { *(bf16x8*)(V_lds + (bf) * SHM_V + vst0) = S.st_v0; *(bf16x8*)(V_lds + (bf) * SHM_V + vst1) = S.st_v1; } while (0)

template <int LDQ, int LDK, int LDV>
__device__ __forceinline__ void prime(const BlockRef& cur, char* lds, Seam& S, const int tid) {
    const int wid = __builtin_amdgcn_readfirstlane(tid >> 6), lane = tid & 63, r32 = lane & 31, hi = lane >> 5;
    const int sr = tid >> 4, sc = (tid & 15) * 8, kws = KSWZ(sr, sc * 2); char* K_lds = lds + 2 * SHM_V;
    const unsigned offV = (unsigned)(sr * LDV + sc) * 2u, offK = (unsigned)(sr * LDK + sc) * 2u, offQ = (unsigned)(r32 * LDQ + hi * 8) * 2u;
    { const bf16* qb_ = uni(cur.Q + (size_t)(wid * QBLK) * LDQ);
#pragma unroll
    for (int d0 = 0; d0 < 8; ++d0) S.qr[d0] = load8o(qb_, offQ + d0 * 32u); }
    ATT_SLOAD(cur.K, cur.V, 0); ATT_VMW(); ATT_SWRITE_K(0);
    __syncthreads();
}

__device__ __forceinline__ void put_next(char* lds, const BlockRef& nxt, const int tid) {
    if (tid == 0) { volatile unsigned long long* p = (volatile unsigned long long*)(lds + LDS_BYTES); p[0] = (unsigned long long)nxt.Q; p[1] = (unsigned long long)nxt.K; p[2] = (unsigned long long)nxt.V; }
}
__device__ __forceinline__ const bf16* get_next(char* lds, int k) {
    const volatile unsigned* p = (const volatile unsigned*)(lds + LDS_BYTES) + 2 * k; const unsigned lo = p[0], hi = p[1];
    return (const bf16*)(((unsigned long long)(unsigned)__builtin_amdgcn_readfirstlane(hi) << 32) | (unsigned)__builtin_amdgcn_readfirstlane(lo));
}
template <int LDQ, int LDK, int LDV, int LDO, int MODE>
__device__ __forceinline__ void block(const BlockRef& cur, char* lds, Seam& S, float lam, const LinRef& lr, const int tid) {
    constexpr bool LIN = (MODE == 2);
    const int wid = __builtin_amdgcn_readfirstlane(tid >> 6), lane = tid & 63, r32 = lane & 31, hi = lane >> 5;
    const int NT = cur.P0 / KVBLK + QB / KVBLK;
    const int qlo = cur.P0 + wid * QBLK, qm = qlo + r32 - 4 * hi;
    char* V_lds = lds; char* K_lds = lds + 2 * SHM_V;
    float* ws = (float*)(lds + 2 * SHM_V + 2 * SHM_K) + wid * 64; float* li_l = ws, * al_l = ws + 32;
    float m_reg = -1e30f, l_reg = 0; f32x16 o[4] = {};
    const int sr = tid >> 4, sc = (tid & 15) * 8, vst0 = v_st(sr, sc), vst1 = v_st(32 + sr, sc), kws = KSWZ(sr, sc * 2);
    const int vb0 = (int)(uintptr_t)V_lds + v_rd_base(lane);
    const bf16* Kh = cur.K; const bf16* Vh = cur.V;
    const unsigned offV = (unsigned)(sr * LDV + sc) * 2u, offK = (unsigned)(sr * LDK + sc) * 2u, offQ = (unsigned)(r32 * LDQ + hi * 8) * 2u;
    float Mt = 0.f; if constexpr (LIN) Mt = *reinterpret_cast<const float*>(reinterpret_cast<const char*>(uni(lr.MT + qlo)) + (unsigned)r32 * 4u);
#define ATT_RESC(a) do { if constexpr (!LIN) { if (__any((a) < 1.f)) { if (hi == 0) al_l[r32] = (a); asm volatile("s_waitcnt lgkmcnt(0)" ::: "memory");              \
                     for (int d_ = 0; d_ < 4; ++d_) for (int r = 0; r < 16; ++r) o[d_][r] *= al_l[crow(r, hi)]; } } } while (0)
#define ATT_KBASE(t) ((t) * KVBLK)
#define ATT_MASKT(P0_, P1_, t) do { const int kb_ = ATT_KBASE(t); if (kb_ + KVBLK - 1 > qlo) mask_tile<LIN>(P0_, P1_, qm - kb_); } while (0)
#define ATT_PSM(P0_, P1_, mnX, alX, t) do { if constexpr (LIN) { mnX = __builtin_amdgcn_exp2f((lr.REF[t] - Mt) * 1.4426950408889634f); } \
                                            else partialSM(P0_, P1_, m_reg, mnX, alX); } while (0)
#define ATT_FSM(P0_, P1_, alY, mnY) do { if constexpr (LIN) { partialLin(P0_, P1_, mnY); finishLin(P0_, P1_, l_reg, pa0, pa1, pa2, pa3); } else finishSM(P0_, P1_, alY, l_reg, pa0, pa1, pa2, pa3); } while (0)
#define ATT_SEAM_K0() do { ATT_VMW(); ATT_SWRITE_K(0); SBAR(); } while (0)
    f32x16 pA0, pA1, pB0, pB1; float mnA = 0.f, mnB = 0.f, alA = 1.f, alB = 1.f; bf16x8 pa0, pa1, pa2, pa3;
    ATT_SWRITE_V(0); SBAR();
    const char* qlds = lds + LDS_QIMG + wid * 8192 + lane * 16;
    if constexpr (LIN) {
#pragma unroll
        for (int d0 = 0; d0 < 8; ++d0) *reinterpret_cast<bf16x8*>(const_cast<char*>(qlds) + d0 * 1024) = S.qr[d0];
    }
    if (NT > 1) ATT_SLOAD(Kh, Vh, ATT_KBASE(1));
    SBAR(); qkt<0, LIN>(pA0, pA1, K_lds, r32, hi, S.qr, qlds);
    ATT_MASKT(pA0, pA1, 0); ATT_PSM(pA0, pA1, mnA, alA, 0);
    if (NT > 1) { ATT_VMW(); ATT_SWRITE_V(1); ATT_SWRITE_K(1); }
    __syncthreads();
#define ATT_HALF_STEP(PX0, PX1, mnX, alX, PY0, PY1, alY, mnY, t, KB, VB, SB) do {                                                      \
        SBAR(); qkt<KB, LIN>(PX0, PX1, K_lds, r32, hi, S.qr, qlds);                                             \
        ATT_FSM(PY0, PY1, alY, mnY); SBAR();                                                           \
        if ((t) + 1 < NT) { ATT_SLOAD(Kh, Vh, ATT_KBASE((t) + 1)); SBAR(); }                                               \
        pv_tile<VB>(o, vb0, pa0, pa1, pa2, pa3); ATT_MASKT(PX0, PX1, (t)); ATT_PSM(PX0, PX1, mnX, alX, (t));                                        \
        __syncthreads();                                                                                                      \
        if ((t) + 1 < NT) { ATT_VMW(); ATT_SWRITE_V(SB); ATT_SWRITE_K(SB); }                                                                          \
        ATT_RESC(alX); __syncthreads(); } while (0)
    for (int t = 1; t + 1 < NT; t += 2) {
        ATT_HALF_STEP(pB0, pB1, mnB, alB, pA0, pA1, alA, mnA, t, 1, 0, 0);
        ATT_HALF_STEP(pA0, pA1, mnA, alA, pB0, pB1, alB, mnB, t + 1, 0, 1, 1);
    }
    SBAR(); qkt<1, LIN>(pB0, pB1, K_lds, r32, hi, S.qr, qlds); SBAR();
    { const bf16* nK = get_next(lds, 1); const bf16* nV = get_next(lds, 2); ATT_SLOAD(nK, nV, 0); } SBAR();
    ATT_FSM(pA0, pA1, alA, mnA); SBAR();
    pv_tile<0>(o, vb0, pa0, pa1, pa2, pa3);
    ATT_MASKT(pB0, pB1, NT - 1); ATT_PSM(pB0, pB1, mnB, alB, NT - 1); __syncthreads(); ATT_RESC(alB);
    ATT_FSM(pB0, pB1, alB, mnB); SBAR(); pv_tile<1>(o, vb0, pa0, pa1, pa2, pa3);
    SBAR(); ATT_SEAM_K0();
    { const bf16* qb_ = uni(get_next(lds, 0) + (size_t)(wid * QBLK) * LDQ);
#pragma unroll
    for (int d0 = 0; d0 < 8; ++d0) S.qr[d0] = load8o(qb_, offQ + d0 * 32u); }
    SBAR();
    if constexpr (LIN) { auto rr = __builtin_amdgcn_permlane32_swap(__float_as_uint(l_reg), __float_as_uint(l_reg), false, false); l_reg = __uint_as_float(rr[0]) + __uint_as_float(rr[1]); }
    if (hi == 0) li_l[r32] = l_reg; asm volatile("s_waitcnt lgkmcnt(0)" ::: "memory");
    float rli[16];
    const float* emtp = LIN ? reinterpret_cast<const float*>(reinterpret_cast<const char*>(uni(lr.EMT + (cur.P0 + wid * QBLK))) + (unsigned)hi * 16u) : nullptr;
#pragma unroll
    for (int r = 0; r < 16; ++r) {
        const float lv = li_l[crow(r, hi)];
        if constexpr (LIN) { const float em = emtp[(r & 3) + 8 * (r >> 2)]; rli[r] = __builtin_amdgcn_rcpf(fmaxf(fabsf(lv), em)); }
        else rli[r] = __builtin_amdgcn_rcpf(lv);
    }
    char* Ow = reinterpret_cast<char*>(uni(cur.O + (size_t)(wid * QBLK) * LDO));
    const unsigned offO = (unsigned)(4 * hi * LDO + r32) * 4u;
#pragma unroll
    for (int r = 0; r < 16; ++r) {
#pragma unroll
        for (int d0 = 0; d0 < 4; ++d0) { const float v = o[d0][r] * rli[r];
            float* p = reinterpret_cast<float*>(Ow + (offO + (unsigned)((((r & 3) + 8 * (r >> 2)) * LDO + d0 * 32) * 4)));
            if constexpr (MODE == 1) { const float prev = *p; *p = prev - lam * v; }
            else *p = v; } }
    __syncthreads();
#undef ATT_RESC
#undef ATT_KBASE
#undef ATT_MASKT
#undef ATT_PSM
#undef ATT_FSM
#undef ATT_SEAM_K0
#undef ATT_HALF_STEP
}
#undef ATT_VMW
#undef ATT_VMWN
#undef ATT_SLOAD
#undef ATT_SWRITE_K
#undef ATT_SWRITE_V
#undef ATT_PK4
#undef KSWZ
#undef SBAR
}
constexpr int NWAVES = 8;
constexpr int DM = 2048, NB = 8, SEQ = 4096, DEPTH = 4, M = NB * SEQ;
constexpr int DIN = 13320, NP = 13312, DFF = 5632, NGU = 2 * DFF;
constexpr int KMRG = 3072;
constexpr int C_MQK = 0, C_MV = 1024, C_MO = 2048, C_AQ = 3072, C_AK = 5120, C_AV = 7168, C_GM = 9216, C_GA = 11264;
constexpr float EPS = 1e-6f;
#ifndef DBG
#define DBG 0
#endif

constexpr size_t MiB = 1u << 20;
constexpr size_t WS_CTL = 0, CTL_ZERO_BYTES = 1 * MiB;
constexpr size_t WS_ROPE = 2 * MiB;
constexpr size_t WS_LIF = 6 * MiB;
constexpr size_t WS_MT = 7 * MiB;
constexpr size_t WS_EMT = WS_MT + 512 * 1024;
constexpr size_t WS_KSC = 8 * MiB;
constexpr size_t WS_REF = WS_KSC + 512 * 1024;
constexpr size_t WS_WIN = 16 * MiB, WS_PM = 68 * MiB, WS_PA = 72 * MiB, WS_WO = 80 * MiB, WS_WGU = 88 * MiB, WS_WD = 132 * MiB;
constexpr size_t WS_HY = 154 * MiB;
constexpr size_t WS_QKM = 282 * MiB;
constexpr size_t WS_HT = 346 * MiB;
constexpr size_t WS_OST = 474 * MiB;
constexpr size_t WS_PROJ = 730 * MiB;
constexpr size_t WS_END = 1562 * MiB;
static_assert(WS_PROJ + (size_t)M * NP * 2 == WS_END, "ws map");
constexpr int CW_BAR = 4096;

constexpr int RING_OFF = 0, RING_BYTES = 135168;
constexpr int LDSCTL_OFF = RING_BYTES, MISC_OFF = LDSCTL_OFF + 320;
constexpr int LDS_BYTES = 147456;

#define GAS __attribute__((address_space(1)))
#define LAS __attribute__((address_space(3)))
typedef unsigned short bf16;
typedef unsigned v4u __attribute__((ext_vector_type(4)));
typedef unsigned v2u __attribute__((ext_vector_type(2)));
typedef float f32x4 __attribute__((ext_vector_type(4)));
typedef GAS unsigned gu32;
#define LDS_WAIT() asm volatile("s_waitcnt lgkmcnt(0)" ::: "memory")
#define VM_WAIT() asm volatile("s_waitcnt vmcnt(0)" ::: "memory")
__device__ __forceinline__ unsigned f2bf(float f) { unsigned u = __builtin_bit_cast(unsigned, f); return (u + 0x7fffu + ((u >> 16) & 1u)) >> 16; }
__device__ __forceinline__ unsigned pk2(float lo, float hi) { return f2bf(lo) | (f2bf(hi) << 16); }
__device__ __forceinline__ float bflo(unsigned u) { return __uint_as_float(u << 16); }
__device__ __forceinline__ float bfhi(unsigned u) { return __uint_as_float(u & 0xffff0000u); }
__device__ __forceinline__ float bf2f(bf16 h) { return __uint_as_float((unsigned)h << 16); }
#define SWZ_XOR(v, o) __uint_as_float((unsigned)__builtin_amdgcn_ds_swizzle((int)__float_as_uint(v), ((o) << 10) | 0x1f))
__device__ __forceinline__ float xhalf(float v, bool is_max) { auto rr = __builtin_amdgcn_permlane32_swap(__float_as_uint(v), __float_as_uint(v), false, false);
    const float a = __uint_as_float(rr[0]), b = __uint_as_float(rr[1]); return is_max ? fmaxf(a, b) : a + b; }
__device__ __forceinline__ float wave_sum(float v) {
    v += SWZ_XOR(v, 1); v += SWZ_XOR(v, 2); v += SWZ_XOR(v, 4); v += SWZ_XOR(v, 8); v += SWZ_XOR(v, 16);
    return xhalf(v, false);
}
__device__ __forceinline__ float shfl_up_l(float v, int o, int lane) { return __uint_as_float((unsigned)__builtin_amdgcn_ds_bpermute(((lane - o) & 63) << 2, (int)__float_as_uint(v))); }
__device__ __forceinline__ float sigmoidf_(float x) { return 1.0f / (1.0f + __expf(-x)); }

#define XB_TMO      128
#define XB_XCNT(j)  (256  + 64 * (j))
#define XB_XSUB(j)  (1280 + 64 * (j))
#define XB_XGEN(j)  (2304 + 64 * (j))
#define XB_TOP      3328
#define XB_TOPGEN   3392
#define XCD_BAR_WORDS 3456
#define XB_SPIN_CAP (1u << 18)
__device__ __forceinline__ unsigned xb_ld(unsigned* p)              { return __hip_atomic_load(p, __ATOMIC_RELAXED, __HIP_MEMORY_SCOPE_AGENT); }
__device__ __forceinline__ unsigned xb_add(unsigned* p, unsigned v) { return __hip_atomic_fetch_add(p, v, __ATOMIC_RELAXED, __HIP_MEMORY_SCOPE_AGENT); }
__device__ __forceinline__ unsigned xb_xcc_id() { return (unsigned)__builtin_amdgcn_s_getreg((3 << 11) | 20) & 0xFu; }
#define XB_SPIN(cond, bar) do { unsigned _sp = 0; while (cond) { __builtin_amdgcn_s_sleep(1); \
    if ((++_sp & 255u) == 0u) { if (xb_ld(&(bar)[XB_TMO])) break; if (_sp > XB_SPIN_CAP) { atomicAdd(&(bar)[XB_TMO], 1u); break; } } } } while (0)
struct XcdBarrier { unsigned* bar; unsigned x; volatile LAS unsigned* st; };
__device__ __forceinline__ XcdBarrier xcd_barrier_post(unsigned* bar, volatile LAS unsigned* st) {
    XcdBarrier b; b.bar = bar; b.x = xb_xcc_id(); b.st = st;
    if (threadIdx.x == 0) (void)xb_add(&bar[XB_XCNT(b.x)], 1u);
    return b;
}
__device__ __forceinline__ void xcd_barrier_complete(unsigned* bar, unsigned x, unsigned& nloc, unsigned& nx) {
    const unsigned G = gridDim.x * gridDim.y * gridDim.z;
    unsigned sum, cnt, mine, sp = 0u;
    for (;;) {
        sum = 0u; cnt = 0u; mine = 0u;
#pragma unroll
        for (unsigned j = 0; j < 16; ++j) { const unsigned c = xb_ld(&bar[XB_XCNT(j)]); sum += c; cnt += (c > 0u) ? 1u : 0u; mine = (j == x) ? c : mine; }
        if (sum == G) break;
        __builtin_amdgcn_s_sleep(1);
        if ((++sp & 255u) == 0u) { if (xb_ld(&bar[XB_TMO])) break; if (sp > XB_SPIN_CAP) { atomicAdd(&bar[XB_TMO], 1u); break; } }
    }
    nloc = mine > 0u ? mine : 1u; nx = cnt > 0u ? cnt : 1u;
}
__device__ __forceinline__ void xcd_barrier(const XcdBarrier& b) {
    asm volatile("s_waitcnt vmcnt(0)" ::: "memory");
    __syncthreads();
    if (threadIdx.x == 0) {
        unsigned* bar = b.bar;
        __builtin_amdgcn_s_waitcnt(0);
        unsigned nloc = b.st[0], nx = b.st[1];
        if (nloc == 0u) { xcd_barrier_complete(bar, b.x, nloc, nx); b.st[0] = nloc; b.st[1] = nx; }
        const unsigned old = xb_add(&bar[XB_XSUB(b.x)], 1u);
        const unsigned gen = old / nloc;
        if (old + 1u == (gen + 1u) * nloc) {
            __builtin_amdgcn_fence(__ATOMIC_RELEASE, "agent");
            asm volatile("s_waitcnt vmcnt(0)" ::: "memory");
            const unsigned og = xb_add(&bar[XB_TOP], 1u);
            const unsigned tg = og / nx;
            if (og + 1u == (tg + 1u) * nx) xb_add(&bar[XB_TOPGEN], 1u);
            else XB_SPIN(xb_ld(&bar[XB_TOPGEN]) == tg, bar);
            __builtin_amdgcn_fence(__ATOMIC_ACQUIRE, "agent");
            xb_add(&bar[XB_XGEN(b.x)], 1u);
            asm volatile("s_waitcnt vmcnt(0)" ::: "memory");
        } else {
            XB_SPIN(xb_ld(&bar[XB_XGEN(b.x)]) == gen, bar);
            __builtin_amdgcn_fence(__ATOMIC_ACQUIRE, "agent");
            asm volatile("s_waitcnt vmcnt(0)" ::: "memory");
        }
    }
    __syncthreads();
}

__device__ const double ROPE_INV[16] = {1.0, 0.44036660267178046, 0.19392274474868576, 0.08539710028576561, 0.03760603093086393, 0.016560440080994446, 0.007292664737217109, 0.003211445994752591,
    0.001414213562373095, 0.000622772421914596, 0.0002742481756762073, 0.00012076973741146504, 5.318295896944988e-05, 2.341999896140934e-05, 1.031338537721246e-05, 4.5416704806078695e-06};

__device__ __forceinline__ void rope_table_phase(const int* pos, float* rope, int gtid, int gthreads) {
    for (int idx = gtid; idx < M * 16; idx += gthreads) {
        const int row = idx >> 4, i = idx & 15;
        const float angf = (float)pos[row] * (float)ROPE_INV[i];
        const double rev = (double)angf * 0.15915494309189535;
        const float fr = (float)(rev - __builtin_rint(rev));
        rope[(size_t)row * 32 + i] = __builtin_amdgcn_cosf(fr);
        rope[(size_t)row * 32 + 16 + i] = __builtin_amdgcn_sinf(fr);
    }
}

__device__ __forceinline__ void tr_item64(const float* W, int ldw, int ldk, bf16* WT, int k0, int k0d, int n0d, int n0s, bool ropeperm, LAS float* scr, int lane) {
    const int c = lane & 15, rr = lane >> 4;
    f32x4 v[16];
    const float* src = W + (size_t)(k0 + rr) * ldw + n0s + 4 * c;
#pragma unroll
    for (int i = 0; i < 16; ++i) v[i] = *(const GAS f32x4*)(src + (size_t)(4 * i) * ldw);
#pragma unroll
    for (int i = 0; i < 16; ++i) { LAS float* d = scr + (4 * c) * 65 + 4 * i + rr; d[0] = v[i].x; d[65] = v[i].y; d[130] = v[i].z; d[195] = v[i].w; }
    LDS_WAIT(); asm volatile("" ::: "memory");
    const int c8 = lane & 7;
#pragma unroll
    for (int j = 0; j < 8; ++j) { const int n = 8 * j + (lane >> 3); const int ns = (ropeperm && n < 32) ? ((n >> 1) + 16 * (n & 1)) : n; const LAS float* s = scr + ns * 65 + 8 * c8;
        v4u o; o.x = pk2(s[0], s[1]); o.y = pk2(s[2], s[3]); o.z = pk2(s[4], s[5]); o.w = pk2(s[6], s[7]);
        *(GAS v4u*)(WT + (size_t)(n0d + n) * ldk + k0d + 8 * c8) = o; }
    LDS_WAIT(); asm volatile("" ::: "memory");
}

__device__ __forceinline__ void convert_weights_phase(int l, const float* w_in, const float* p_m, const float* p_a, const float* w_out, const float* w_gate, const float* w_up, const float* w_down,
                                                      unsigned char* ws, LAS float* scr, int gw, int ngw, int lane) {
    constexpr int I1 = (DM / 64) * (NP / 64), I2 = (1024 / 64) * (DM / 64), I3 = (DM / 64) * (DM / 64), I4 = I3, I5 = (DM / 64) * (NGU / 64), I6 = (DFF / 64) * (DM / 64);
    constexpr int NIT = I1 + I2 + I3 + I4 + I5 + I6;
    for (int it = gw; it < NIT; it += ngw) {
        int r = it; const float* W; int ldw, K, nblk, koff = 0; size_t wsoff; int mode;
        if (r < I1) { W = w_in + (size_t)l * DM * DIN; ldw = DIN; K = DM; nblk = NP / 64; wsoff = WS_WIN; mode = 1; }
        else if ((r -= I1) < I2) { W = p_m + (size_t)l * 1024 * DM; ldw = DM; K = KMRG; nblk = DM / 64; wsoff = WS_PM; mode = 0; }
        else if ((r -= I2) < I3) { W = p_a + (size_t)l * DM * DM; ldw = DM; K = KMRG; koff = 1024; nblk = DM / 64; wsoff = WS_PM; mode = 0; }
        else if ((r -= I3) < I4) { W = w_out + (size_t)l * DM * DM; ldw = DM; K = DM; nblk = DM / 64; wsoff = WS_WO; mode = 0; }
        else if ((r -= I4) < I5) { W = nullptr; ldw = DFF; K = DM; nblk = NGU / 64; wsoff = WS_WGU; mode = 2; }
        else { r -= I5; W = w_down + (size_t)l * DFF * DM; ldw = DM; K = DFF; nblk = DM / 64; wsoff = WS_WD; mode = 0; }
        const int kb = r / nblk, nb = r % nblk, n0d = nb * 64; int n0s = n0d; bool rp = false;
        if (mode == 1) { n0s = n0d < 3072 ? n0d : n0d + 8; rp = (n0d >= C_AQ && n0d < C_AV && (n0d & 127) == 0); }
        if (mode == 2) { const int pn = n0d >> 8, r0 = n0d & 255; W = (r0 < 128 ? w_gate : w_up) + (size_t)l * DM * DFF; n0s = pn * 128 + (r0 & 127); }
        tr_item64(W, ldw, K, (bf16*)(ws + wsoff), kb * 64, koff + kb * 64, n0d, n0s, rp, scr, lane);
    }
}

__device__ __forceinline__ void norm_row(const float* xrow, const float* g, bf16* orow, int lane, f32x4 (&v)[8]) {
    const GAS f32x4* xr = (const GAS f32x4*)xrow + lane; const GAS f32x4* gr = (const GAS f32x4*)g + lane;
    float s = 0.f;
#pragma unroll
    for (int j = 0; j < 8; ++j) { v[j] = xr[64 * j]; s += (v[j].x * v[j].x + v[j].y * v[j].y) + (v[j].z * v[j].z + v[j].w * v[j].w); }
    const float rstd = 1.0f / sqrtf(wave_sum(s) * (1.f / DM) + EPS);
    GAS unsigned long long* o8 = (GAS unsigned long long*)orow + lane;
#pragma unroll
    for (int j = 0; j < 8; ++j) { const f32x4 gg = gr[64 * j]; v[j] = v[j] * rstd * gg;
        o8[64 * j] = (unsigned long long)pk2(v[j].x, v[j].y) | ((unsigned long long)pk2(v[j].z, v[j].w) << 32); }
}

__device__ __forceinline__ void mlstm_scan(int b, int h, const float* LIF, float* KSC, float* MT, float* EMT, float* REF, LAS float* sm, int tid) {
    const int lane = tid & 63, wave = tid >> 6;
    const float* base = LIF + (size_t)(b * SEQ) * 8;
    float li[8], c[8]; float run = 0.f;
#pragma unroll
    for (int j = 0; j < 8; ++j) { const int s = 8 * tid + j; li[j] = base[(size_t)s * 8 + h]; run += base[(size_t)s * 8 + 4 + h]; c[j] = run; }
    float inc = run;
#pragma unroll
    for (int o = 1; o < 64; o <<= 1) { const float vv = shfl_up_l(inc, o, lane); if (lane >= o) inc += vv; }
    if (lane == 63) sm[wave] = inc;
    __syncthreads();
    float woff = 0.f; for (int w = 0; w < wave; ++w) woff += sm[w];
    const float excl = woff + inc - run;
    float a[8], bs[8]; float lmax = -__builtin_inff();
#pragma unroll
    for (int j = 0; j < 8; ++j) { bs[j] = excl + c[j]; a[j] = li[j] - bs[j]; lmax = fmaxf(lmax, a[j]); }
    float tmax = lmax; tmax = fmaxf(tmax, SWZ_XOR(tmax, 1)); tmax = fmaxf(tmax, SWZ_XOR(tmax, 2)); tmax = fmaxf(tmax, SWZ_XOR(tmax, 4));
    float pm = lmax;
#pragma unroll
    for (int o = 1; o < 64; o <<= 1) { const float vv = shfl_up_l(pm, o, lane); if (lane >= o) pm = fmaxf(pm, vv); }
    if (lane == 63) sm[8 + wave] = pm;
    __syncthreads();
    float wpm = -__builtin_inff(); for (int w = 0; w < wave; ++w) wpm = fmaxf(wpm, sm[8 + w]);
    float prevl = shfl_up_l(pm, 1, lane); if (lane == 0) prevl = -__builtin_inff();
    float rmax = fmaxf(0.f, fmaxf(wpm, prevl));
    const size_t o0 = (size_t)(b * 4 + h) * SEQ + 8 * tid;
#pragma unroll
    for (int j = 0; j < 8; ++j) { rmax = fmaxf(rmax, a[j]); MT[o0 + j] = rmax; EMT[o0 + j] = __expf(-(bs[j] + rmax)); KSC[o0 + j] = __expf(a[j] - tmax); }
    if ((tid & 7) == 0) REF[(b * 4 + h) * 64 + (tid >> 3)] = tmax;
    __syncthreads();
}

__device__ __forceinline__ void mprep_unit(int unit, const bf16* PROJ, const float* cw, const float* cb, const float* KSC, bf16* QKM, int lane) {
    const int strip = unit >> 1, half = unit & 1;
    const int m0 = strip * 16, b = m0 / SEQ, s0 = m0 % SEQ, hh = lane >> 4, ch = half * 512 + 8 * lane;
    v4u xr[19];
#pragma unroll
    for (int i = 0; i < 19; ++i) { const int s = s0 - 3 + i; xr[i] = (v4u){0u, 0u, 0u, 0u};
        if (s >= 0) xr[i] = *(const GAS v4u*)(PROJ + (size_t)(b * SEQ + s) * NP + C_MQK + ch); }
    float ksc[16];
#pragma unroll
    for (int i = 0; i < 16; ++i) ksc[i] = half ? KSC[(size_t)(b * 4 + hh) * SEQ + s0 + i] * 0.08838834764831845f : 1.0f;
    float w[4][8], bias[8];
#pragma unroll
    for (int j = 0; j < 4; ++j) { const f32x4 a = *(const GAS f32x4*)(cw + j * 1024 + ch), c2 = *(const GAS f32x4*)(cw + j * 1024 + ch + 4);
        w[j][0] = a.x; w[j][1] = a.y; w[j][2] = a.z; w[j][3] = a.w; w[j][4] = c2.x; w[j][5] = c2.y; w[j][6] = c2.z; w[j][7] = c2.w; }
    { const f32x4 a = *(const GAS f32x4*)(cb + ch), c2 = *(const GAS f32x4*)(cb + ch + 4);
      bias[0] = a.x; bias[1] = a.y; bias[2] = a.z; bias[3] = a.w; bias[4] = c2.x; bias[5] = c2.y; bias[6] = c2.z; bias[7] = c2.w; }
#define XE(i_, e_) (((e_) & 1) ? bfhi(xr[i_][(e_) >> 1]) : bflo(xr[i_][(e_) >> 1]))
#pragma unroll
    for (int i = 0; i < 16; ++i) {
        float y[8];
#pragma unroll
        for (int e = 0; e < 8; ++e) { float t = bias[e] + w[0][e] * XE(i, e) + w[1][e] * XE(i + 1, e) + w[2][e] * XE(i + 2, e) + w[3][e] * XE(i + 3, e); t = t * sigmoidf_(t); y[e] = t * ksc[i]; }
        v4u o; o.x = pk2(y[0], y[1]); o.y = pk2(y[2], y[3]); o.z = pk2(y[4], y[5]); o.w = pk2(y[6], y[7]);
        *(GAS v4u*)(QKM + (size_t)(m0 + i) * 1024 + ch) = o;
    }
#undef XE
}

__device__ __forceinline__ void finish_row(int row, const float* HT, const float* OST, bf16* PROJ, const float* g_mhead, const float* g_sub, float one_m_laminit, int lane) {
    bf16* prow = PROJ + (size_t)row * NP;
#pragma unroll
    for (int hh = 0; hh < 4; ++hh) {
        const f32x4 v = *(const GAS f32x4*)(HT + (size_t)row * 1024 + hh * 256 + 4 * lane);
        const float ss = wave_sum((v.x * v.x + v.y * v.y) + (v.z * v.z + v.w * v.w));
        const float rstd = 1.0f / sqrtf(ss * (1.f / 256.f) + EPS);
        const f32x4 g = *(const GAS f32x4*)(g_mhead + hh * 256 + 4 * lane);
        const v2u so = *(const GAS v2u*)(prow + C_MO + hh * 256 + 4 * lane);
        const float o0 = bflo(so.x) * (v.x * rstd * g.x), o1 = bfhi(so.x) * (v.y * rstd * g.y), o2 = bflo(so.y) * (v.z * rstd * g.z), o3 = bfhi(so.y) * (v.w * rstd * g.w);
        v2u w; w.x = pk2(o0, o1); w.y = pk2(o2, o3);
        *(GAS v2u*)(prow + C_MO + hh * 256 + 4 * lane) = w;
    }
    const f32x4 gs = *(const GAS f32x4*)(g_sub + 4 * lane);
#pragma unroll
    for (int hh = 0; hh < 8; ++hh) {
        const f32x4 v = *(const GAS f32x4*)(OST + (size_t)row * 2048 + hh * 256 + 4 * lane);
        const float ss = wave_sum((v.x * v.x + v.y * v.y) + (v.z * v.z + v.w * v.w));
        const float rstd = 1.0f / sqrtf(ss * (1.f / 256.f) + EPS) * one_m_laminit;
        v2u w; w.x = pk2(v.x * rstd * gs.x, v.y * rstd * gs.y); w.y = pk2(v.z * rstd * gs.z, v.w * rstd * gs.w);
        *(GAS v2u*)(prow + C_AQ + hh * 256 + 4 * lane) = w;
    }
}
struct Args { const void* in[22]; float* out; unsigned char* ws; int stop_layer; int stop_phase; };

constexpr int PT_OFF = MISC_OFF + 128;
constexpr int PT_OUT = 22, PT_WS = 23;
static_assert(PT_OFF + 24 * 8 <= LDS_BYTES, "LDS map");
__device__ __forceinline__ const void* ldp(LAS unsigned char* ldsA, int k) {
    const volatile LAS unsigned* p = (const volatile LAS unsigned*)(ldsA + PT_OFF) + 2 * k; const unsigned lo = p[0], hi = p[1];
    return (const void*)(((unsigned long long)(unsigned)__builtin_amdgcn_readfirstlane(hi) << 32) | (unsigned)__builtin_amdgcn_readfirstlane(lo));
}
#define LDPF(k) ((const float*)ldp(ldsA, (k)))

__global__ void __launch_bounds__(NWAVES * 64, 2) hybrid_fwd(Args args) {
    extern __shared__ __attribute__((aligned(16))) unsigned char lds[];
    LAS unsigned char* ldsA0 = (LAS unsigned char*)lds;
    const int tid0 = threadIdx.x;
    const int wave0 = __builtin_amdgcn_readfirstlane(tid0 >> 6);
    const int G0 = gridDim.x; const int bx0 = blockIdx.x;
    const int vcu0 = (G0 % 8 == 0) ? (bx0 % 8) * (G0 / 8) + bx0 / 8 : bx0;
#define PHASE_IDS() int tid = wave0 * 64 + (int)__builtin_amdgcn_mbcnt_hi(~0u, __builtin_amdgcn_mbcnt_lo(~0u, 0u)); asm volatile("" : "+v"(tid)); int lz_ = 0; asm volatile("" : "+s"(lz_)); \
    const int lane = tid & 63, wave = __builtin_amdgcn_readfirstlane(tid >> 6), G = G0 + lz_, bx = bx0 + lz_, vcu = vcu0 + lz_, NGW = G * NWAVES, gw = vcu * NWAVES + wave; \
    LAS unsigned char* ldsA = ldsA0 + lz_; char* ldsG = (char*)lds + lz_; (void)lane; (void)gw; (void)bx; (void)NGW; (void)ldsG
    for (int u = tid0; u < (LDS_BYTES - LDSCTL_OFF) / 4; u += NWAVES * 64) ((LAS unsigned*)(ldsA0 + LDSCTL_OFF))[u] = 0u;
    __syncthreads();
    if (tid0 < 24) { const unsigned long long v = (tid0 < 22) ? (unsigned long long)args.in[tid0] : (tid0 == 22 ? (unsigned long long)args.out : (unsigned long long)args.ws);
        ((volatile LAS unsigned long long*)(ldsA0 + PT_OFF))[tid0] = v; }
    __syncthreads();
    { XcdBarrier b0_ = xcd_barrier_post((unsigned*)((unsigned char*)ldp(ldsA0, PT_WS) + WS_CTL) + CW_BAR, (volatile LAS unsigned*)(ldsA0 + MISC_OFF) + 8); (void)b0_; }
#define GRID_BAR() do { int lzb_ = 0; asm volatile("" : "+s"(lzb_)); XcdBarrier b_; b_.bar = (unsigned*)((unsigned char*)ldp(ldsA0 + lzb_, PT_WS) + WS_CTL) + CW_BAR; b_.x = xb_xcc_id(); \
        b_.st = (volatile LAS unsigned*)(ldsA0 + lzb_ + MISC_OFF) + 8; xcd_barrier(b_); } while (0)
    const int stop_layer = args.stop_layer, stop_phase = args.stop_phase;

    { PHASE_IDS(); unsigned char* ws = (unsigned char*)ldp(ldsA, PT_WS); rope_table_phase((const int*)ldp(ldsA, 1), (float*)(ws + WS_ROPE), gw * 64 + lane, NGW * 64); }

#define STOP_AT(ph) do { if (DBG && l == stop_layer && stop_phase == (ph)) return; } while (0)
    for (int l = 0; l < DEPTH; ++l) {
        for (int rep_ = 0; rep_ < REPS(0); ++rep_)
        {
            PHASE_IDS();
            unsigned char* ws = (unsigned char*)ldp(ldsA, PT_WS);
            const float* w_in = LDPF(3);
            convert_weights_phase(l, w_in, LDPF(14), LDPF(15), LDPF(16), LDPF(18), LDPF(19), LDPF(20), ws, (LAS float*)(ldsA + RING_OFF + wave * 16640), gw, NGW, lane);
            __syncthreads();
            LAS float* wgT = (LAS float*)(ldsA + RING_OFF);
            for (int k = tid; k < DM; k += NWAVES * 64) {
                const float* src = w_in + (size_t)l * DM * DIN + (size_t)k * DIN + 3072;
                const f32x4 a = *(const GAS f32x4*)src, b2 = *(const GAS f32x4*)(src + 4);
                wgT[0 * DM + k] = a.x; wgT[1 * DM + k] = a.y; wgT[2 * DM + k] = a.z; wgT[3 * DM + k] = a.w;
                wgT[4 * DM + k] = b2.x; wgT[5 * DM + k] = b2.y; wgT[6 * DM + k] = b2.z; wgT[7 * DM + k] = b2.w;
            }
            __syncthreads();
            const float* resid_in = (l == 0) ? LDPF(0) : LDPF(PT_OUT);
            const float* g_mix = LDPF(2) + (size_t)l * DM; const float* i_bias = LDPF(6) + l * 4; const float* f_bias = LDPF(7) + l * 4;
            bf16* HY = (bf16*)(ws + WS_HY); float* LIF = (float*)(ws + WS_LIF);
            for (int m = gw; m < M; m += NGW) {
                f32x4 v[8];
                norm_row(resid_in + (size_t)m * DM, g_mix, HY + (size_t)m * DM, lane, v);
                float ga[8];
#pragma unroll
                for (int c = 0; c < 8; ++c) { float s = 0.f;
#pragma unroll
                    for (int j = 0; j < 8; ++j) { const f32x4 wv = *(const LAS f32x4*)(wgT + c * DM + 256 * j + 4 * lane); s += (v[j].x * wv.x + v[j].y * wv.y) + (v[j].z * wv.z + v[j].w * wv.w); }
                    ga[c] = wave_sum(s); }
                if (lane < 8) {
                    float val = 0.f;
#pragma unroll
                    for (int c = 0; c < 8; ++c) if (lane == c) val = ga[c];
                    if (lane < 4) val += i_bias[lane];
                    else { const float z = val + f_bias[lane - 4]; const float e = __expf(-fabsf(z)), u = 1.0f + e, d = u - 1.0f; val = fminf(z, 0.f) - ((d == 0.f) ? e : __logf(u) * (e / d)); }
                    LIF[(size_t)m * 8 + lane] = val;
                }
            }
        }
        GRID_BAR(); STOP_AT(0);
        for (int rep_ = 0; rep_ < REPS(1); ++rep_)
        {
            PHASE_IDS();
            unsigned char* ws = (unsigned char*)ldp(ldsA, PT_WS);
            {
                float* LIF = (float*)(ws + WS_LIF); float* MT = (float*)(ws + WS_MT); float* EMT = (float*)(ws + WS_EMT); float* KSC = (float*)(ws + WS_KSC); float* REF = (float*)(ws + WS_REF);
                for (int id = vcu; id < NB * 4; id += G) mlstm_scan(id >> 2, id & 3, LIF, KSC, MT, EMT, REF, (LAS float*)(ldsA + RING_OFF), tid);
            }
            pg8::Gemm g{(const bf16*)(ws + WS_HY), (const bf16*)(ws + WS_WIN), DM, DM}; pg8::StaticOrder S; S.init(M, NP, G, bx);
            pg8::EpiProj E{(bf16*)(ws + WS_PROJ), NP, (const float*)(ws + WS_ROPE)};
            pg8::gemm_phase<pg8::EpiProj, true>(ldsA + RING_OFF, g, S, E, tid);
        }
        GRID_BAR(); STOP_AT(1);
        for (int rep_ = 0; rep_ < REPS(2); ++rep_)
        {
            PHASE_IDS();
            unsigned char* ws = (unsigned char*)ldp(ldsA, PT_WS);
            const float* cw = LDPF(4) + (size_t)l * 4 * 1024; const float* cb = LDPF(5) + (size_t)l * 1024;
            for (int st = gw; st < M / 8; st += NGW) mprep_unit(st, (const bf16*)(ws + WS_PROJ), cw, cb, (const float*)(ws + WS_KSC), (bf16*)(ws + WS_QKM), lane);
        }
        GRID_BAR(); STOP_AT(2);
        for (int rep_ = 0; rep_ < REPS(3); ++rep_)
        {
            PHASE_IDS();
            unsigned char* ws = (unsigned char*)ldp(ldsA, PT_WS);
            char* albs = ldsG + RING_OFF;
            att::Seam S;
            {
                constexpr int NIT = NB * 4 * 2 * 8; const int cnt = (NIT + G - 1) / G; const int id0 = vcu * cnt; int nitems = NIT - id0; nitems = nitems < 0 ? 0 : (nitems > cnt ? cnt : nitems);
                const int nblk = 2 * nitems;
                bf16* QKM = (bf16*)(ws + WS_QKM); bf16* PROJ = (bf16*)(ws + WS_PROJ); float* HT = (float*)(ws + WS_HT);
                const float* MT = (const float*)(ws + WS_MT); const float* EMT = (const float*)(ws + WS_EMT); const float* REF = (const float*)(ws + WS_REF);
#define MREF(s_, R, L) do { const int id_ = id0 + ((s_) >> 1), bh_ = id_ >> 4, r_ = id_ & 15, j_ = r_ >> 3, p_ = r_ & 7, qb_ = ((s_) & 1) ? 15 - p_ : p_, b_ = bh_ >> 2, hm_ = bh_ & 3; \
                    R.Q = QKM + (size_t)(b_ * SEQ + qb_ * 256) * 1024 + hm_ * 128; R.K = QKM + (size_t)(b_ * SEQ) * 1024 + 512 + hm_ * 128; \
                    R.V = PROJ + (size_t)(b_ * SEQ) * NP + C_MV + hm_ * 256 + j_ * 128; R.O = HT + (size_t)(b_ * SEQ + qb_ * 256) * 1024 + hm_ * 256 + j_ * 128; R.P0 = qb_ * 256; \
                    L.MT = MT + (size_t)bh_ * SEQ; L.EMT = EMT + (size_t)bh_ * SEQ; L.REF = REF + bh_ * 64; } while (0)
                if (nblk > 0) {
                    { att::BlockRef cur; att::LinRef lc; MREF(0, cur, lc); att::prime<1024, 1024, NP>(cur, albs, S, tid); }
                    for (int s = 0; s < nblk; ++s) {
                        { att::BlockRef nxt; att::LinRef ln; const int sn = (s + 1 < nblk) ? s + 1 : s; MREF(sn, nxt, ln); att::put_next(albs, nxt, tid); }
                        att::BlockRef cur; att::LinRef lc; MREF(s, cur, lc);
                        { int t2 = tid; asm volatile("" : "+v"(t2)); att::block<1024, 1024, NP, 1024, 2>(cur, albs, S, 0.f, lc, t2); }
                    }
                }
#undef MREF
            }
            {
                float lam;
                { const float* lq1 = LDPF(9) + l * 128; const float* lk1 = LDPF(10) + l * 128; const float* lq2 = LDPF(11) + l * 128; const float* lk2 = LDPF(12) + l * 128;
                  const float a1 = lq1[lane] * lk1[lane] + lq1[64 + lane] * lk1[64 + lane];
                  const float a2 = lq2[lane] * lk2[lane] + lq2[64 + lane] * lk2[64 + lane];
                  const float lam_init = 0.8f - 0.6f * __expf(-0.3f * (float)l);
                  lam = __expf(wave_sum(a1)) - __expf(wave_sum(a2)) + lam_init; }
                constexpr int NIT = NB * 8 * 2 * 8; const int cnt = (NIT + G - 1) / G; const int id0 = vcu * cnt; int nitems = NIT - id0; nitems = nitems < 0 ? 0 : (nitems > cnt ? cnt : nitems);
                const int nps = 2 * nitems;
                bf16* PROJ = (bf16*)(ws + WS_PROJ); float* OST = (float*)(ws + WS_OST);
                att::LinRef lr0{nullptr, nullptr, nullptr};
#define AREF(ps_, c_, R) do { const int id_ = id0 + ((ps_) >> 1), bh_ = id_ >> 4, r_ = id_ & 15, j_ = r_ >> 3, p_ = r_ & 7, qb_ = ((ps_) & 1) ? 15 - p_ : p_, b_ = bh_ >> 3, h_ = bh_ & 7; \
                    R.Q = PROJ + (size_t)(b_ * SEQ + qb_ * 256) * NP + C_AQ + h_ * 256 + (c_) * 128; R.K = PROJ + (size_t)(b_ * SEQ) * NP + C_AK + h_ * 256 + (c_) * 128; \
                    R.V = PROJ + (size_t)(b_ * SEQ) * NP + C_AV + h_ * 256 + j_ * 128; R.O = OST + (size_t)(b_ * SEQ + qb_ * 256) * 2048 + h_ * 256 + j_ * 128; R.P0 = qb_ * 256; } while (0)
                if (nps > 0) {
                    { att::BlockRef c0; AREF(0, 0, c0); att::prime<NP, NP, NP>(c0, albs, S, tid); }
                    for (int ps = 0; ps < nps; ++ps) {
                        { att::BlockRef nx; AREF(ps, 1, nx); att::put_next(albs, nx, tid); }
                        { att::BlockRef c0; AREF(ps, 0, c0); int t2 = tid; asm volatile("" : "+v"(t2)); att::block<NP, NP, NP, 2048, 0>(c0, albs, S, lam, lr0, t2); }
                        { att::BlockRef nx; if (ps + 1 < nps) AREF(ps + 1, 0, nx); else AREF(ps, 1, nx); att::put_next(albs, nx, tid); }
                        { att::BlockRef c1; AREF(ps, 1, c1); int t2 = tid; asm volatile("" : "+v"(t2)); att::block<NP, NP, NP, 2048, 1>(c1, albs, S, lam, lr0, t2); }
                    }
                }
#undef AREF
            }
        }
        GRID_BAR(); STOP_AT(3);
        for (int rep_ = 0; rep_ < REPS(4); ++rep_)
        {
            PHASE_IDS();
            unsigned char* ws = (unsigned char*)ldp(ldsA, PT_WS);
            const float oml = 1.0f - (0.8f - 0.6f * __expf(-0.3f * (float)l));
            const float* gmh = LDPF(8) + (size_t)l * 1024; const float* gsub = LDPF(13) + (size_t)l * 256;
            for (int m = gw; m < M; m += NGW) finish_row(m, (const float*)(ws + WS_HT), (const float*)(ws + WS_OST), (bf16*)(ws + WS_PROJ), gmh, gsub, oml, lane);
        }
        GRID_BAR(); STOP_AT(4);
        for (int rep_ = 0; rep_ < REPS(5); ++rep_)
        {
            PHASE_IDS();
            unsigned char* ws = (unsigned char*)ldp(ldsA, PT_WS);
            bf16* PROJ = (bf16*)(ws + WS_PROJ);
            pg8::StaticOrder S; S.init(M, DM, G, bx);
            pg8::Gemm g{PROJ + C_MO, (const bf16*)(ws + WS_PM), NP, KMRG}; pg8::EpiMerge E{PROJ + C_GM, PROJ + C_GA, NP, (bf16*)(ws + WS_HY), DM};
            pg8::gemm_phase<pg8::EpiMerge, true, 16>(ldsA + RING_OFF, g, S, E, tid);
        }
        GRID_BAR(); STOP_AT(5);
        {
            PHASE_IDS();
            unsigned char* ws = (unsigned char*)ldp(ldsA, PT_WS);
            float* out = (float*)ldp(ldsA, PT_OUT);
            const float* resid_in = (l == 0) ? LDPF(0) : (const float*)out;
            pg8::StaticOrder S; S.init(M, DM, G, bx);
            pg8::Gemm g{(const bf16*)(ws + WS_HY), (const bf16*)(ws + WS_WO), DM, DM}; pg8::EpiRes E{resid_in, out, DM};
            pg8::gemm_phase<pg8::EpiRes, true>(ldsA + RING_OFF, g, S, E, tid);
        }
        GRID_BAR(); STOP_AT(6);
        for (int rep_ = 0; rep_ < REPS(7); ++rep_)
        {
            PHASE_IDS();
            unsigned char* ws = (unsigned char*)ldp(ldsA, PT_WS);
            const float* out = LDPF(PT_OUT); const float* g_ffn = LDPF(17) + (size_t)l * DM; bf16* HY = (bf16*)(ws + WS_HY);
            for (int m = gw; m < M; m += NGW) { f32x4 v[8]; norm_row(out + (size_t)m * DM, g_ffn, HY + (size_t)m * DM, lane, v); }
        }
        GRID_BAR(); STOP_AT(7);
        for (int rep_ = 0; rep_ < REPS(8); ++rep_)
        {
            PHASE_IDS();
            unsigned char* ws = (unsigned char*)ldp(ldsA, PT_WS);
            pg8::StaticOrder S; S.init(M, NGU, G, bx);
            pg8::Gemm g{(const bf16*)(ws + WS_HY), (const bf16*)(ws + WS_WGU), DM, DM}; pg8::EpiSwiglu E{(bf16*)(ws + WS_PROJ), DFF};
            pg8::gemm_phase<pg8::EpiSwiglu, true>(ldsA + RING_OFF, g, S, E, tid);
        }
        GRID_BAR(); STOP_AT(8);
        {
            PHASE_IDS();
            unsigned char* ws = (unsigned char*)ldp(ldsA, PT_WS);
            float* out = (float*)ldp(ldsA, PT_OUT);
            pg8::StaticOrder S; S.init(M, DM, G, bx);
            pg8::Gemm g{(const bf16*)(ws + WS_PROJ), (const bf16*)(ws + WS_WD), DFF, DFF};
            pg8::EpiRes E{out, (DBG && l == stop_layer && stop_phase == 9) ? (float*)(ws + WS_OST) : out, DM};
            pg8::gemm_phase<pg8::EpiRes, true>(ldsA + RING_OFF, g, S, E, tid);
        }
        GRID_BAR(); STOP_AT(9);
    }
    {
        PHASE_IDS();
        float* out = (float*)ldp(ldsA, PT_OUT); const float* g_final = LDPF(21);
        for (int m = gw; m < M; m += NGW) {
            GAS f32x4* xr = (GAS f32x4*)(out + (size_t)m * DM) + lane; const GAS f32x4* gr = (const GAS f32x4*)g_final + lane;
            f32x4 v[8]; float s = 0.f;
#pragma unroll
            for (int j = 0; j < 8; ++j) { v[j] = xr[64 * j]; s += (v[j].x * v[j].x + v[j].y * v[j].y) + (v[j].z * v[j].z + v[j].w * v[j].w); }
            const float rstd = 1.0f / sqrtf(wave_sum(s) * (1.f / DM) + EPS);
#pragma unroll
            for (int j = 0; j < 8; ++j) xr[64 * j] = v[j] * rstd * gr[64 * j];
        }
    }
#undef GRID_BAR
#undef STOP_AT
}
extern "C" void kernel_launch(void* const* d_in, const int* in_sizes, int n_in, void* d_out, int out_size, void* d_ws, size_t ws_size, hipStream_t stream) {
    static int grid = 0;
    if (grid == 0) {
        if (n_in != 22 || in_sizes[0] != M * DM || out_size != M * DM || ws_size < WS_END) {
            fprintf(stderr, "kernel_launch: shape mismatch (n_in %d, in0 %d, out %d, ws %zu < %zu); nothing launched\n", n_in, n_in > 0 ? in_sizes[0] : -1, out_size, ws_size, (size_t)WS_END); grid = -1; return; }
        int dev = 0, cus = 0, per_cu = 0;
        if (hipGetDevice(&dev) != hipSuccess || hipDeviceGetAttribute(&cus, hipDeviceAttributeMultiprocessorCount, dev) != hipSuccess) { grid = -1; return; }
        if (hipFuncSetAttribute((const void*)hybrid_fwd, hipFuncAttributeMaxDynamicSharedMemorySize, LDS_BYTES) != hipSuccess) { fprintf(stderr, "kernel_launch: hipFuncSetAttribute failed\n"); grid = -1; return; }
        if (hipOccupancyMaxActiveBlocksPerMultiprocessor(&per_cu, (const void*)hybrid_fwd, NWAVES * 64, LDS_BYTES) != hipSuccess || per_cu < 1)
            fprintf(stderr, "kernel_launch: note: occupancy query reports %d workgroups per CU\n", per_cu);
        (void)hipGetLastError();
        grid = cus;
    }
    if (grid < 0) return;
    if (hipMemsetAsync((char*)d_ws + WS_CTL, 0, CTL_ZERO_BYTES, stream) != hipSuccess) return;
    Args a{};
    for (int i = 0; i < 22; ++i) a.in[i] = d_in[i];
    a.out = (float*)d_out; a.ws = (unsigned char*)d_ws;
    a.stop_layer = DBG ? DBG_STOP_LAYER : -1; a.stop_phase = DBG ? DBG_STOP_PHASE : -1;
    hipLaunchKernelGGL(hybrid_fwd, dim3(grid), dim3(NWAVES * 64), LDS_BYTES, stream, a);
#if DBG
    dbg_checks(d_in, (float*)d_out, (unsigned char*)d_ws, stream);
#endif
}
```

```cpp
#include <hip/hip_runtime.h>
#include <cstdio>
#include <cstdint>
#define DBG 0
#define DBG_STOP_LAYER 0
#define DBG_STOP_PHASE 3
#define PROBE_PHASE -1
#define REPS(k) ((PROBE_PHASE == (k)) ? 2 : 1)
namespace pg8 {
#define PG8_LAS __attribute__((address_space(3)))
#define PG8_GAS __attribute__((address_space(1)))
typedef unsigned short bf16_t;
typedef short bf16x8 __attribute__((ext_vector_type(8)));
typedef float f32x4 __attribute__((ext_vector_type(4)));
typedef unsigned u32x4 __attribute__((ext_vector_type(4)));
constexpr int BM = 256, BK = 64, HALF = 128, HTB = HALF * BK * 2  , STAGE_BYTES = 8 * HTB, NXCD = 8, WGM = 4;

__host__ __device__ __forceinline__ int lds_byte(int r, int c) { const int st = (r >> 4) * 2 + (c >> 5), rr = r & 15, cc = c & 31, ob = rr * 64 + cc * 2; return st * 1024 + (ob ^ (((ob >> 9) & 1) << 5)); }
__host__ __device__ __forceinline__ void stage_rc(int b, int& R, int& C) { const int st = b / 1024, sb = b % 1024, swz = sb ^ (((sb >> 9) & 1) << 5); R = (st >> 1) * 16 + swz / 64; C = (st & 1) * 32 + (swz % 64) / 2; }
__host__ __device__ __forceinline__ int perm32(int rho) { const int n = rho >> 4, i = rho & 15; return 8 * (i >> 2) + 4 * n + (i & 3); }

struct Unit { int pm, pn; };
struct Gemm { const bf16_t* A; const bf16_t* Bt; int lda; int K; };

struct StaticOrder {
    int nM, nN, nwg, G, c;
    __host__ __device__ void init(int M, int N, int G_, int c_) { nM = M / BM; nN = N / BM; nwg = nM * nN; G = G_; c = c_; }
    __host__ __device__ bool next(int i, Unit& u) const {
        const long L = (long)i * G + c; if (L >= nwg) return false;
        int wgid = (int)L; { const int q = nwg / NXCD, r = nwg % NXCD, xcd = wgid % NXCD, off = wgid / NXCD; wgid = (xcd < r ? xcd * (q + 1) : r * (q + 1) + (xcd - r) * q) + off; }
        const int nig = WGM * nN, gid = wgid / nig, fm = gid * WGM, gsz = (nM - fm) < WGM ? (nM - fm) : WGM;
        u.pm = fm + ((wgid % nig) % gsz); u.pn = (wgid % nig) / gsz; return true;
    }
};

__device__ __forceinline__ unsigned cvt_pk_bf16(float lo, float hi) { unsigned r; asm volatile("v_cvt_pk_bf16_f32 %0, %1, %2" : "=v"(r) : "v"(lo), "v"(hi)); return r; }
__device__ __forceinline__ float bf_lo(unsigned u) { return __uint_as_float(u << 16); }
__device__ __forceinline__ float bf_hi(unsigned u) { return __uint_as_float(u & 0xffff0000u); }
__device__ __forceinline__ float sigm(float x) { return __builtin_amdgcn_rcpf(1.0f + __builtin_amdgcn_exp2f(-1.4426950408889634f * x)); }
__device__ __forceinline__ u32x4 pack8f(f32x4 a, f32x4 b) { u32x4 w; w.x = cvt_pk_bf16(a[0], a[1]); w.y = cvt_pk_bf16(a[2], a[3]); w.z = cvt_pk_bf16(b[0], b[1]); w.w = cvt_pk_bf16(b[2], b[3]); return w; }

struct EpiProj {
    static constexpr bool PERM = true;
    bf16_t* O; int ldc; const float* rope;
    __device__ __forceinline__ void operator()(const f32x4 (&acc)[2][2][4][2], const Unit& u, int wr, int wc, int fr, int fq) const {
        const int row0 = u.pm * BM + wr * 64 + fr, col0 = u.pn * BM + wc * 32 + 8 * fq;
        const int pn = u.pn;
        const bool is_sig = (pn >= 8 && pn < 12) || pn >= 36;
        const bool is_rope = (pn >= 12 && pn < 28) && (wc == 0);
        f32x4 csN = (f32x4){1.f, 1.f, 1.f, 1.f}, snN = (f32x4){0.f, 0.f, 0.f, 0.f};
        if (is_rope) { const float* rp = rope + (size_t)row0 * 32 + 4 * fq; csN = *(const PG8_GAS f32x4*)rp; snN = *(const PG8_GAS f32x4*)(rp + 16); }
#pragma unroll
        for (int ai = 0; ai < 2; ++ai)
#pragma unroll
            for (int m = 0; m < 4; ++m) {
                const int row = row0 + ai * HALF + m * 16;
                bf16_t* rowp = O + (size_t)row * ldc + col0;
                if (pn >= 36) {
                    u32x4 w;
#pragma unroll
                    for (int bj = 0; bj < 2; ++bj) {
                        const f32x4 v0 = acc[ai][bj][m][0], v1 = acc[ai][bj][m][1]; unsigned q0 = 0u, q1 = 0u;
#pragma unroll
                        for (int e = 0; e < 4; ++e) { q0 = __builtin_amdgcn_cvt_pk_u8_f32(fmaxf(__builtin_rintf(sigm(v0[e]) * 255.f), 1.f), e, q0); q1 = __builtin_amdgcn_cvt_pk_u8_f32(fmaxf(__builtin_rintf(sigm(v1[e]) * 255.f), 1.f), e, q1); }
                        w[2 * bj] = q0; w[2 * bj + 1] = q1;
                    }
                    __builtin_nontemporal_store(w, (PG8_GAS u32x4*)((unsigned char*)(O + (size_t)row * ldc + 9216) + (pn - 36) * 256 + wc * 64 + fq * 16));
                    continue;
                }
                const f32x4 cs = csN, sn = snN;
                if (is_rope && (ai * 4 + m) < 7) { const int it1 = ai * 4 + m + 1; const float* rp = rope + (size_t)(row0 + (it1 >> 2) * HALF + (it1 & 3) * 16) * 32 + 4 * fq; csN = *(const PG8_GAS f32x4*)rp; snN = *(const PG8_GAS f32x4*)(rp + 16); }
                asm volatile("" ::: "memory");
#pragma unroll
                for (int bj = 0; bj < 2; ++bj) {
                    f32x4 v0 = acc[ai][bj][m][0], v1 = acc[ai][bj][m][1];
                    if (is_sig) {
#pragma unroll
                        for (int e = 0; e < 4; ++e) { v0[e] = sigm(v0[e]); v1[e] = sigm(v1[e]); }
                    }
                    if (is_rope) {
                        f32x4 a0, a1;
                        a0[0] = v0[0] * cs[0] - v0[1] * sn[0]; a0[1] = v0[1] * cs[0] + v0[0] * sn[0];
                        a0[2] = v0[2] * cs[1] - v0[3] * sn[1]; a0[3] = v0[3] * cs[1] + v0[2] * sn[1];
                        a1[0] = v1[0] * cs[2] - v1[1] * sn[2]; a1[1] = v1[1] * cs[2] + v1[0] * sn[2];
                        a1[2] = v1[2] * cs[3] - v1[3] * sn[3]; a1[3] = v1[3] * cs[3] + v1[2] * sn[3];
                        v0 = a0; v1 = a1;
                    }
                    __builtin_nontemporal_store(pack8f(v0, v1), (PG8_GAS u32x4*)(rowp + bj * HALF));
                }
            }
    }
};
struct EpiMerge {
    static constexpr bool PERM = true;
    const unsigned char* G8; int ldg8; bf16_t* Y; int ldy;
#define UB(w_, k_) ((float)(((w_) >> (8 * (k_))) & 0xffu))
    __device__ __forceinline__ void hook(f32x4 (&acc)[2][2][4][2], const Unit& u, int wr, int wc, int fr, int fq) const {
        int z_ = 0; asm volatile("" : "+v"(z_));
        const int row0 = u.pm * BM + wr * 64 + fr + z_, boff = u.pn * 256 + wc * 64 + fq * 16;
#pragma unroll
        for (int ai = 0; ai < 2; ++ai)
#pragma unroll
            for (int m = 0; m < 4; ++m) {
                const unsigned char* gp = G8 + (size_t)(row0 + ai * HALF + m * 16) * ldg8 + boff;
                const u32x4 a = *(const PG8_GAS u32x4*)gp, b = *(const PG8_GAS u32x4*)(gp + 2048);
#pragma unroll
                for (int bj = 0; bj < 2; ++bj) {
                    f32x4& v0 = acc[ai][bj][m][0]; f32x4& v1 = acc[ai][bj][m][1];
                    const unsigned a0 = a[2 * bj], a1 = a[2 * bj + 1], b0 = b[2 * bj], b1 = b[2 * bj + 1];
#pragma unroll
                    for (int e = 0; e < 4; ++e) { v0[e] *= UB(a0, e) * __builtin_amdgcn_rcpf(UB(b0, e)); v1[e] *= UB(a1, e) * __builtin_amdgcn_rcpf(UB(b1, e)); }
                }
                if (m == 3) asm volatile("" ::: "memory");
            }
    }
    __device__ __forceinline__ void operator()(const f32x4 (&acc)[2][2][4][2], const Unit& u, int wr, int wc, int fr, int fq) const {
        const int row0 = u.pm * BM + wr * 64 + fr, col0 = u.pn * BM + wc * 32 + 8 * fq, boff = u.pn * 256 + wc * 64 + fq * 16 + 2048;
        u32x4 gA[2][4];
#pragma unroll
        for (int ai = 0; ai < 2; ++ai)
#pragma unroll
            for (int m = 0; m < 4; ++m) gA[ai][m] = *(const PG8_GAS u32x4*)(G8 + (size_t)(row0 + ai * HALF + m * 16) * ldg8 + boff);
        asm volatile("" ::: "memory");
#pragma unroll
        for (int ai = 0; ai < 2; ++ai)
#pragma unroll
            for (int m = 0; m < 4; ++m) {
                const int row = row0 + ai * HALF + m * 16;
                const u32x4 g = gA[ai][m];
#pragma unroll
                for (int bj = 0; bj < 2; ++bj) {
                    const int col = col0 + bj * HALF;
                    const f32x4 v0 = acc[ai][bj][m][0], v1 = acc[ai][bj][m][1];
                    const unsigned g0 = g[2 * bj], g1 = g[2 * bj + 1];
                    f32x4 o0, o1;
#pragma unroll
                    for (int e = 0; e < 4; ++e) { o0[e] = UB(g0, e) * (1.0f / 255.0f) * v0[e]; o1[e] = UB(g1, e) * (1.0f / 255.0f) * v1[e]; }
                    *(PG8_GAS u32x4*)(Y + (size_t)row * ldy + col) = pack8f(o0, o1);
                }
                if (m == 3) asm volatile("" ::: "memory");
            }
    }
#undef UB
};
typedef _Float16 h16_t;
typedef _Float16 h16x8 __attribute__((ext_vector_type(8)));
struct EpiRes16 {
    static constexpr bool PERM = true;
    h16_t* X; int ldc;
    __device__ __forceinline__ void operator()(const f32x4 (&acc)[2][2][4][2], const Unit& u, int wr, int wc, int fr, int fq) const {
        const int row0 = u.pm * BM + wr * 64 + fr, col0 = u.pn * BM + wc * 32 + 8 * fq;
        h16x8 r[2][4][2];
#pragma unroll
        for (int ai = 0; ai < 2; ++ai)
#pragma unroll
            for (int m = 0; m < 4; ++m)
#pragma unroll
                for (int bj = 0; bj < 2; ++bj) r[ai][m][bj] = __builtin_nontemporal_load((const PG8_GAS h16x8*)(X + (size_t)(row0 + ai * HALF + m * 16) * ldc + col0 + bj * HALF));
        asm volatile("" ::: "memory");
#pragma unroll
        for (int ai = 0; ai < 2; ++ai)
#pragma unroll
            for (int m = 0; m < 4; ++m)
#pragma unroll
                for (int bj = 0; bj < 2; ++bj) { h16x8 o; const h16x8 q = r[ai][m][bj];
#pragma unroll
                    for (int e = 0; e < 4; ++e) { o[e] = (h16_t)((float)q[e] + acc[ai][bj][m][0][e]); o[4 + e] = (h16_t)((float)q[4 + e] + acc[ai][bj][m][1][e]); }
                    *(PG8_GAS h16x8*)(X + (size_t)(row0 + ai * HALF + m * 16) * ldc + col0 + bj * HALF) = o; }
    }
};
struct EpiSwiglu {
    static constexpr bool PERM = true;
    bf16_t* H; int ldh;
    __device__ __forceinline__ void operator()(const f32x4 (&acc)[2][2][4][2], const Unit& u, int wr, int wc, int fr, int fq) const {
        const int row0 = u.pm * BM + wr * 64 + fr, col0 = u.pn * HALF + wc * 32 + 8 * fq;
#pragma unroll
        for (int ai = 0; ai < 2; ++ai)
#pragma unroll
            for (int m = 0; m < 4; ++m) {
                const int row = row0 + ai * HALF + m * 16;
                f32x4 o0, o1;
#pragma unroll
                for (int e = 0; e < 4; ++e) { const float g0 = acc[ai][0][m][0][e], g1 = acc[ai][0][m][1][e];
                    o0[e] = g0 * sigm(g0) * acc[ai][1][m][0][e]; o1[e] = g1 * sigm(g1) * acc[ai][1][m][1][e]; }
                __builtin_nontemporal_store(pack8f(o0, o1), (PG8_GAS u32x4*)(H + (size_t)row * ldh + col0));
            }
    }
};

template <class Epi, bool ALIGN_EPI, int HOOKT = 0>
__device__ __forceinline__ void gemm_phase(PG8_LAS unsigned char* lds, const Gemm g, const StaticOrder& S, const Epi& E, const int tid) {
    const int wid = __builtin_amdgcn_readfirstlane(tid >> 6), lane = tid & 63, wr = wid >> 2, wc = wid & 3, fr = lane & 15, fq = lane >> 4;
    const int K = g.K, nt = K / BK, lda = g.lda;
    unsigned voffA[2], voffB[2];
#pragma unroll
    for (int i = 0; i < 2; ++i) { int R, C; stage_rc(tid * 16 + i * 8192, R, C); const int Rb = Epi::PERM ? ((R & ~31) + perm32(R & 31)) : R;
        voffA[i] = (unsigned)(R * lda + C) * 2u; voffB[i] = (unsigned)(Rb * K + C) * 2u; }
    const size_t kstep = (size_t)(BK * 2);
    const size_t hstepA = (size_t)HALF * lda * 2, hstepB = (size_t)HALF * K * 2;
    const size_t tstepA = 2 * hstepA, tstepB = 2 * hstepB;
    const unsigned ldsw = (unsigned)wid * 1024u;
    const int aoff = lds_byte(wr * 64 + fr, fq * 8), boff = lds_byte(wc * 32 + fr, fq * 8);
#define PG8_SA(b, h) (((b) * 2 + (h)) * HTB)
#define PG8_SB(b, h) ((4 + (b) * 2 + (h)) * HTB)
#define PG8_STAGE(bufoff, gbase, voff) do { _Pragma("unroll") for (int _i = 0; _i < 2; ++_i) \
        __builtin_amdgcn_global_load_lds((const unsigned*)((const char*)(gbase) + (voff)[_i]), (PG8_LAS unsigned*)(lds + (bufoff) + ldsw + _i * 8192), 16, 0, 0); } while (0)
#define PG8_LDA(dst, b, h) do { _Pragma("unroll") for (int m = 0; m < 4; ++m) _Pragma("unroll") for (int k = 0; k < 2; ++k) dst[m][k] = *(const PG8_LAS bf16x8*)(lds + PG8_SA(b, h) + aoff + m * 2048 + k * 1024); } while (0)
#define PG8_LDB(dst, b, h) do { _Pragma("unroll") for (int n = 0; n < 2; ++n) _Pragma("unroll") for (int k = 0; k < 2; ++k) dst[n][k] = *(const PG8_LAS bf16x8*)(lds + PG8_SB(b, h) + boff + n * 2048 + k * 1024); } while (0)
#define PG8_MMA(ai, bj, At, Bt) do { __builtin_amdgcn_s_setprio(1); _Pragma("unroll") for (int m = 0; m < 4; ++m) _Pragma("unroll") for (int n = 0; n < 2; ++n) _Pragma("unroll") for (int k = 0; k < 2; ++k) \
        acc[ai][bj][m][n] = __builtin_amdgcn_mfma_f32_16x16x32_bf16(Bt[n][k], At[m][k], acc[ai][bj][m][n], 0, 0, 0); __builtin_amdgcn_s_setprio(0); } while (0)
#define PG8_WAIT_V(n) asm volatile("s_waitcnt vmcnt(" #n ")" ::: "memory")
#define PG8_WAIT_L(n) asm volatile("s_waitcnt lgkmcnt(" #n ")" ::: "memory")
#define PG8_BAR __builtin_amdgcn_s_barrier()
#define PG8_SCHED __builtin_amdgcn_sched_barrier(0)
    Unit cur, nxt; int ui = 0;
    if (!S.next(0, cur)) return;
    f32x4 acc[2][2][4][2];
#pragma unroll
    for (int a = 0; a < 2; ++a)
#pragma unroll
        for (int b = 0; b < 2; ++b)
#pragma unroll
            for (int m = 0; m < 4; ++m)
#pragma unroll
                for (int n = 0; n < 2; ++n) acc[a][b][m][n] = (f32x4){0.f, 0.f, 0.f, 0.f};
    bf16x8 At[4][2], B0[2][2], B1[2][2];
    const char* cA = (const char*)g.A + (size_t)cur.pm * tstepA; const char* cB = (const char*)g.Bt + (size_t)cur.pn * tstepB;
    PG8_STAGE(PG8_SB(0, 0), cB, voffB); PG8_STAGE(PG8_SB(0, 1), cB + hstepB, voffB); PG8_STAGE(PG8_SA(0, 0), cA, voffA); PG8_STAGE(PG8_SA(0, 1), cA + hstepA, voffA);
    if (wr == 1) PG8_BAR;
    PG8_WAIT_V(2); PG8_BAR;
    PG8_STAGE(PG8_SB(1, 0), cB + kstep, voffB); PG8_STAGE(PG8_SA(1, 0), cA + kstep, voffA); PG8_STAGE(PG8_SB(1, 1), cB + hstepB + kstep, voffB);
    PG8_WAIT_V(6); PG8_BAR;
    for (;;) {
        const bool has_next = S.next(ui + 1, nxt);
        const char* nA = has_next ? (const char*)g.A + (size_t)nxt.pm * tstepA : cA; const char* nB = has_next ? (const char*)g.Bt + (size_t)nxt.pn * tstepB : cB;
        for (int t = 0; t < nt; t += 2) {
            if constexpr (HOOKT > 0) { if (t == HOOKT) { E.hook(acc, cur, wr, wc, fr, fq); PG8_SCHED; } }
            const bool last = (t == nt - 2);
            const char* a1 = cA + (size_t)(t + 1) * kstep;
            const char* a2 = last ? nA : cA + (size_t)(t + 2) * kstep; const char* b2 = last ? nB : cB + (size_t)(t + 2) * kstep;
            const char* a3 = a2 + kstep; const char* b3 = b2 + kstep;
            PG8_LDB(B0, 0, 0); PG8_LDB(B1, 0, 1); PG8_SCHED; PG8_LDA(At, 0, 0); PG8_STAGE(PG8_SA(1, 1), a1 + hstepA, voffA);
            PG8_WAIT_V(8); PG8_WAIT_L(0); PG8_BAR; PG8_MMA(0, 0, At, B0); PG8_MMA(0, 1, At, B1); PG8_BAR; PG8_SCHED;
            PG8_LDA(At, 0, 1); PG8_STAGE(PG8_SB(0, 0), b2, voffB); PG8_STAGE(PG8_SB(0, 1), b2 + hstepB, voffB); PG8_STAGE(PG8_SA(0, 0), a2, voffA);
            PG8_WAIT_V(8); PG8_WAIT_L(0); PG8_BAR; PG8_MMA(1, 0, At, B0); PG8_MMA(1, 1, At, B1); PG8_BAR; PG8_SCHED;
            PG8_LDB(B0, 1, 0); PG8_LDB(B1, 1, 1); PG8_SCHED; PG8_LDA(At, 1, 0); PG8_STAGE(PG8_SA(0, 1), a2 + hstepA, voffA);
            PG8_WAIT_V(8); PG8_WAIT_L(0); PG8_BAR; PG8_MMA(0, 0, At, B0); PG8_MMA(0, 1, At, B1); PG8_BAR; PG8_SCHED;
            PG8_LDA(At, 1, 1); PG8_STAGE(PG8_SB(1, 0), b3, voffB); PG8_STAGE(PG8_SB(1, 1), b3 + hstepB, voffB); PG8_STAGE(PG8_SA(1, 0), a3, voffA);
            PG8_WAIT_V(8); PG8_WAIT_L(0); PG8_BAR; PG8_MMA(1, 0, At, B0); PG8_MMA(1, 1, At, B1); PG8_BAR; PG8_SCHED;
        }
        if constexpr (ALIGN_EPI) { if (wr == 0) PG8_BAR; }
        E(acc, cur, wr, wc, fr, fq);
        if (!has_next) break;
#pragma unroll
        for (int a = 0; a < 2; ++a)
#pragma unroll
            for (int b = 0; b < 2; ++b)
#pragma unroll
                for (int m = 0; m < 4; ++m)
#pragma unroll
                    for (int n = 0; n < 2; ++n) acc[a][b][m][n] = (f32x4){0.f, 0.f, 0.f, 0.f};
        cur = nxt; cA = nA; cB = nB; ++ui;
        if constexpr (ALIGN_EPI) { if (wr == 1) PG8_BAR; }
    }
    PG8_WAIT_V(0);
    if constexpr (!ALIGN_EPI) { if (wr == 0) PG8_BAR; }
    PG8_BAR;
#undef PG8_SA
#undef PG8_SB
#undef PG8_STAGE
#undef PG8_LDA
#undef PG8_LDB
#undef PG8_MMA
#undef PG8_WAIT_V
#undef PG8_WAIT_L
#undef PG8_BAR
#undef PG8_SCHED
}
}
namespace att {
typedef unsigned short bf16;
typedef short bf16x8 __attribute__((ext_vector_type(8)));
typedef short s16x4 __attribute__((ext_vector_type(4)));
typedef float f32x16 __attribute__((ext_vector_type(16)));
typedef float f32x4 __attribute__((ext_vector_type(4)));
typedef unsigned u32x4 __attribute__((ext_vector_type(4)));
constexpr int D = 128;
constexpr float SCALE = 0.08838834764831845f;
constexpr float THR = 8.f;
constexpr int NW = 8, QBLK = 32, KVBLK = 64, QB = NW * QBLK;
constexpr int SHM_V = KVBLK * D * 2, SHM_K = KVBLK * D * 2;
constexpr int LDS_BYTES = 2 * SHM_V + 2 * SHM_K + NW * 64 * 4;
constexpr int LDS_QIMG = LDS_BYTES + 32, LDS_SSQ = LDS_QIMG + NW * 8192, LDS_TOTAL = LDS_SSQ + NW * 32 * 4;

#define KSWZ(row, colB) ((row) * 256 + ((colB) ^ (((row) & 7) << 4)))
#define SBAR() __builtin_amdgcn_sched_barrier(0)
__device__ __forceinline__ int v_st(int k, int c) { const int kk = (k & ~0xC) | ((k & 4) << 1) | ((k & 8) >> 1); return ((kk >> 3) * 4 + (c >> 5)) * 512 + ((kk & 7) * 32 + (c & 31)) * 2; }
__device__ __forceinline__ int v_rd_base(int lane) { return ((lane & 3) << 3) | (((lane >> 2) & 3) << 6) | (((lane >> 4) & 1) << 5) | (((lane >> 5) & 1) << 8); }
constexpr int v_rd_off(int d0, int ks, int half) { return d0 * 512 + ks * 4096 + half * 2048; }
__device__ __forceinline__ int crow(int r, int hi) { return (r & 3) + 8 * (r >> 2) + 4 * hi; }
__device__ __forceinline__ unsigned cvtpk(float lo, float hi) { unsigned r; asm volatile("v_cvt_pk_bf16_f32 %0, %1, %2" : "=v"(r) : "v"(lo), "v"(hi)); return r; }
__device__ __forceinline__ bf16x8 load8(const bf16* p) { return *reinterpret_cast<const bf16x8*>(p); }
template <bool ZERO>
__device__ __forceinline__ void mask_tile(f32x16& p0, f32x16& p1, int dq) {
    const float NEG = ZERO ? 0.f : -__builtin_inff();
#pragma unroll
    for (int r = 0; r < 16; ++r) {
        const int c = (r & 3) + 8 * (r >> 2);
        if (dq - c < 0) p0[r] = NEG;
        if (dq - c - 32 < 0) p1[r] = NEG;
    }
}
__device__ __forceinline__ void partialSM(f32x16& p0, f32x16& p1, float& m_reg, float& mn, float& alpha) {
    float pmax = p0[0]; for (int r = 1; r < 16; ++r) pmax = fmaxf(pmax, p0[r]); for (int r = 0; r < 16; ++r) pmax = fmaxf(pmax, p1[r]);
    { auto rr = __builtin_amdgcn_permlane32_swap(__float_as_uint(pmax), __float_as_uint(pmax), false, false);
      pmax = fmaxf(__uint_as_float(rr[0]), __uint_as_float(rr[1])); }
    constexpr float C2 = 1.4426950408889634f * SCALE;
    if (__builtin_expect(__all((pmax - m_reg) * SCALE <= THR), 1)) { mn = m_reg; alpha = 1.f; }
    else { mn = fmaxf(m_reg, pmax); alpha = __builtin_amdgcn_exp2f((m_reg - mn) * C2); m_reg = mn; }
    const float mnL = -mn * C2;
    for (int r = 0; r < 16; ++r) p0[r] = fmaf(p0[r], C2, mnL); for (int r = 0; r < 16; ++r) p1[r] = fmaf(p1[r], C2, mnL);
    for (int r = 0; r < 16; ++r) p0[r] = __builtin_amdgcn_exp2f(p0[r]);
}
#define ATT_PK4(P, B_, OUT) do { unsigned a0 = cvtpk(P[B_+0], P[B_+1]), a1 = cvtpk(P[B_+2], P[B_+3]);                          \
        unsigned b0 = cvtpk(P[B_+4], P[B_+5]), b1 = cvtpk(P[B_+6], P[B_+7]);                                             \
        auto r0 = __builtin_amdgcn_permlane32_swap(a0, b0, false, false); auto r1 = __builtin_amdgcn_permlane32_swap(a1, b1, false, false); \
        u32x4 w = {r0[0], r1[0], r0[1], r1[1]}; OUT = *reinterpret_cast<bf16x8*>(&w); } while (0)
__device__ __forceinline__ void finishSM(f32x16& p0, f32x16& p1, float alpha, float& l_reg, bf16x8& pa0, bf16x8& pa1, bf16x8& pa2, bf16x8& pa3) {
    for (int r = 0; r < 16; ++r) p1[r] = __builtin_amdgcn_exp2f(p1[r]);
    float ps = 0; for (int r = 0; r < 16; ++r) ps += p0[r]; for (int r = 0; r < 16; ++r) ps += p1[r];
    { auto rr = __builtin_amdgcn_permlane32_swap(__float_as_uint(ps), __float_as_uint(ps), false, false);
      ps = __uint_as_float(rr[0]) + __uint_as_float(rr[1]); }
    l_reg = l_reg * alpha + ps;
    ATT_PK4(p0, 0, pa0); ATT_PK4(p0, 8, pa1); ATT_PK4(p1, 0, pa2); ATT_PK4(p1, 8, pa3);
}
__device__ __forceinline__ void partialLin(f32x16& p0, f32x16& p1, float f) {
    for (int r = 0; r < 16; ++r) { p0[r] *= f; p1[r] *= f; }
}
__device__ __forceinline__ void finishLin(f32x16& p0, f32x16& p1, float& den, bf16x8& pa0, bf16x8& pa1, bf16x8& pa2, bf16x8& pa3) {
    float ps = 0; for (int r = 0; r < 16; ++r) ps += p0[r]; for (int r = 0; r < 16; ++r) ps += p1[r];
    den += ps;
    ATT_PK4(p0, 0, pa0); ATT_PK4(p0, 8, pa1); ATT_PK4(p1, 0, pa2); ATT_PK4(p1, 8, pa3);
}
template <int KB, bool QL>
__device__ __forceinline__ void qkt(f32x16& p0, f32x16& p1, const char* K_lds, int r32, int hi, const bf16x8* qr, const char* qlds) {
    p0 = f32x16{}; p1 = f32x16{};
    const char* kb[4];
#pragma unroll
    for (int dd = 0; dd < 4; ++dd) kb[dd] = K_lds + KB * SHM_K + KSWZ(r32, (dd * 16 + hi * 8) * 2);
#pragma unroll
    for (int d0 = 0; d0 < 8; ++d0) { const char* a = kb[d0 & 3] + (d0 >> 2) * 128;
        bf16x8 b0 = *reinterpret_cast<const bf16x8*>(a);
        bf16x8 b1 = *reinterpret_cast<const bf16x8*>(a + 32 * 256);
        bf16x8 qf; if constexpr (QL) qf = *reinterpret_cast<const bf16x8*>(qlds + d0 * 1024); else qf = qr[d0];
        p0 = __builtin_amdgcn_mfma_f32_32x32x16_bf16(b0, qf, p0, 0, 0, 0);
        p1 = __builtin_amdgcn_mfma_f32_32x32x16_bf16(b1, qf, p1, 0, 0, 0); }
}
template <int VB>
__device__ __forceinline__ void pv_tile(f32x16* o, int vb0, bf16x8 pa0, bf16x8 pa1, bf16x8 pa2, bf16x8 pa3) {
#define TRRD(dst, off) asm volatile("ds_read_b64_tr_b16 %0, %1 offset:%2" : "=&v"(dst) : "v"(vb0), "i"(off) : "memory")
#define PV_D0(d0) do { s16x4 l0, l1, l2, l3, h0, h1, h2, h3; constexpr int b_ = VB * SHM_V + v_rd_off(d0, 0, 0); \
        TRRD(l0, b_); TRRD(h0, b_ + 2048); TRRD(l1, b_ + 4096); TRRD(h1, b_ + 6144); TRRD(l2, b_ + 8192); TRRD(h2, b_ + 10240); TRRD(l3, b_ + 12288); TRRD(h3, b_ + 14336); \
        asm volatile("s_waitcnt lgkmcnt(0)" ::: "memory"); SBAR();   \
        o[d0] = __builtin_amdgcn_mfma_f32_32x32x16_bf16(pa0, (bf16x8){l0[0], l0[1], l0[2], l0[3], h0[0], h0[1], h0[2], h0[3]}, o[d0], 0, 0, 0);   \
        o[d0] = __builtin_amdgcn_mfma_f32_32x32x16_bf16(pa1, (bf16x8){l1[0], l1[1], l1[2], l1[3], h1[0], h1[1], h1[2], h1[3]}, o[d0], 0, 0, 0);   \
        o[d0] = __builtin_amdgcn_mfma_f32_32x32x16_bf16(pa2, (bf16x8){l2[0], l2[1], l2[2], l2[3], h2[0], h2[1], h2[2], h2[3]}, o[d0], 0, 0, 0);   \
        o[d0] = __builtin_amdgcn_mfma_f32_32x32x16_bf16(pa3, (bf16x8){l3[0], l3[1], l3[2], l3[3], h3[0], h3[1], h3[2], h3[3]}, o[d0], 0, 0, 0); } while (0)
    PV_D0(0); PV_D0(1); PV_D0(2); PV_D0(3);
#undef PV_D0
#undef TRRD
}

struct BlockRef { const bf16* Q; const bf16* K; const bf16* V; float* O; int P0; };
struct LinRef { const float* MT; const float* EMT; const float* REF; };
struct Seam { bf16x8 qr[8]; bf16x8 st_v0, st_v1, st_k0, st_k1; };
struct FinRef { const float* g; bf16* dst; float scale; };

#define ATT_VMW() asm volatile("s_waitcnt vmcnt(0)" ::: "memory")
#define ATT_VMWN(n) asm volatile("s_waitcnt vmcnt(%0)" :: "i"(n) : "memory")
__device__ __forceinline__ bf16x8 load8o(const bf16* base, unsigned voff) { return *reinterpret_cast<const bf16x8*>(reinterpret_cast<const char*>(base) + voff); }
template <class T> __device__ __forceinline__ T* uni(T* p) {
    const unsigned long long u = (unsigned long long)p; const unsigned lo = __builtin_amdgcn_readfirstlane((unsigned)u), hi = __builtin_amdgcn_readfirstlane((unsigned)(u >> 32));
    return (T*)(((unsigned long long)hi << 32) | lo); }
#define ATT_SLOAD(Kp, Vp, k0) do { const bf16* vb_ = uni((Vp) + (size_t)(k0) * LDV); const bf16* kb_ = uni((Kp) + (size_t)(k0) * LDK);                                         \
                                   S.st_v0 = load8o(vb_, offV); S.st_v1 = load8o(vb_, offV + 32u * LDV * 2u);              \
                                   S.st_k0 = load8o(kb_, offK); S.st_k1 = load8o(kb_, offK + 32u * LDK * 2u); } while (0)
#define ATT_SWRITE_K(bf) do { *(bf16x8*)(K_lds + (bf) * SHM_K + kws) = S.st_k0; *(bf16x8*)(K_lds + (bf) * SHM_K + kws + 32 * 256) = S.st_k1; } while (0)
#define ATT_SWRITE_V(bf) do { *(bf16x8*)(V_lds + (bf) * SHM_V + vst0) = S.st_v0; *(bf16x8*)(V_lds + (bf) * SHM_V + vst1) = S.st_v1; } while (0)

template <int LDQ, int LDK, int LDV>
__device__ __forceinline__ void prime(const BlockRef& cur, char* lds, Seam& S, const int tid) {
    const int wid = __builtin_amdgcn_readfirstlane(tid >> 6), lane = tid & 63, r32 = lane & 31, hi = lane >> 5;
    const int sr = tid >> 4, sc = (tid & 15) * 8, kws = KSWZ(sr, sc * 2); char* K_lds = lds + 2 * SHM_V;
    const unsigned offV = (unsigned)(sr * LDV + sc) * 2u, offK = (unsigned)(sr * LDK + sc) * 2u, offQ = (unsigned)(r32 * LDQ + hi * 8) * 2u;
    { const bf16* qb_ = uni(cur.Q + (size_t)(wid * QBLK) * LDQ);
#pragma unroll
    for (int d0 = 0; d0 < 8; ++d0) S.qr[d0] = load8o(qb_, offQ + d0 * 32u); }
    ATT_SLOAD(cur.K, cur.V, 0); ATT_VMW(); ATT_SWRITE_K(0);
    __syncthreads();
}

__device__ __forceinline__ void put_next(char* lds, const BlockRef& nxt, const int tid) {
    if (tid == 0) { volatile unsigned long long* p = (volatile unsigned long long*)(lds + LDS_BYTES); p[0] = (unsigned long long)nxt.Q; p[1] = (unsigned long long)nxt.K; p[2] = (unsigned long long)nxt.V; }
}
__device__ __forceinline__ const bf16* get_next(char* lds, int k) {
    const volatile unsigned* p = (const volatile unsigned*)(lds + LDS_BYTES) + 2 * k; const unsigned lo = p[0], hi = p[1];
    return (const bf16*)(((unsigned long long)(unsigned)__builtin_amdgcn_readfirstlane(hi) << 32) | (unsigned)__builtin_amdgcn_readfirstlane(lo));
}
template <int LDQ, int LDK, int LDV, int LDO, int LDD, int MODE>
__device__ __forceinline__ void block(const BlockRef& cur, char* lds, Seam& S, float lam, const LinRef& lr, const FinRef& fin, const int tid) {
    constexpr bool LIN = (MODE == 2 || MODE == 4), COMB = (MODE == 1 || MODE == 3), FIRST = (MODE == 1 || MODE == 2), SECOND = (MODE == 3 || MODE == 4);
    const int wid = __builtin_amdgcn_readfirstlane(tid >> 6), lane = tid & 63, r32 = lane & 31, hi = lane >> 5;
    const int NT = cur.P0 / KVBLK + QB / KVBLK;
    const int qlo = cur.P0 + wid * QBLK, qm = qlo + r32 - 4 * hi;
    char* V_lds = lds; char* K_lds = lds + 2 * SHM_V;
    float* ws = (float*)(lds + 2 * SHM_V + 2 * SHM_K) + wid * 64; float* li_l = ws, * al_l = ws + 32;
    float m_reg = -1e30f, l_reg = 0; f32x16 o[4] = {};
    const int sr = tid >> 4, sc = (tid & 15) * 8, vst0 = v_st(sr, sc), vst1 = v_st(32 + sr, sc), kws = KSWZ(sr, sc * 2);
    const int vb0 = (int)(uintptr_t)V_lds + v_rd_base(lane);
    const bf16* Kh = cur.K; const bf16* Vh = cur.V;
    const unsigned offV = (unsigned)(sr * LDV + sc) * 2u, offK = (unsigned)(sr * LDK + sc) * 2u, offQ = (unsigned)(r32 * LDQ + hi * 8) * 2u;
    float Mt = 0.f; if constexpr (LIN) Mt = *reinterpret_cast<const float*>(reinterpret_cast<const char*>(uni(lr.MT + qlo)) + (unsigned)r32 * 4u);
#define ATT_RESC(a) do { if constexpr (!LIN) { if (__any((a) < 1.f)) { if (hi == 0) al_l[r32] = (a); asm volatile("s_waitcnt lgkmcnt(0)" ::: "memory");              \
                     for (int d_ = 0; d_ < 4; ++d_) for (int r = 0; r < 16; ++r) o[d_][r] *= al_l[crow(r, hi)]; } } } while (0)
#define ATT_KBASE(t) ((t) * KVBLK)
#define ATT_MASKT(P0_, P1_, t) do { const int kb_ = ATT_KBASE(t); if (kb_ + KVBLK - 1 > qlo) mask_tile<LIN>(P0_, P1_, qm - kb_); } while (0)
#define ATT_PSM(P0_, P1_, mnX, alX, t) do { if constexpr (LIN) { mnX = __builtin_amdgcn_exp2f((lr.REF[t] - Mt) * 1.4426950408889634f); } \
                                            else partialSM(P0_, P1_, m_reg, mnX, alX); } while (0)
#define ATT_FSM(P0_, P1_, alY, mnY) do { if constexpr (LIN) { partialLin(P0_, P1_, mnY); finishLin(P0_, P1_, l_reg, pa0, pa1, pa2, pa3); } else finishSM(P0_, P1_, alY, l_reg, pa0, pa1, pa2, pa3); } while (0)
#define ATT_SEAM_K0() do { ATT_VMW(); ATT_SWRITE_K(0); SBAR(); } while (0)
    f32x16 pA0, pA1, pB0, pB1; float mnA = 0.f, mnB = 0.f, alA = 1.f, alB = 1.f; bf16x8 pa0, pa1, pa2, pa3;
    ATT_SWRITE_V(0); SBAR();
    const char* qlds = lds + LDS_QIMG + wid * 8192 + lane * 16;
    if constexpr (LIN) {
#pragma unroll
        for (int d0 = 0; d0 < 8; ++d0) *reinterpret_cast<bf16x8*>(const_cast<char*>(qlds) + d0 * 1024) = S.qr[d0];
    }
    if (NT > 1) ATT_SLOAD(Kh, Vh, ATT_KBASE(1));
    SBAR(); qkt<0, LIN>(pA0, pA1, K_lds, r32, hi, S.qr, qlds);
    ATT_MASKT(pA0, pA1, 0); ATT_PSM(pA0, pA1, mnA, alA, 0);
    if (NT > 1) { ATT_VMW(); ATT_SWRITE_V(1); ATT_SWRITE_K(1); }
    __syncthreads();
#define ATT_HALF_STEP(PX0, PX1, mnX, alX, PY0, PY1, alY, mnY, t, KB, VB, SB) do {                                                      \
        SBAR(); qkt<KB, LIN>(PX0, PX1, K_lds, r32, hi, S.qr, qlds);                                             \
        ATT_FSM(PY0, PY1, alY, mnY); SBAR();                                                           \
        if ((t) + 1 < NT) { ATT_SLOAD(Kh, Vh, ATT_KBASE((t) + 1)); SBAR(); }                                               \
        pv_tile<VB>(o, vb0, pa0, pa1, pa2, pa3); ATT_MASKT(PX0, PX1, (t)); ATT_PSM(PX0, PX1, mnX, alX, (t));                                        \
        __syncthreads();                                                                                                      \
        if ((t) + 1 < NT) { ATT_VMW(); ATT_SWRITE_V(SB); ATT_SWRITE_K(SB); }                                                                          \
        ATT_RESC(alX); __syncthreads(); } while (0)
    for (int t = 1; t + 1 < NT; t += 2) {
        ATT_HALF_STEP(pB0, pB1, mnB, alB, pA0, pA1, alA, mnA, t, 1, 0, 0);
        ATT_HALF_STEP(pA0, pA1, mnA, alA, pB0, pB1, alB, mnB, t + 1, 0, 1, 1);
    }
    SBAR(); qkt<1, LIN>(pB0, pB1, K_lds, r32, hi, S.qr, qlds); SBAR();
    { const bf16* nK = get_next(lds, 1); const bf16* nV = get_next(lds, 2); ATT_SLOAD(nK, nV, 0); } SBAR();
    ATT_FSM(pA0, pA1, alA, mnA); SBAR();
    pv_tile<0>(o, vb0, pa0, pa1, pa2, pa3);
    ATT_MASKT(pB0, pB1, NT - 1); ATT_PSM(pB0, pB1, mnB, alB, NT - 1); __syncthreads(); ATT_RESC(alB);
    ATT_FSM(pB0, pB1, alB, mnB); SBAR(); pv_tile<1>(o, vb0, pa0, pa1, pa2, pa3);
    SBAR(); ATT_SEAM_K0();
    { const bf16* qb_ = uni(get_next(lds, 0) + (size_t)(wid * QBLK) * LDQ);
#pragma unroll
    for (int d0 = 0; d0 < 8; ++d0) S.qr[d0] = load8o(qb_, offQ + d0 * 32u); }
    SBAR();
    if constexpr (LIN) { auto rr = __builtin_amdgcn_permlane32_swap(__float_as_uint(l_reg), __float_as_uint(l_reg), false, false); l_reg = __uint_as_float(rr[0]) + __uint_as_float(rr[1]); }
    if (hi == 0) li_l[r32] = l_reg; asm volatile("s_waitcnt lgkmcnt(0)" ::: "memory");
    float rli[16];
    const float* emtp = LIN ? reinterpret_cast<const float*>(reinterpret_cast<const char*>(uni(lr.EMT + (cur.P0 + wid * QBLK))) + (unsigned)hi * 16u) : nullptr;
#pragma unroll
    for (int r = 0; r < 16; ++r) {
        const float lv = li_l[crow(r, hi)];
        if constexpr (LIN) { const float em = emtp[(r & 3) + 8 * (r >> 2)]; rli[r] = __builtin_amdgcn_rcpf(fmaxf(fabsf(lv), em)); }
        else rli[r] = __builtin_amdgcn_rcpf(lv);
    }
    char* Ow = reinterpret_cast<char*>(uni(cur.O + (size_t)(wid * QBLK) * LDO));
    const unsigned offO = (unsigned)(4 * hi * LDO + r32) * 4u;
#define ATT_OOFF(r_, d0_) (offO + (unsigned)(((((r_) & 3) + 8 * ((r_) >> 2)) * LDO + (d0_) * 32) * 4))
#pragma unroll
    for (int r = 0; r < 16; ++r) {
#pragma unroll
        for (int d0 = 0; d0 < 4; ++d0) { float v = o[d0][r] * rli[r];
            if constexpr (COMB) { const float prev = *reinterpret_cast<const float*>(Ow + ATT_OOFF(r, d0)); v = prev - lam * v; }
            o[d0][r] = v; } }
    if constexpr (MODE == 0) {
#pragma unroll
        for (int r = 0; r < 16; ++r)
#pragma unroll
            for (int d0 = 0; d0 < 4; ++d0) *reinterpret_cast<float*>(Ow + ATT_OOFF(r, d0)) = o[d0][r];
    } else {
        float* ssq_l = (float*)(lds + LDS_SSQ) + wid * 32;
        float sq[16];
#pragma unroll
        for (int r = 0; r < 16; ++r) { sq[r] = (o[0][r] * o[0][r] + o[1][r] * o[1][r]) + (o[2][r] * o[2][r] + o[3][r] * o[3][r]); }
#define ATT_SQX(ST) do { _Pragma("unroll") for (int r = 0; r < 16; ++r) sq[r] += __uint_as_float((unsigned)__builtin_amdgcn_ds_swizzle((int)__float_as_uint(sq[r]), ((ST) << 10) | 0x1f)); } while (0)
        ATT_SQX(1); ATT_SQX(2); ATT_SQX(4); ATT_SQX(8); ATT_SQX(16);
#undef ATT_SQX
        if constexpr (FIRST) {
#pragma unroll
            for (int r = 0; r < 16; ++r)
#pragma unroll
                for (int d0 = 0; d0 < 4; ++d0) *reinterpret_cast<float*>(Ow + ATT_OOFF(r, d0)) = o[d0][r];
            if (r32 == 0) {
#pragma unroll
                for (int r = 0; r < 16; ++r) ssq_l[crow(r, hi)] = sq[r];
            }
        } else {
            asm volatile("s_waitcnt lgkmcnt(0)" ::: "memory");
#pragma unroll
            for (int r = 0; r < 16; ++r) sq[r] = __builtin_amdgcn_rsqf((sq[r] + ssq_l[crow(r, hi)]) * (1.0f / 256.0f) + 1e-6f) * fin.scale;
            char* Dw = reinterpret_cast<char*>(uni(fin.dst + (size_t)(wid * QBLK) * LDD));
            const unsigned offD = (unsigned)(4 * hi * LDD + r32) * 2u;
#define ATT_DOFF(r_, c_) (offD + (unsigned)(((((r_) & 3) + 8 * ((r_) >> 2)) * LDD + (c_)) * 2))
            const float* gp = reinterpret_cast<const float*>(reinterpret_cast<const char*>(uni(fin.g)) + (unsigned)r32 * 4u);
#pragma unroll
            for (int d0 = 0; d0 < 4; ++d0) { const float g1 = gp[128 + d0 * 32];
#pragma unroll
                for (int r = 0; r < 16; ++r) { float val = o[d0][r] * sq[r] * g1; bf16* dp = reinterpret_cast<bf16*>(Dw + ATT_DOFF(r, 128 + d0 * 32));
                    if constexpr (LIN) val *= __uint_as_float((unsigned)(*dp) << 16);
                    *dp = (bf16)(cvtpk(val, val) & 0xffffu); } }
            const char* Ow0 = Ow - 128 * 4;
#pragma unroll
            for (int d0 = 0; d0 < 4; ++d0) { const float g0 = gp[d0 * 32];
#pragma unroll
                for (int r = 0; r < 16; ++r) { const float x0 = *reinterpret_cast<const float*>(Ow0 + ATT_OOFF(r, d0));
                    float val = x0 * sq[r] * g0; bf16* dp = reinterpret_cast<bf16*>(Dw + ATT_DOFF(r, d0 * 32));
                    if constexpr (LIN) val *= __uint_as_float((unsigned)(*dp) << 16);
                    *dp = (bf16)(cvtpk(val, val) & 0xffffu); } }
#undef ATT_DOFF
        }
    }
#undef ATT_OOFF
    __syncthreads();
#undef ATT_RESC
#undef ATT_KBASE
#undef ATT_MASKT
#undef ATT_PSM
#undef ATT_FSM
#undef ATT_SEAM_K0
#undef ATT_HALF_STEP
}
#undef ATT_VMW
#undef ATT_VMWN
#undef ATT_SLOAD
#undef ATT_SWRITE_K
#undef ATT_SWRITE_V
#undef ATT_PK4
#undef KSWZ
#undef SBAR
}
namespace attw {
using att::bf16; using att::bf16x8; using att::s16x4; using att::f32x16; using att::f32x4; using att::u32x4;
using att::crow; using att::cvtpk; using att::uni; using att::load8o; using att::mask_tile; using att::partialSM; using att::finishSM; using att::partialLin; using att::finishLin; using att::v_rd_base;
using att::BlockRef; using att::LinRef; using att::FinRef;
constexpr int D = 128, DV = 256, NW = 8, QBLK = 32, KVBLK = 64, QB = NW * QBLK;
constexpr int SHM_K = KVBLK * D * 2, SHM_V = KVBLK * DV * 2;
constexpr int QIMG_W = 7 * 1024;
constexpr int OFF_V = 0, OFF_K = 2 * SHM_V, OFF_WS = OFF_K + 2 * SHM_K, OFF_NX = OFF_WS + NW * 64 * 4, OFF_QIMG = OFF_NX + 32, LDS_TOTAL = OFF_QIMG + NW * QIMG_W;
#define KSWZ(row, colB) ((row) * 256 + ((colB) ^ (((row) & 7) << 4)))
#define SBAR() __builtin_amdgcn_sched_barrier(0)
typedef unsigned u32x2 __attribute__((ext_vector_type(2)));
#define ATW_GAS __attribute__((address_space(1)))
__device__ __forceinline__ int v_st(int k, int c) { const int kk = (k & ~0xC) | ((k & 4) << 1) | ((k & 8) >> 1); return ((kk >> 3) * 8 + (c >> 5)) * 512 + ((kk & 7) * 32 + (c & 31)) * 2; }
constexpr int v_rd_off(int d0, int ks, int half) { return d0 * 512 + ks * 8192 + half * 4096; }
struct Seam { bf16x8 qr[8]; };

template <int KB>
__device__ __forceinline__ void qkt(f32x16& p0, f32x16& p1, const char* K_lds, int r32, int hi, const char* qlds, const bf16x8 q7) {
    typedef __attribute__((address_space(3))) const char* lp;
    p0 = f32x16{}; p1 = f32x16{};
    const unsigned ka = (unsigned)(uintptr_t)(K_lds + KB * SHM_K);
    unsigned kb[4];
#pragma unroll
    for (int dd = 0; dd < 4; ++dd) kb[dd] = ka + (unsigned)KSWZ(r32, (dd * 16 + hi * 8) * 2);
    const unsigned qa = (unsigned)(uintptr_t)qlds;
#define QK_RD(B0, B1, QF, d0) do { \
        asm volatile("ds_read_b128 %0, %1 offset:%2" : "=&v"(B0) : "v"(kb[(d0) & 3]), "i"(((d0) >> 2) * 128) : "memory"); \
        asm volatile("ds_read_b128 %0, %1 offset:%2" : "=&v"(B1) : "v"(kb[(d0) & 3]), "i"(((d0) >> 2) * 128 + 32 * 256) : "memory"); \
        if ((d0) < 7) asm volatile("ds_read_b128 %0, %1 offset:%2" : "=&v"(QF) : "v"(qa), "i"((d0) * 1024) : "memory"); else QF = q7; } while (0)
#define QK_W(n) asm volatile("s_waitcnt lgkmcnt(" #n ")" ::: "memory")
#define QK_MM(B0, B1, QF) do { p0 = __builtin_amdgcn_mfma_f32_32x32x16_bf16(B0, QF, p0, 0, 0, 0); p1 = __builtin_amdgcn_mfma_f32_32x32x16_bf16(B1, QF, p1, 0, 0, 0); } while (0)
    bf16x8 xa0, xa1, xaq, xb0, xb1, xbq;
    QK_RD(xa0, xa1, xaq, 0);
    QK_RD(xb0, xb1, xbq, 1); QK_W(3); SBAR(); QK_MM(xa0, xa1, xaq); SBAR();
    QK_RD(xa0, xa1, xaq, 2); QK_W(3); SBAR(); QK_MM(xb0, xb1, xbq); SBAR();
    QK_RD(xb0, xb1, xbq, 3); QK_W(3); SBAR(); QK_MM(xa0, xa1, xaq); SBAR();
    QK_RD(xa0, xa1, xaq, 4); QK_W(3); SBAR(); QK_MM(xb0, xb1, xbq); SBAR();
    QK_RD(xb0, xb1, xbq, 5); QK_W(3); SBAR(); QK_MM(xa0, xa1, xaq); SBAR();
    QK_RD(xa0, xa1, xaq, 6); QK_W(3); SBAR(); QK_MM(xb0, xb1, xbq); SBAR();
    QK_RD(xb0, xb1, xbq, 7); QK_W(2); SBAR(); QK_MM(xa0, xa1, xaq); SBAR();
    QK_W(0); SBAR(); QK_MM(xb0, xb1, xbq);
#undef QK_RD
#undef QK_W
#undef QK_MM
}
template <int VB>
__device__ __forceinline__ void pv_tile(f32x16* o, int vb0, bf16x8 pa0, bf16x8 pa1, bf16x8 pa2, bf16x8 pa3) {
#define TRRD(dst, off) asm volatile("ds_read_b64_tr_b16 %0, %1 offset:%2" : "=&v"(dst) : "v"(vb0), "i"(off) : "memory")
#define PV_RD(S_, d0) do { constexpr int b_ = VB * SHM_V + v_rd_off(d0, 0, 0); \
        TRRD(S_##0, b_); TRRD(S_##1, b_ + 4096); TRRD(S_##2, b_ + 8192); TRRD(S_##3, b_ + 12288); TRRD(S_##4, b_ + 16384); TRRD(S_##5, b_ + 20480); TRRD(S_##6, b_ + 24576); TRRD(S_##7, b_ + 28672); } while (0)
#define PV_MM(S_, d0) do { \
        o[d0] = __builtin_amdgcn_mfma_f32_32x32x16_bf16((bf16x8){S_##0[0], S_##0[1], S_##0[2], S_##0[3], S_##1[0], S_##1[1], S_##1[2], S_##1[3]}, pa0, o[d0], 0, 0, 0);   \
        o[d0] = __builtin_amdgcn_mfma_f32_32x32x16_bf16((bf16x8){S_##2[0], S_##2[1], S_##2[2], S_##2[3], S_##3[0], S_##3[1], S_##3[2], S_##3[3]}, pa1, o[d0], 0, 0, 0);   \
        o[d0] = __builtin_amdgcn_mfma_f32_32x32x16_bf16((bf16x8){S_##4[0], S_##4[1], S_##4[2], S_##4[3], S_##5[0], S_##5[1], S_##5[2], S_##5[3]}, pa2, o[d0], 0, 0, 0);   \
        o[d0] = __builtin_amdgcn_mfma_f32_32x32x16_bf16((bf16x8){S_##6[0], S_##6[1], S_##6[2], S_##6[3], S_##7[0], S_##7[1], S_##7[2], S_##7[3]}, pa3, o[d0], 0, 0, 0); } while (0)
#define PV_W8() do { asm volatile("s_waitcnt lgkmcnt(8)" ::: "memory"); SBAR(); } while (0)
#define PV_W0() do { asm volatile("s_waitcnt lgkmcnt(0)" ::: "memory"); SBAR(); } while (0)
    s16x4 fa0, fa1, fa2, fa3, fa4, fa5, fa6, fa7, fb0, fb1, fb2, fb3, fb4, fb5, fb6, fb7;
    PV_RD(fa, 0);
    PV_RD(fb, 1); PV_W8(); PV_MM(fa, 0); SBAR();
    PV_RD(fa, 2); PV_W8(); PV_MM(fb, 1); SBAR();
    PV_RD(fb, 3); PV_W8(); PV_MM(fa, 2); SBAR();
    PV_RD(fa, 4); PV_W8(); PV_MM(fb, 3); SBAR();
    PV_RD(fb, 5); PV_W8(); PV_MM(fa, 4); SBAR();
    PV_RD(fa, 6); PV_W8(); PV_MM(fb, 5); SBAR();
    PV_RD(fb, 7); PV_W8(); PV_MM(fa, 6); SBAR();
    PV_W0(); PV_MM(fb, 7);
#undef PV_RD
#undef PV_MM
#undef PV_W8
#undef PV_W0
#undef TRRD
}

#define ATW_VMW() asm volatile("s_waitcnt vmcnt(0)" ::: "memory")
__device__ __forceinline__ void glds16(const void* gsrc, unsigned lds_dst) { unsigned keep;
    asm volatile("s_mov_b32 %0, m0\n\ts_mov_b32 m0, %2\n\ts_nop 0\n\tglobal_load_lds_dwordx4 %1, off\n\ts_mov_b32 m0, %0" : "=&s"(keep) : "v"(gsrc), "s"(lds_dst) : "memory"); }
#define ATW_DMA_SETUP()                                                                                                                   \
    unsigned offKd[2], offVd[4];                                                                                                          \
    _Pragma("unroll") for (int i_ = 0; i_ < 2; ++i_) { const int row_ = 8 * wid + 4 * i_ + (lane >> 4), c_ = (lane & 15) ^ (row_ & 7); offKd[i_] = (unsigned)(row_ * LDK + c_ * 8) * 2u; } \
    _Pragma("unroll") for (int i_ = 0; i_ < 4; ++i_) { const int st_ = 8 * wid + 2 * i_ + (lane >> 5), kk_ = 8 * (st_ >> 3) + ((lane & 31) >> 2);                                          \
        const int k_ = (kk_ & ~0xC) | ((kk_ & 4) << 1) | ((kk_ & 8) >> 1), col_ = (st_ & 7) * 32 + 8 * (lane & 3); offVd[i_] = (unsigned)(k_ * LDV + col_) * 2u; }                          \
    const unsigned ldsKd = (unsigned)__builtin_amdgcn_readfirstlane((int)((unsigned)(uintptr_t)(lds + OFF_K) + (unsigned)wid * 2048u));                                                     \
    const unsigned ldsVd = (unsigned)__builtin_amdgcn_readfirstlane((int)((unsigned)(uintptr_t)(lds + OFF_V) + (unsigned)wid * 4096u))
#define ATW_DMA_K(Kp, k0, buf) do { const char* kb_ = reinterpret_cast<const char*>(uni((Kp) + (size_t)(k0) * LDK));                        \
        glds16(kb_ + offKd[0], ldsKd + (unsigned)(buf) * SHM_K); glds16(kb_ + offKd[1], ldsKd + (unsigned)(buf) * SHM_K + 1024u); } while (0)
#define ATW_DMA_V(Vp, k0, buf) do { const char* vb_ = reinterpret_cast<const char*>(uni((Vp) + (size_t)(k0) * LDV));                        \
        glds16(vb_ + offVd[0], ldsVd + (unsigned)(buf) * SHM_V); glds16(vb_ + offVd[1], ldsVd + (unsigned)(buf) * SHM_V + 1024u);          \
        glds16(vb_ + offVd[2], ldsVd + (unsigned)(buf) * SHM_V + 2048u); glds16(vb_ + offVd[3], ldsVd + (unsigned)(buf) * SHM_V + 3072u); } while (0)
template <int LDQ, int LDK, int LDV>
__device__ __forceinline__ void prime(const BlockRef& cur, char* lds, Seam& S, const float* gains, const int tid) {
    const int wid = __builtin_amdgcn_readfirstlane(tid >> 6), lane = tid & 63, r32 = lane & 31, hi = lane >> 5;
    const unsigned offQ = (unsigned)(r32 * LDQ + hi * 8) * 2u;
    ATW_DMA_SETUP();
    asm volatile("s_waitcnt vmcnt(0) lgkmcnt(0)\n\ts_barrier" ::: "memory");
    { const f32x4 gv = *reinterpret_cast<const f32x4*>(reinterpret_cast<const char*>(uni(gains)) + (unsigned)lane * 16u);
      *reinterpret_cast<f32x4*>(lds + OFF_WS + 256 + lane * 16) = gv; }
    ATW_DMA_K(cur.K, 0, 0); ATW_DMA_V(cur.V, 0, 0);
    { const bf16* qb_ = uni(cur.Q + (size_t)(wid * QBLK) * LDQ);
#pragma unroll
    for (int d0 = 0; d0 < 8; ++d0) S.qr[d0] = load8o(qb_, offQ + d0 * 32u); }
}
__device__ __forceinline__ void put_next(char* lds, const BlockRef& nxt, const int tid) {
    if (tid == 0) { volatile unsigned long long* p = (volatile unsigned long long*)(lds + OFF_NX); p[0] = (unsigned long long)nxt.Q; p[1] = (unsigned long long)nxt.K; p[2] = (unsigned long long)nxt.V; }
}
__device__ __forceinline__ const bf16* get_next(char* lds, int k) {
    const volatile unsigned* p = (const volatile unsigned*)(lds + OFF_NX) + 2 * k; const unsigned lo = p[0], hi = p[1];
    return (const bf16*)(((unsigned long long)(unsigned)__builtin_amdgcn_readfirstlane(hi) << 32) | (unsigned)__builtin_amdgcn_readfirstlane(lo));
}

typedef unsigned short h16s;
typedef _Float16 h16x2 __attribute__((ext_vector_type(2)));
__device__ __forceinline__ unsigned pkh(float a, float b) { const h16x2 v = {(_Float16)a, (_Float16)b}; return __builtin_bit_cast(unsigned, v); }
__device__ __forceinline__ float hlo(unsigned w) { return (float)__builtin_bit_cast(h16x2, w).x; }
__device__ __forceinline__ float hhi(unsigned w) { return (float)__builtin_bit_cast(h16x2, w).y; }
template <int LDQ, int LDK, int LDV, int LDO, int LDD, int MODE>
__device__ __forceinline__ void block(const BlockRef& cur, char* lds, Seam& S, float lam, const LinRef& lr, const FinRef& fin, const int tid) {
    constexpr bool LIN = (MODE == 2);
    const int wid = __builtin_amdgcn_readfirstlane(tid >> 6), lane = tid & 63, r32 = lane & 31, hi = lane >> 5;
    const int NT = cur.P0 / KVBLK + QB / KVBLK;
    const int qlo = cur.P0 + wid * QBLK, qm = qlo + r32 - 4 * hi;
    char* V_lds = lds + OFF_V; char* K_lds = lds + OFF_K;
    float* ws = (float*)(lds + OFF_WS);
    float m_reg = -1e30f, l_reg = 0; f32x16 o[8] = {};
    const int vb0 = (int)(uintptr_t)V_lds + v_rd_base(lane);
    const bf16* Kh = cur.K; const bf16* Vh = cur.V;
    const unsigned offQ = (unsigned)(r32 * LDQ + hi * 8) * 2u;
    ATW_DMA_SETUP();
    float Mt = 0.f;
    if constexpr (LIN) { Mt = *reinterpret_cast<const float*>(reinterpret_cast<const char*>(uni(lr.MT + qlo)) + (unsigned)r32 * 4u);
        ws[lane] = *reinterpret_cast<const float*>(reinterpret_cast<const char*>(uni(lr.REF)) + (unsigned)lane * 4u); }
    f32x16 p0, p1; float mn = 0.f, al = 1.f; bf16x8 pa0, pa1, pa2, pa3;
#define ATW_RESC(a) do { if constexpr (!LIN) { if (__any((a) < 1.f)) { for (int d_ = 0; d_ < 8; ++d_) for (int r = 0; r < 16; ++r) o[d_][r] *= (a); } } } while (0)
#define ATW_MASKT(t) do { const int kb_ = (t) * KVBLK; if (kb_ + KVBLK - 1 > qlo) mask_tile<LIN>(p0, p1, qm - kb_); } while (0)
#define ATW_SM(t) do { ATW_MASKT(t); if constexpr (LIN) { const float f_ = __builtin_amdgcn_exp2f((ws[t] - Mt) * 1.4426950408889634f); partialLin(p0, p1, f_); finishLin(p0, p1, l_reg, pa0, pa1, pa2, pa3); } \
                       else { partialSM(p0, p1, m_reg, mn, al); finishSM(p0, p1, al, l_reg, pa0, pa1, pa2, pa3); } } while (0)
#define ATW_BAR() asm volatile("s_waitcnt lgkmcnt(0)\n\ts_barrier" ::: "memory")
    const char* qlds = lds + OFF_QIMG + wid * QIMG_W + lane * 16;
    ATW_VMW();
#pragma unroll
    for (int d0 = 0; d0 < 7; ++d0) *reinterpret_cast<bf16x8*>(const_cast<char*>(qlds) + d0 * 1024) = S.qr[d0];
    const bf16x8 q7 = S.qr[7];
    SBAR();
    ATW_DMA_K(Kh, KVBLK, 1);
    SBAR(); ATW_BAR();
#define ATW_ISSUE_K(x) do { if ((x) < NT) { ATW_DMA_K(Kh, (x) * KVBLK, (x) & 1); } else { const bf16* nK = get_next(lds, 1); ATW_DMA_K(nK, 0, 0); } } while (0)
#define ATW_ISSUE_V(x) do { if ((x) < NT) { ATW_DMA_V(Vh, (x) * KVBLK, (x) & 1); } else { const bf16* nV = get_next(lds, 2); ATW_DMA_V(nV, 0, 0); } } while (0)
#define ATW_STEP(t, KB, PVB, HEADSTEP) do {                                                                                            \
        SBAR();                                                                                                                       \
        if (!(HEADSTEP)) { pv_tile<PVB>(o, vb0, pa0, pa1, pa2, pa3); SBAR(); }                                                        \
        qkt<KB>(p0, p1, K_lds, r32, hi, qlds, q7); SBAR();                                                                            \
        ATW_SM(t); SBAR();                                                                                                            \
        ATW_VMW(); ATW_BAR();                                                                                                         \
        if ((t) + 2 <= NT) ATW_ISSUE_K((t) + 2);                                                                                      \
        ATW_ISSUE_V((t) + 1); SBAR();                                                                                                 \
        ATW_RESC(al); } while (0)
    ATW_STEP(0, 0, 0, true);
    for (int t = 1; t + 1 < NT; t += 2) {
        ATW_STEP(t, 1, 0, false);
        ATW_STEP(t + 1, 0, 1, false);
    }
    ATW_STEP(NT - 1, 1, 0, false);
    SBAR(); pv_tile<1>(o, vb0, pa0, pa1, pa2, pa3); SBAR();
    const bf16* nq_ = get_next(lds, 0);
    ATW_BAR();
#undef ATW_ISSUE_K
#undef ATW_ISSUE_V
#undef ATW_BAR
    { const bf16* qb_ = uni(nq_ + (size_t)(wid * QBLK) * LDQ);
#pragma unroll
    for (int d0 = 0; d0 < 8; ++d0) S.qr[d0] = load8o(qb_, offQ + d0 * 32u); }
    SBAR();
    if constexpr (LIN) { auto rr = __builtin_amdgcn_permlane32_swap(__float_as_uint(l_reg), __float_as_uint(l_reg), false, false); l_reg = __uint_as_float(rr[0]) + __uint_as_float(rr[1]); }
    float rl;
    if constexpr (LIN) { const float em = *reinterpret_cast<const float*>(reinterpret_cast<const char*>(uni(lr.EMT + (cur.P0 + wid * QBLK))) + (unsigned)r32 * 4u); rl = __builtin_amdgcn_rcpf(fmaxf(fabsf(l_reg), em)); }
    else rl = __builtin_amdgcn_rcpf(l_reg);
    if constexpr (MODE == 0) {
        char* Ow = reinterpret_cast<char*>(uni(reinterpret_cast<h16s*>(cur.O) + (size_t)(wid * QBLK) * LDO));
        const unsigned offO = (unsigned)(r32 * LDO + 8 * hi) * 2u;
#pragma unroll
        for (int d0 = 0; d0 < 8; ++d0)
#pragma unroll
            for (int g0 = 0; g0 < 4; g0 += 2) {
                const unsigned a0 = pkh(o[d0][4 * g0] * rl, o[d0][4 * g0 + 1] * rl), a1 = pkh(o[d0][4 * g0 + 2] * rl, o[d0][4 * g0 + 3] * rl);
                const unsigned b0 = pkh(o[d0][4 * g0 + 4] * rl, o[d0][4 * g0 + 5] * rl), b1 = pkh(o[d0][4 * g0 + 6] * rl, o[d0][4 * g0 + 7] * rl);
                auto r0 = __builtin_amdgcn_permlane32_swap(a0, b0, false, false); auto r1 = __builtin_amdgcn_permlane32_swap(a1, b1, false, false);
                const u32x4 w = {r0[0], r1[0], r0[1], r1[1]};
                *(ATW_GAS u32x4*)(Ow + (offO + (unsigned)((d0 * 32 + 8 * g0) * 2))) = w;
            }
    } else {
        if constexpr (MODE == 1) {
            const char* Ow = reinterpret_cast<const char*>(uni(reinterpret_cast<const h16s*>(cur.O) + (size_t)(wid * QBLK) * LDO));
            const unsigned offO = (unsigned)(r32 * LDO + 8 * hi) * 2u;
#pragma unroll
            for (int d0 = 0; d0 < 8; ++d0)
#pragma unroll
                for (int g0 = 0; g0 < 4; g0 += 2) { const u32x4 w = *(const ATW_GAS u32x4*)(Ow + (offO + (unsigned)((d0 * 32 + 8 * g0) * 2)));
                    auto r0 = __builtin_amdgcn_permlane32_swap(w.x, w.z, false, false); auto r1 = __builtin_amdgcn_permlane32_swap(w.y, w.w, false, false);
                    const float pv[8] = {hlo(r0[0]), hhi(r0[0]), hlo(r1[0]), hhi(r1[0]), hlo(r0[1]), hhi(r0[1]), hlo(r1[1]), hhi(r1[1])};
#pragma unroll
                    for (int e = 0; e < 8; ++e) o[d0][4 * g0 + e] = pv[e] - lam * (o[d0][4 * g0 + e] * rl); }
        } else {
#pragma unroll
            for (int d0 = 0; d0 < 8; ++d0)
#pragma unroll
                for (int r = 0; r < 16; ++r) o[d0][r] *= rl;
        }
        float sq = 0.f;
#pragma unroll
        for (int d0 = 0; d0 < 8; ++d0) { float s4[4];
#pragma unroll
            for (int g = 0; g < 4; ++g) s4[g] = (o[d0][4 * g] * o[d0][4 * g] + o[d0][4 * g + 1] * o[d0][4 * g + 1]) + (o[d0][4 * g + 2] * o[d0][4 * g + 2] + o[d0][4 * g + 3] * o[d0][4 * g + 3]);
            sq += (s4[0] + s4[1]) + (s4[2] + s4[3]); }
        { auto rr = __builtin_amdgcn_permlane32_swap(__float_as_uint(sq), __float_as_uint(sq), false, false); sq = __uint_as_float(rr[0]) + __uint_as_float(rr[1]); }
        const float rs = __builtin_amdgcn_rsqf(sq * (1.0f / 256.0f) + 1e-6f) * fin.scale;
        char* Dw = reinterpret_cast<char*>(uni(fin.dst + (size_t)(wid * QBLK) * LDD));
        const unsigned offD = (unsigned)(r32 * LDD) * 2u;
        const char* gp = lds + OFF_WS + 256 + hi * 16;
        u32x2 gtN[4];
        if constexpr (LIN) {
#pragma unroll
            for (int g = 0; g < 4; ++g) gtN[g] = *(const ATW_GAS u32x2*)(Dw + (offD + (unsigned)((8 * g + 4 * hi) * 2)));
        }
#pragma unroll
        for (int d0 = 0; d0 < 8; ++d0) {
            u32x2 gt[4];
            if constexpr (LIN) {
#pragma unroll
                for (int g = 0; g < 4; ++g) gt[g] = gtN[g];
                if (d0 < 7) {
#pragma unroll
                    for (int g = 0; g < 4; ++g) gtN[g] = *(const ATW_GAS u32x2*)(Dw + (offD + (unsigned)(((d0 + 1) * 32 + 8 * g + 4 * hi) * 2)));
                }
                asm volatile("" ::: "memory");
            }
#pragma unroll
            for (int g0 = 0; g0 < 4; g0 += 2) {
                const f32x4 ga = *reinterpret_cast<const f32x4*>(gp + (d0 * 32 + 8 * g0) * 4), gb = *reinterpret_cast<const f32x4*>(gp + (d0 * 32 + 8 * g0 + 8) * 4);
                float va[4], vb[4];
#pragma unroll
                for (int e = 0; e < 4; ++e) { va[e] = o[d0][4 * g0 + e] * rs * ga[e]; vb[e] = o[d0][4 * g0 + 4 + e] * rs * gb[e]; }
                if constexpr (LIN) {
                    const u32x2 ta = gt[g0], tb = gt[g0 + 1];
                    va[0] *= __uint_as_float(ta.x << 16); va[1] *= __uint_as_float(ta.x & 0xffff0000u); va[2] *= __uint_as_float(ta.y << 16); va[3] *= __uint_as_float(ta.y & 0xffff0000u);
                    vb[0] *= __uint_as_float(tb.x << 16); vb[1] *= __uint_as_float(tb.x & 0xffff0000u); vb[2] *= __uint_as_float(tb.y << 16); vb[3] *= __uint_as_float(tb.y & 0xffff0000u);
                }
                const unsigned a0 = cvtpk(va[0], va[1]), a1 = cvtpk(va[2], va[3]), b0 = cvtpk(vb[0], vb[1]), b1 = cvtpk(vb[2], vb[3]);
                auto r0 = __builtin_amdgcn_permlane32_swap(a0, b0, false, false); auto r1 = __builtin_amdgcn_permlane32_swap(a1, b1, false, false);
                const u32x4 w = {r0[0], r1[0], r0[1], r1[1]};
                *(ATW_GAS u32x4*)(Dw + (offD + (unsigned)((d0 * 32 + 8 * (g0 + hi)) * 2))) = w;
            }
        }
    }
#undef ATW_RESC
#undef ATW_MASKT
#undef ATW_SM
#undef ATW_STEP
}
#undef ATW_VMW
#undef ATW_DMA_SETUP
#undef ATW_DMA_K
#undef ATW_DMA_V
#undef KSWZ
#undef SBAR
}
constexpr int NWAVES = 8;
constexpr int DM = 2048, NB = 8, SEQ = 4096, DEPTH = 4, M = NB * SEQ;
constexpr int DIN = 13320, NP = 13312, DFF = 5632, NGU = 2 * DFF;
constexpr int KMRG = 3072;
constexpr int C_MQK = 0, C_MV = 1024, C_MO = 2048, C_AQ = 3072, C_AK = 5120, C_AV = 7168, C_GM = 9216, C_GA = 11264;
constexpr float EPS = 1e-6f;
#ifndef DBG
#define DBG 0
#endif

constexpr size_t MiB = 1u << 20;
constexpr size_t WS_CTL = 0, CTL_ZERO_BYTES = 1 * MiB;
constexpr size_t WS_ROPE = 2 * MiB;
constexpr size_t WS_LIF = 6 * MiB;
constexpr size_t WS_MT = 7 * MiB;
constexpr size_t WS_EMT = WS_MT + 512 * 1024;
constexpr size_t WS_KSC = 8 * MiB;
constexpr size_t WS_REF = WS_KSC + 512 * 1024;
constexpr size_t WS_WIN = 16 * MiB, WS_PM = 68 * MiB, WS_PA = 72 * MiB, WS_WO = 80 * MiB, WS_WGU = 88 * MiB, WS_WD = 132 * MiB;
constexpr size_t WS_HY = 154 * MiB;
constexpr size_t WS_QKM = 282 * MiB;
constexpr size_t WS_HT = 346 * MiB;
constexpr size_t WS_XH = WS_HT;
constexpr size_t WS_OST = 474 * MiB;
constexpr size_t WS_PROJ = 730 * MiB;
constexpr size_t WS_END = 1562 * MiB;
static_assert(WS_PROJ + (size_t)M * NP * 2 == WS_END, "ws map");
constexpr int CW_BAR = 4096;

constexpr int RING_OFF = 0, RING_BYTES = 157952;
constexpr int LDSCTL_OFF = RING_BYTES, MISC_OFF = LDSCTL_OFF + 320;
constexpr int LDS_BYTES = 159744;

#define GAS __attribute__((address_space(1)))
#define LAS __attribute__((address_space(3)))
typedef unsigned short bf16;
typedef unsigned v4u __attribute__((ext_vector_type(4)));
typedef unsigned v2u __attribute__((ext_vector_type(2)));
typedef float f32x4 __attribute__((ext_vector_type(4)));
typedef GAS unsigned gu32;
#define LDS_WAIT() asm volatile("s_waitcnt lgkmcnt(0)" ::: "memory")
#define VM_WAIT() asm volatile("s_waitcnt vmcnt(0)" ::: "memory")
__device__ __forceinline__ unsigned f2bf(float f) { unsigned u = __builtin_bit_cast(unsigned, f); return (u + 0x7fffu + ((u >> 16) & 1u)) >> 16; }
__device__ __forceinline__ unsigned pk2(float lo, float hi) { return f2bf(lo) | (f2bf(hi) << 16); }
__device__ __forceinline__ float bflo(unsigned u) { return __uint_as_float(u << 16); }
__device__ __forceinline__ float bfhi(unsigned u) { return __uint_as_float(u & 0xffff0000u); }
__device__ __forceinline__ float bf2f(bf16 h) { return __uint_as_float((unsigned)h << 16); }
#define SWZ_XOR(v, o) __uint_as_float((unsigned)__builtin_amdgcn_ds_swizzle((int)__float_as_uint(v), ((o) << 10) | 0x1f))
__device__ __forceinline__ float xhalf(float v, bool is_max) { auto rr = __builtin_amdgcn_permlane32_swap(__float_as_uint(v), __float_as_uint(v), false, false);
    const float a = __uint_as_float(rr[0]), b = __uint_as_float(rr[1]); return is_max ? fmaxf(a, b) : a + b; }
__device__ __forceinline__ float wave_sum(float v) {
    v += SWZ_XOR(v, 1); v += SWZ_XOR(v, 2); v += SWZ_XOR(v, 4); v += SWZ_XOR(v, 8); v += SWZ_XOR(v, 16);
    return xhalf(v, false);
}
__device__ __forceinline__ float shfl_up_l(float v, int o, int lane) { return __uint_as_float((unsigned)__builtin_amdgcn_ds_bpermute(((lane - o) & 63) << 2, (int)__float_as_uint(v))); }
__device__ __forceinline__ float sigmoidf_(float x) { return 1.0f / (1.0f + __expf(-x)); }

#define XB_TMO      128
#define XB_XCNT(j)  (256  + 64 * (j))
#define XB_XSUB(j)  (1280 + 64 * (j))
#define XB_XGEN(j)  (2304 + 64 * (j))
#define XB_TOP      3328
#define XB_TOPGEN   3392
#define XCD_BAR_WORDS 3456
#define XB_SPIN_CAP (1u << 18)
__device__ __forceinline__ unsigned xb_ld(unsigned* p)              { return __hip_atomic_load(p, __ATOMIC_RELAXED, __HIP_MEMORY_SCOPE_AGENT); }
__device__ __forceinline__ unsigned xb_add(unsigned* p, unsigned v) { return __hip_atomic_fetch_add(p, v, __ATOMIC_RELAXED, __HIP_MEMORY_SCOPE_AGENT); }
__device__ __forceinline__ unsigned xb_xcc_id() { return (unsigned)__builtin_amdgcn_s_getreg((3 << 11) | 20) & 0xFu; }
#define XB_SPIN(cond, bar) do { unsigned _sp = 0; while (cond) { __builtin_amdgcn_s_sleep(1); \
    if ((++_sp & 255u) == 0u) { if (xb_ld(&(bar)[XB_TMO])) break; if (_sp > XB_SPIN_CAP) { atomicAdd(&(bar)[XB_TMO], 1u); break; } } } } while (0)
struct XcdBarrier { unsigned* bar; unsigned x; volatile LAS unsigned* st; };
__device__ __forceinline__ XcdBarrier xcd_barrier_post(unsigned* bar, volatile LAS unsigned* st) {
    XcdBarrier b; b.bar = bar; b.x = xb_xcc_id(); b.st = st;
    if (threadIdx.x == 0) (void)xb_add(&bar[XB_XCNT(b.x)], 1u);
    return b;
}
__device__ __forceinline__ void xcd_barrier_complete(unsigned* bar, unsigned x, unsigned& nloc, unsigned& nx) {
    const unsigned G = gridDim.x * gridDim.y * gridDim.z;
    unsigned sum, cnt, mine, sp = 0u;
    for (;;) {
        sum = 0u; cnt = 0u; mine = 0u;
#pragma unroll
        for (unsigned j = 0; j < 16; ++j) { const unsigned c = xb_ld(&bar[XB_XCNT(j)]); sum += c; cnt += (c > 0u) ? 1u : 0u; mine = (j == x) ? c : mine; }
        if (sum == G) break;
        __builtin_amdgcn_s_sleep(1);
        if ((++sp & 255u) == 0u) { if (xb_ld(&bar[XB_TMO])) break; if (sp > XB_SPIN_CAP) { atomicAdd(&bar[XB_TMO], 1u); break; } }
    }
    nloc = mine > 0u ? mine : 1u; nx = cnt > 0u ? cnt : 1u;
}
__device__ __forceinline__ void xcd_barrier(const XcdBarrier& b) {
    asm volatile("s_waitcnt vmcnt(0)" ::: "memory");
    __syncthreads();
    if (threadIdx.x == 0) {
        unsigned* bar = b.bar;
        __builtin_amdgcn_s_waitcnt(0);
        unsigned nloc = b.st[0], nx = b.st[1];
        if (nloc == 0u) { xcd_barrier_complete(bar, b.x, nloc, nx); b.st[0] = nloc; b.st[1] = nx; }
        const unsigned old = xb_add(&bar[XB_XSUB(b.x)], 1u);
        const unsigned gen = old / nloc;
        if (old + 1u == (gen + 1u) * nloc) {
            __builtin_amdgcn_fence(__ATOMIC_RELEASE, "agent");
            asm volatile("s_waitcnt vmcnt(0)" ::: "memory");
            const unsigned og = xb_add(&bar[XB_TOP], 1u);
            const unsigned tg = og / nx;
            if (og + 1u == (tg + 1u) * nx) xb_add(&bar[XB_TOPGEN], 1u);
            else XB_SPIN(xb_ld(&bar[XB_TOPGEN]) == tg, bar);
            __builtin_amdgcn_fence(__ATOMIC_ACQUIRE, "agent");
            xb_add(&bar[XB_XGEN(b.x)], 1u);
            asm volatile("s_waitcnt vmcnt(0)" ::: "memory");
        } else {
            XB_SPIN(xb_ld(&bar[XB_XGEN(b.x)]) == gen, bar);
            __builtin_amdgcn_fence(__ATOMIC_ACQUIRE, "agent");
            asm volatile("s_waitcnt vmcnt(0)" ::: "memory");
        }
    }
    __syncthreads();
}

__device__ const double ROPE_INV[16] = {1.0, 0.44036660267178046, 0.19392274474868576, 0.08539710028576561, 0.03760603093086393, 0.016560440080994446, 0.007292664737217109, 0.003211445994752591,
    0.001414213562373095, 0.000622772421914596, 0.0002742481756762073, 0.00012076973741146504, 5.318295896944988e-05, 2.341999896140934e-05, 1.031338537721246e-05, 4.5416704806078695e-06};

__device__ __forceinline__ void rope_table_phase(const int* pos, float* rope, int gtid, int gthreads) {
    for (int idx = gtid; idx < M * 16; idx += gthreads) {
        const int row = idx >> 4, i = idx & 15;
        const float angf = (float)pos[row] * (float)ROPE_INV[i];
        const double rev = (double)angf * 0.15915494309189535;
        const float fr = (float)(rev - __builtin_rint(rev));
        rope[(size_t)row * 32 + i] = __builtin_amdgcn_cosf(fr);
        rope[(size_t)row * 32 + 16 + i] = __builtin_amdgcn_sinf(fr);
    }
}

struct TrItem { const float* src; bf16* dst; int ldw, ldk; bool rp; };
__device__ __forceinline__ void tr_load(const TrItem& t, f32x4 (&v)[16]) {
#pragma unroll
    for (int i = 0; i < 16; ++i) v[i] = __builtin_nontemporal_load((const GAS f32x4*)(t.src + (size_t)(4 * i) * t.ldw));
}
__device__ __forceinline__ void tr_finish(const TrItem& t, const f32x4 (&v)[16], LAS float* scr, int lane) {
    const int c = lane & 15, rr = lane >> 4;
#pragma unroll
    for (int i = 0; i < 16; ++i) { LAS float* d = scr + (4 * c) * 65 + 4 * i + rr; d[0] = v[i].x; d[65] = v[i].y; d[130] = v[i].z; d[195] = v[i].w; }
    LDS_WAIT(); asm volatile("" ::: "memory");
    const int c8 = lane & 7;
#pragma unroll
    for (int j = 0; j < 8; ++j) { const int n = 8 * j + (lane >> 3); const int ns = (t.rp && n < 32) ? ((n >> 1) + 16 * (n & 1)) : n; const LAS float* s = scr + ns * 65 + 8 * c8;
        v4u o; o.x = pk2(s[0], s[1]); o.y = pk2(s[2], s[3]); o.z = pk2(s[4], s[5]); o.w = pk2(s[6], s[7]);
        *(GAS v4u*)(t.dst + (size_t)n * t.ldk + 8 * c8) = o; }
    LDS_WAIT(); asm volatile("" ::: "memory");
}

__device__ __forceinline__ void convert_weights_phase(int l, const float* w_in, const float* p_m, const float* p_a, const float* w_out, const float* w_gate, const float* w_up, const float* w_down,
                                                      unsigned char* ws, LAS float* scr, int gw, int ngw, int lane) {
    constexpr int I1 = (DM / 64) * (NP / 64), I2 = (1024 / 64) * (DM / 64), I3 = (DM / 64) * (DM / 64), I4 = I3, I5 = (DM / 64) * (NGU / 64), I6 = (DFF / 64) * (DM / 64);
    constexpr int NIT = I1 + I2 + I3 + I4 + I5 + I6;
#define TR_DECODE(it_, T) do { int r = (it_); const float* W; int ldw, K, nblk, koff = 0; size_t wsoff; int mode;     \
        if (r < I1) { W = w_in + (size_t)l * DM * DIN; ldw = DIN; K = DM; nblk = NP / 64; wsoff = WS_WIN; mode = 1; }                                                          \
        else if ((r -= I1) < I2) { W = p_m + (size_t)l * 1024 * DM; ldw = DM; K = KMRG; nblk = DM / 64; wsoff = WS_PM; mode = 0; }                   \
        else if ((r -= I2) < I3) { W = p_a + (size_t)l * DM * DM; ldw = DM; K = KMRG; koff = 1024; nblk = DM / 64; wsoff = WS_PM; mode = 0; }        \
        else if ((r -= I3) < I4) { W = w_out + (size_t)l * DM * DM; ldw = DM; K = DM; nblk = DM / 64; wsoff = WS_WO; mode = 0; }                                                \
        else if ((r -= I4) < I5) { W = nullptr; ldw = DFF; K = DM; nblk = NGU / 64; wsoff = WS_WGU; mode = 2; }                                                                 \
        else { r -= I5; W = w_down + (size_t)l * DFF * DM; ldw = DM; K = DFF; nblk = DM / 64; wsoff = WS_WD; mode = 0; }                                                        \
        const int kb = r / nblk, nb = r % nblk, n0d = nb * 64; int n0s = n0d; bool rp = false;                                                                                  \
        if (mode == 1) { n0s = n0d < 3072 ? n0d : n0d + 8; rp = (n0d >= C_AQ && n0d < C_AV && (n0d & 127) == 0); }                                                              \
        if (mode == 2) { const int pn = n0d >> 8, r0 = n0d & 255; W = (r0 < 128 ? w_gate : w_up) + (size_t)l * DM * DFF; n0s = pn * 128 + (r0 & 127); }                        \
        T.src = W + (size_t)(kb * 64 + (lane >> 4)) * ldw + n0s + 4 * (lane & 15); T.ldw = ldw; T.ldk = K; T.rp = rp;                                                          \
        T.dst = (bf16*)(ws + wsoff) + (size_t)n0d * K + koff + kb * 64; } while (0)
    TrItem ta, tb; f32x4 va[16], vb[16];
    int it = gw;
    if (it < NIT) { TR_DECODE(it, ta); tr_load(ta, va); }
    while (it < NIT) {
        int itn = it + ngw;
        if (itn < NIT) { TR_DECODE(itn, tb); tr_load(tb, vb); }
        tr_finish(ta, va, scr, lane);
        it = itn; if (it >= NIT) break;
        itn = it + ngw;
        if (itn < NIT) { TR_DECODE(itn, ta); tr_load(ta, va); }
        tr_finish(tb, vb, scr, lane);
        it = itn;
    }
#undef TR_DECODE
}

__device__ __forceinline__ void norm_row(const float* xrow, const float* g, bf16* orow, int lane, f32x4 (&v)[8]) {
    const GAS f32x4* xr = (const GAS f32x4*)xrow + lane; const GAS f32x4* gr = (const GAS f32x4*)g + lane;
    float s = 0.f;
#pragma unroll
    for (int j = 0; j < 8; ++j) { v[j] = __builtin_nontemporal_load(xr + 64 * j); s += (v[j].x * v[j].x + v[j].y * v[j].y) + (v[j].z * v[j].z + v[j].w * v[j].w); }
    const float rstd = 1.0f / sqrtf(wave_sum(s) * (1.f / DM) + EPS);
    GAS unsigned long long* o8 = (GAS unsigned long long*)orow + lane;
#pragma unroll
    for (int j = 0; j < 8; ++j) { const f32x4 gg = gr[64 * j]; v[j] = v[j] * rstd * gg;
        o8[64 * j] = (unsigned long long)pk2(v[j].x, v[j].y) | ((unsigned long long)pk2(v[j].z, v[j].w) << 32); }
}

typedef _Float16 h16;
typedef _Float16 h16x8 __attribute__((ext_vector_type(8)));
template <bool IN16, bool WR16>
__device__ __forceinline__ void norm_row2(const void* xrow0, const void* xrow1, const float* g, bf16* orow0, bf16* orow1, int lane, f32x4 (&v0)[8], f32x4 (&v1)[8], h16* xh0 = nullptr, h16* xh1 = nullptr) {
    const GAS f32x4* gr = (const GAS f32x4*)g + 2 * lane;
    if constexpr (IN16) {
        const GAS h16x8* xr0 = (const GAS h16x8*)xrow0 + lane; const GAS h16x8* xr1 = (const GAS h16x8*)xrow1 + lane;
        h16x8 t0[4], t1[4];
#pragma unroll
        for (int j = 0; j < 4; ++j) { t0[j] = __builtin_nontemporal_load(xr0 + 64 * j); t1[j] = __builtin_nontemporal_load(xr1 + 64 * j); }
#pragma unroll
        for (int j = 0; j < 4; ++j) {
            v0[2 * j] = (f32x4){(float)t0[j][0], (float)t0[j][1], (float)t0[j][2], (float)t0[j][3]}; v0[2 * j + 1] = (f32x4){(float)t0[j][4], (float)t0[j][5], (float)t0[j][6], (float)t0[j][7]};
            v1[2 * j] = (f32x4){(float)t1[j][0], (float)t1[j][1], (float)t1[j][2], (float)t1[j][3]}; v1[2 * j + 1] = (f32x4){(float)t1[j][4], (float)t1[j][5], (float)t1[j][6], (float)t1[j][7]}; }
    } else {
        const GAS f32x4* xr0 = (const GAS f32x4*)xrow0 + 2 * lane; const GAS f32x4* xr1 = (const GAS f32x4*)xrow1 + 2 * lane;
#pragma unroll
        for (int j = 0; j < 4; ++j) { v0[2 * j] = __builtin_nontemporal_load(xr0 + 128 * j); v0[2 * j + 1] = __builtin_nontemporal_load(xr0 + 128 * j + 1);
                                      v1[2 * j] = __builtin_nontemporal_load(xr1 + 128 * j); v1[2 * j + 1] = __builtin_nontemporal_load(xr1 + 128 * j + 1); }
    }
    if constexpr (WR16) {
        GAS h16x8* w0 = (GAS h16x8*)xh0 + lane; GAS h16x8* w1 = (GAS h16x8*)xh1 + lane;
#pragma unroll
        for (int j = 0; j < 4; ++j) {
            w0[64 * j] = (h16x8){(h16)v0[2 * j].x, (h16)v0[2 * j].y, (h16)v0[2 * j].z, (h16)v0[2 * j].w, (h16)v0[2 * j + 1].x, (h16)v0[2 * j + 1].y, (h16)v0[2 * j + 1].z, (h16)v0[2 * j + 1].w};
            w1[64 * j] = (h16x8){(h16)v1[2 * j].x, (h16)v1[2 * j].y, (h16)v1[2 * j].z, (h16)v1[2 * j].w, (h16)v1[2 * j + 1].x, (h16)v1[2 * j + 1].y, (h16)v1[2 * j + 1].z, (h16)v1[2 * j + 1].w}; }
    }
    float s0 = 0.f, s1 = 0.f;
#pragma unroll
    for (int j = 0; j < 8; ++j) { s0 += (v0[j].x * v0[j].x + v0[j].y * v0[j].y) + (v0[j].z * v0[j].z + v0[j].w * v0[j].w); s1 += (v1[j].x * v1[j].x + v1[j].y * v1[j].y) + (v1[j].z * v1[j].z + v1[j].w * v1[j].w); }
    s0 += SWZ_XOR(s0, 1); s1 += SWZ_XOR(s1, 1); s0 += SWZ_XOR(s0, 2); s1 += SWZ_XOR(s1, 2); s0 += SWZ_XOR(s0, 4); s1 += SWZ_XOR(s1, 4);
    s0 += SWZ_XOR(s0, 8); s1 += SWZ_XOR(s1, 8); s0 += SWZ_XOR(s0, 16); s1 += SWZ_XOR(s1, 16); s0 = xhalf(s0, false); s1 = xhalf(s1, false);
    const float r0 = 1.0f / sqrtf(s0 * (1.f / DM) + EPS), r1 = 1.0f / sqrtf(s1 * (1.f / DM) + EPS);
    GAS v4u* o0 = (GAS v4u*)orow0 + lane; GAS v4u* o1 = (GAS v4u*)orow1 + lane;
#pragma unroll
    for (int j = 0; j < 4; ++j) { const f32x4 ga = gr[128 * j], gb = gr[128 * j + 1];
        v0[2 * j] = v0[2 * j] * r0 * ga; v0[2 * j + 1] = v0[2 * j + 1] * r0 * gb; v1[2 * j] = v1[2 * j] * r1 * ga; v1[2 * j + 1] = v1[2 * j + 1] * r1 * gb;
        v4u a, b; a.x = pk2(v0[2 * j].x, v0[2 * j].y); a.y = pk2(v0[2 * j].z, v0[2 * j].w); a.z = pk2(v0[2 * j + 1].x, v0[2 * j + 1].y); a.w = pk2(v0[2 * j + 1].z, v0[2 * j + 1].w);
        b.x = pk2(v1[2 * j].x, v1[2 * j].y); b.y = pk2(v1[2 * j].z, v1[2 * j].w); b.z = pk2(v1[2 * j + 1].x, v1[2 * j + 1].y); b.w = pk2(v1[2 * j + 1].z, v1[2 * j + 1].w);
        o0[64 * j] = a; o1[64 * j] = b; }
}

__device__ __forceinline__ void mlstm_scan(int b, int h, const float* LIF, float* KSC, float* MT, float* EMT, float* REF, LAS float* sm, int tid) {
    const int lane = tid & 63, wave = tid >> 6;
    const float* base = LIF + (size_t)(b * SEQ) * 8;
    float li[8], c[8]; float run = 0.f;
#pragma unroll
    for (int j = 0; j < 8; ++j) { const int s = 8 * tid + j; li[j] = base[(size_t)s * 8 + h]; run += base[(size_t)s * 8 + 4 + h]; c[j] = run; }
    float inc = run;
#pragma unroll
    for (int o = 1; o < 64; o <<= 1) { const float vv = shfl_up_l(inc, o, lane); if (lane >= o) inc += vv; }
    if (lane == 63) sm[wave] = inc;
    __syncthreads();
    float woff = 0.f; for (int w = 0; w < wave; ++w) woff += sm[w];
    const float excl = woff + inc - run;
    float a[8], bs[8]; float lmax = -__builtin_inff();
#pragma unroll
    for (int j = 0; j < 8; ++j) { bs[j] = excl + c[j]; a[j] = li[j] - bs[j]; lmax = fmaxf(lmax, a[j]); }
    float tmax = lmax; tmax = fmaxf(tmax, SWZ_XOR(tmax, 1)); tmax = fmaxf(tmax, SWZ_XOR(tmax, 2)); tmax = fmaxf(tmax, SWZ_XOR(tmax, 4));
    float pm = lmax;
#pragma unroll
    for (int o = 1; o < 64; o <<= 1) { const float vv = shfl_up_l(pm, o, lane); if (lane >= o) pm = fmaxf(pm, vv); }
    if (lane == 63) sm[8 + wave] = pm;
    __syncthreads();
    float wpm = -__builtin_inff(); for (int w = 0; w < wave; ++w) wpm = fmaxf(wpm, sm[8 + w]);
    float prevl = shfl_up_l(pm, 1, lane); if (lane == 0) prevl = -__builtin_inff();
    float rmax = fmaxf(0.f, fmaxf(wpm, prevl));
    const size_t o0 = (size_t)(b * 4 + h) * SEQ + 8 * tid;
#pragma unroll
    for (int j = 0; j < 8; ++j) { rmax = fmaxf(rmax, a[j]); MT[o0 + j] = rmax; EMT[o0 + j] = __expf(-(bs[j] + rmax)); KSC[o0 + j] = __expf(a[j] - tmax); }
    if ((tid & 7) == 0) REF[(b * 4 + h) * 64 + (tid >> 3)] = tmax;
    __syncthreads();
}

__device__ __forceinline__ void mprep_unit(int unit, const bf16* PROJ, const float* cw, const float* cb, const float* KSC, bf16* QKM, int lane) {
    const int strip = unit >> 1, half = unit & 1;
    const int m0 = strip * 16, b = m0 / SEQ, s0 = m0 % SEQ, hh = lane >> 4, ch = half * 512 + 8 * lane;
    v4u xr[19];
#pragma unroll
    for (int i = 0; i < 19; ++i) { const int s = s0 - 3 + i; xr[i] = (v4u){0u, 0u, 0u, 0u};
        if (s >= 0) xr[i] = *(const GAS v4u*)(PROJ + (size_t)(b * SEQ + s) * NP + C_MQK + ch); }
    float ksc[16];
#pragma unroll
    for (int i = 0; i < 16; ++i) ksc[i] = half ? KSC[(size_t)(b * 4 + hh) * SEQ + s0 + i] * 0.08838834764831845f : 1.0f;
    float w[4][8], bias[8];
#pragma unroll
    for (int j = 0; j < 4; ++j) { const f32x4 a = *(const GAS f32x4*)(cw + j * 1024 + ch), c2 = *(const GAS f32x4*)(cw + j * 1024 + ch + 4);
        w[j][0] = a.x; w[j][1] = a.y; w[j][2] = a.z; w[j][3] = a.w; w[j][4] = c2.x; w[j][5] = c2.y; w[j][6] = c2.z; w[j][7] = c2.w; }
    { const f32x4 a = *(const GAS f32x4*)(cb + ch), c2 = *(const GAS f32x4*)(cb + ch + 4);
      bias[0] = a.x; bias[1] = a.y; bias[2] = a.z; bias[3] = a.w; bias[4] = c2.x; bias[5] = c2.y; bias[6] = c2.z; bias[7] = c2.w; }
#define XE(i_, e_) (((e_) & 1) ? bfhi(xr[i_][(e_) >> 1]) : bflo(xr[i_][(e_) >> 1]))
#pragma unroll
    for (int i = 0; i < 16; ++i) {
        float y[8];
#pragma unroll
        for (int e = 0; e < 8; ++e) { float t = bias[e] + w[0][e] * XE(i, e) + w[1][e] * XE(i + 1, e) + w[2][e] * XE(i + 2, e) + w[3][e] * XE(i + 3, e); t = t * sigmoidf_(t); y[e] = t * ksc[i]; }
        v4u o; o.x = pk2(y[0], y[1]); o.y = pk2(y[2], y[3]); o.z = pk2(y[4], y[5]); o.w = pk2(y[6], y[7]);
        *(GAS v4u*)(QKM + (size_t)(m0 + i) * 1024 + ch) = o;
    }
#undef XE
}

__device__ __forceinline__ void finish_row(int row, const float* HT, const float* OST, bf16* PROJ, const float* g_mhead, const float* g_sub, float one_m_laminit, int lane) {
    bf16* prow = PROJ + (size_t)row * NP;
#pragma unroll
    for (int hh = 0; hh < 4; ++hh) {
        const f32x4 v = *(const GAS f32x4*)(HT + (size_t)row * 1024 + hh * 256 + 4 * lane);
        const float ss = wave_sum((v.x * v.x + v.y * v.y) + (v.z * v.z + v.w * v.w));
        const float rstd = 1.0f / sqrtf(ss * (1.f / 256.f) + EPS);
        const f32x4 g = *(const GAS f32x4*)(g_mhead + hh * 256 + 4 * lane);
        const v2u so = *(const GAS v2u*)(prow + C_MO + hh * 256 + 4 * lane);
        const float o0 = bflo(so.x) * (v.x * rstd * g.x), o1 = bfhi(so.x) * (v.y * rstd * g.y), o2 = bflo(so.y) * (v.z * rstd * g.z), o3 = bfhi(so.y) * (v.w * rstd * g.w);
        v2u w; w.x = pk2(o0, o1); w.y = pk2(o2, o3);
        *(GAS v2u*)(prow + C_MO + hh * 256 + 4 * lane) = w;
    }
    const f32x4 gs = *(const GAS f32x4*)(g_sub + 4 * lane);
#pragma unroll
    for (int hh = 0; hh < 8; ++hh) {
        const f32x4 v = *(const GAS f32x4*)(OST + (size_t)row * 2048 + hh * 256 + 4 * lane);
        const float ss = wave_sum((v.x * v.x + v.y * v.y) + (v.z * v.z + v.w * v.w));
        const float rstd = 1.0f / sqrtf(ss * (1.f / 256.f) + EPS) * one_m_laminit;
        v2u w; w.x = pk2(v.x * rstd * gs.x, v.y * rstd * gs.y); w.y = pk2(v.z * rstd * gs.z, v.w * rstd * gs.w);
        *(GAS v2u*)(prow + C_AQ + hh * 256 + 4 * lane) = w;
    }
}
struct Args { const void* in[22]; float* out; unsigned char* ws; int stop_layer; int stop_phase; };

constexpr int PT_OFF = MISC_OFF + 128;
constexpr int PT_OUT = 22, PT_WS = 23;
static_assert(PT_OFF + 24 * 8 <= LDS_BYTES, "LDS map");
__device__ __forceinline__ const void* ldp(LAS unsigned char* ldsA, int k) {
    const volatile LAS unsigned* p = (const volatile LAS unsigned*)(ldsA + PT_OFF) + 2 * k; const unsigned lo = p[0], hi = p[1];
    return (const void*)(((unsigned long long)(unsigned)__builtin_amdgcn_readfirstlane(hi) << 32) | (unsigned)__builtin_amdgcn_readfirstlane(lo));
}
#define LDPF(k) ((const float*)ldp(ldsA, (k)))

__global__ void __launch_bounds__(NWAVES * 64, 2) hybrid_fwd(Args args) {
    extern __shared__ __attribute__((aligned(16))) unsigned char lds[];
    LAS unsigned char* ldsA0 = (LAS unsigned char*)lds;
    const int tid0 = threadIdx.x;
    const int wave0 = __builtin_amdgcn_readfirstlane(tid0 >> 6);
    const int G0 = gridDim.x; const int bx0 = blockIdx.x;
    const int vcu0 = (G0 % 8 == 0) ? (bx0 % 8) * (G0 / 8) + bx0 / 8 : bx0;
#define PHASE_IDS() int tid; asm volatile("v_mbcnt_lo_u32_b32 %0, -1, 0\n\tv_mbcnt_hi_u32_b32 %0, -1, %0" : "=v"(tid)); tid += wave0 * 64; int lz_ = 0; asm volatile("" : "+s"(lz_)); \
    const int lane = tid & 63, wave = __builtin_amdgcn_readfirstlane(tid >> 6), G = G0 + lz_, bx = bx0 + lz_, vcu = vcu0 + lz_, NGW = G * NWAVES, gw = vcu * NWAVES + wave; \
    LAS unsigned char* ldsA = ldsA0 + lz_; char* ldsG = (char*)lds + lz_; (void)lane; (void)gw; (void)bx; (void)NGW; (void)ldsG
    for (int u = tid0; u < (LDS_BYTES - LDSCTL_OFF) / 4; u += NWAVES * 64) ((LAS unsigned*)(ldsA0 + LDSCTL_OFF))[u] = 0u;
    __syncthreads();
    if (tid0 < 24) { const unsigned long long v = (tid0 < 22) ? (unsigned long long)args.in[tid0] : (tid0 == 22 ? (unsigned long long)args.out : (unsigned long long)args.ws);
        ((volatile LAS unsigned long long*)(ldsA0 + PT_OFF))[tid0] = v; }
    __syncthreads();
    { XcdBarrier b0_ = xcd_barrier_post((unsigned*)((unsigned char*)ldp(ldsA0, PT_WS) + WS_CTL) + CW_BAR, (volatile LAS unsigned*)(ldsA0 + MISC_OFF) + 8); (void)b0_; }
#define GRID_BAR() do { int lzb_ = 0; asm volatile("" : "+s"(lzb_)); XcdBarrier b_; b_.bar = (unsigned*)((unsigned char*)ldp(ldsA0 + lzb_, PT_WS) + WS_CTL) + CW_BAR; b_.x = xb_xcc_id(); \
        b_.st = (volatile LAS unsigned*)(ldsA0 + lzb_ + MISC_OFF) + 8; xcd_barrier(b_); } while (0)
    const int stop_layer = args.stop_layer, stop_phase = args.stop_phase;

    { PHASE_IDS(); unsigned char* ws = (unsigned char*)ldp(ldsA, PT_WS); rope_table_phase((const int*)ldp(ldsA, 1), (float*)(ws + WS_ROPE), gw * 64 + lane, NGW * 64); }

#define STAGGER(us8) do { if ((us8) > 0) { const unsigned long long t0_ = __builtin_amdgcn_s_memrealtime(); const unsigned long long dt_ = (unsigned long long)((bx & 7) * (us8) * 100 / 8); \
        while (__builtin_amdgcn_s_memrealtime() - t0_ < dt_) __builtin_amdgcn_s_sleep(16); } } while (0)
#define STOP_AT(ph) do { if (DBG && l == stop_layer && stop_phase == (ph)) return; } while (0)
    for (int l = 0; l < DEPTH; ++l) {
        for (int rep_ = 0; rep_ < REPS(0); ++rep_)
        {
            PHASE_IDS();
            unsigned char* ws = (unsigned char*)ldp(ldsA, PT_WS);
            const float* w_in = LDPF(3);
            convert_weights_phase(l, w_in, LDPF(14), LDPF(15), LDPF(16), LDPF(18), LDPF(19), LDPF(20), ws, (LAS float*)(ldsA + RING_OFF + wave * 16640), gw, NGW, lane);
            __syncthreads();
            LAS float* wgT = (LAS float*)(ldsA + RING_OFF);
            for (int k = tid; k < DM; k += NWAVES * 64) {
                const float* src = w_in + (size_t)l * DM * DIN + (size_t)k * DIN + 3072;
                const f32x4 a = *(const GAS f32x4*)src, b2 = *(const GAS f32x4*)(src + 4);
                const int kp = (k & ~511) + 256 * ((k >> 2) & 1) + 4 * ((k >> 3) & 63) + (k & 3);
                wgT[0 * DM + kp] = a.x; wgT[1 * DM + kp] = a.y; wgT[2 * DM + kp] = a.z; wgT[3 * DM + kp] = a.w;
                wgT[4 * DM + kp] = b2.x; wgT[5 * DM + kp] = b2.y; wgT[6 * DM + kp] = b2.z; wgT[7 * DM + kp] = b2.w;
            }
            __syncthreads();
            const float* x_in = LDPF(0); h16* XH = (h16*)(ws + WS_XH);
            const float* g_mix = LDPF(2) + (size_t)l * DM; const float* i_bias = LDPF(6) + l * 4; const float* f_bias = LDPF(7) + l * 4;
            bf16* HY = (bf16*)(ws + WS_HY); float* LIF = (float*)(ws + WS_LIF);
            for (int m = gw; m < M; m += 2 * NGW) {
                f32x4 v0[8], v1[8]; const int m1 = m + NGW;
                if (l == 0) norm_row2<false, true>(x_in + (size_t)m * DM, x_in + (size_t)m1 * DM, g_mix, HY + (size_t)m * DM, HY + (size_t)m1 * DM, lane, v0, v1, XH + (size_t)m * DM, XH + (size_t)m1 * DM);
                else norm_row2<true, false>(XH + (size_t)m * DM, XH + (size_t)m1 * DM, g_mix, HY + (size_t)m * DM, HY + (size_t)m1 * DM, lane, v0, v1);
                float ga0[8], ga1[8];
#pragma unroll
                for (int c = 0; c < 8; ++c) { float s0 = 0.f, s1 = 0.f;
#pragma unroll
                    for (int j = 0; j < 8; ++j) { const f32x4 wv = *(const LAS f32x4*)(wgT + c * DM + 256 * j + 4 * lane);
                        s0 += (v0[j].x * wv.x + v0[j].y * wv.y) + (v0[j].z * wv.z + v0[j].w * wv.w); s1 += (v1[j].x * wv.x + v1[j].y * wv.y) + (v1[j].z * wv.z + v1[j].w * wv.w); }
                    ga0[c] = wave_sum(s0); ga1[c] = wave_sum(s1); }
                if (lane < 16) {
                    const int c8 = lane & 7; const bool second = lane >= 8;
                    float val = 0.f;
#pragma unroll
                    for (int c = 0; c < 8; ++c) if (c8 == c) val = second ? ga1[c] : ga0[c];
                    if (c8 < 4) val += i_bias[c8];
                    else { const float z = val + f_bias[c8 - 4]; const float e = __expf(-fabsf(z)), u = 1.0f + e, d = u - 1.0f; val = fminf(z, 0.f) - ((d == 0.f) ? e : __logf(u) * (e / d)); }
                    LIF[(size_t)(second ? m1 : m) * 8 + c8] = val;
                }
            }
        }
        GRID_BAR(); STOP_AT(0);
        for (int rep_ = 0; rep_ < REPS(1); ++rep_)
        {
            PHASE_IDS();
            unsigned char* ws = (unsigned char*)ldp(ldsA, PT_WS);
            {
                float* LIF = (float*)(ws + WS_LIF); float* MT = (float*)(ws + WS_MT); float* EMT = (float*)(ws + WS_EMT); float* KSC = (float*)(ws + WS_KSC); float* REF = (float*)(ws + WS_REF);
                for (int id = vcu; id < NB * 4; id += G) mlstm_scan(id >> 2, id & 3, LIF, KSC, MT, EMT, REF, (LAS float*)(ldsA + RING_OFF), tid);
            }
            pg8::Gemm g{(const bf16*)(ws + WS_HY), (const bf16*)(ws + WS_WIN), DM, DM}; pg8::StaticOrder S; S.init(M, NP, G, bx);
            pg8::EpiProj E{(bf16*)(ws + WS_PROJ), NP, (const float*)(ws + WS_ROPE)};
            pg8::gemm_phase<pg8::EpiProj, true>(ldsA + RING_OFF, g, S, E, tid);
        }
        GRID_BAR(); STOP_AT(1);
        for (int rep_ = 0; rep_ < REPS(2); ++rep_)
        {
            PHASE_IDS();
            unsigned char* ws = (unsigned char*)ldp(ldsA, PT_WS);
            const float* cw = LDPF(4) + (size_t)l * 4 * 1024; const float* cb = LDPF(5) + (size_t)l * 1024;
            for (int st = gw; st < M / 8; st += NGW) mprep_unit(st, (const bf16*)(ws + WS_PROJ), cw, cb, (const float*)(ws + WS_KSC), (bf16*)(ws + WS_QKM), lane);
        }
        GRID_BAR(); STOP_AT(2);
        for (int rep_ = 0; rep_ < 1; ++rep_)
        {
            PHASE_IDS();
            unsigned char* ws = (unsigned char*)ldp(ldsA, PT_WS);
            char* albs = ldsG + RING_OFF;
            attw::Seam S;
            bf16* PROJ = (bf16*)(ws + WS_PROJ);
            {
                constexpr int NIT = NB * 4 * 8; int nitems = 0; for (int id = vcu; id < NIT; id += G) ++nitems;
                const int nblk = 2 * nitems;
                bf16* QKM = (bf16*)(ws + WS_QKM);
                const float* MT = (const float*)(ws + WS_MT); const float* EMT = (const float*)(ws + WS_EMT); const float* REF = (const float*)(ws + WS_REF);
                const float* gmh = LDPF(8) + (size_t)l * 1024;
#define MREF(s_, R, L, F) do { const int id_ = ((s_) >> 1) * G + vcu, bh_ = id_ >> 3, p_ = id_ & 7, qb_ = ((s_) & 1) ? p_ : 15 - p_, b_ = bh_ >> 2, hm_ = bh_ & 3; \
                    R.Q = QKM + (size_t)(b_ * SEQ + qb_ * 256) * 1024 + hm_ * 128; R.K = QKM + (size_t)(b_ * SEQ) * 1024 + 512 + hm_ * 128; \
                    R.V = PROJ + (size_t)(b_ * SEQ) * NP + C_MV + hm_ * 256; R.O = nullptr; R.P0 = qb_ * 256; \
                    L.MT = MT + (size_t)bh_ * SEQ; L.EMT = EMT + (size_t)bh_ * SEQ; L.REF = REF + bh_ * 64; \
                    F.g = gmh + hm_ * 256; F.dst = PROJ + (size_t)(b_ * SEQ + qb_ * 256) * NP + C_MO + hm_ * 256; F.scale = 1.0f; } while (0)
                if (nblk > 0) {
                    { att::BlockRef cur; att::LinRef lc; att::FinRef fc; MREF(0, cur, lc, fc); attw::prime<1024, 1024, NP>(cur, albs, S, fc.g, tid); }
                    for (int s = 0; s < nblk; ++s) {
                        { att::BlockRef nxt; att::LinRef ln; att::FinRef fn; const int sn = (s + 1 < nblk) ? s + 1 : s; MREF(sn, nxt, ln, fn); attw::put_next(albs, nxt, tid); }
                        { att::BlockRef cur; att::LinRef lc; att::FinRef fc; MREF(s, cur, lc, fc); int t2 = tid; asm volatile("" : "+v"(t2)); attw::block<1024, 1024, NP, 1024, NP, 2>(cur, albs, S, 0.f, lc, fc, t2); }
                    }
                }
#undef MREF
            }
        }
        {
            PHASE_IDS();
            unsigned char* ws = (unsigned char*)ldp(ldsA, PT_WS);
            char* albs = ldsG + RING_OFF;
            attw::Seam S;
            bf16* PROJ = (bf16*)(ws + WS_PROJ);
            {
                float lam; const float oml = 1.0f - (0.8f - 0.6f * __expf(-0.3f * (float)l));
                { const float* lq1 = LDPF(9) + l * 128; const float* lk1 = LDPF(10) + l * 128; const float* lq2 = LDPF(11) + l * 128; const float* lk2 = LDPF(12) + l * 128;
                  const float a1 = lq1[lane] * lk1[lane] + lq1[64 + lane] * lk1[64 + lane];
                  const float a2 = lq2[lane] * lk2[lane] + lq2[64 + lane] * lk2[64 + lane];
                  lam = __expf(wave_sum(a1)) - __expf(wave_sum(a2)) + (1.0f - oml); }
                constexpr int NIT = NB * 8 * 8; int nitems = 0; for (int id = vcu; id < NIT; id += G) ++nitems;
                const int nblk = 4 * nitems;
                float* OST = (float*)(ws + WS_OST);
                const float* gsub = LDPF(13) + (size_t)l * 256;
                att::LinRef lr0{nullptr, nullptr, nullptr};
#define AREF(s_, R, F) do { const int id_ = ((s_) >> 2) * G + vcu, bh_ = id_ >> 3, p_ = id_ & 7, c_ = (s_) & 1, qb_ = ((s_) & 2) ? p_ : 15 - p_, b_ = bh_ >> 3, h_ = bh_ & 7; \
                    R.Q = PROJ + (size_t)(b_ * SEQ + qb_ * 256) * NP + C_AQ + h_ * 256 + c_ * 128; R.K = PROJ + (size_t)(b_ * SEQ) * NP + C_AK + h_ * 256 + c_ * 128; \
                    R.V = PROJ + (size_t)(b_ * SEQ) * NP + C_AV + h_ * 256; R.O = reinterpret_cast<float*>(reinterpret_cast<unsigned short*>(OST) + (size_t)(b_ * SEQ + qb_ * 256) * 2048 + h_ * 256); R.P0 = qb_ * 256; \
                    F.g = gsub; F.dst = PROJ + (size_t)(b_ * SEQ + qb_ * 256) * NP + C_AQ + h_ * 256; F.scale = oml; } while (0)
                if (nblk > 0) {
                    { att::BlockRef c0; att::FinRef f0; AREF(0, c0, f0); attw::prime<NP, NP, NP>(c0, albs, S, f0.g, tid); }
                    for (int s = 0; s < nblk; s += 2) {
                        { att::BlockRef nx; att::FinRef fx; AREF(s + 1, nx, fx); attw::put_next(albs, nx, tid); }
                        { att::BlockRef c0; att::FinRef f0; AREF(s, c0, f0); int t2 = tid; asm volatile("" : "+v"(t2)); attw::block<NP, NP, NP, 2048, NP, 0>(c0, albs, S, lam, lr0, f0, t2); }
                        { att::BlockRef nx; att::FinRef fx; const int sn = (s + 2 < nblk) ? s + 2 : s + 1; AREF(sn, nx, fx); attw::put_next(albs, nx, tid); }
                        { att::BlockRef c1; att::FinRef f1; AREF(s + 1, c1, f1); int t2 = tid; asm volatile("" : "+v"(t2)); attw::block<NP, NP, NP, 2048, NP, 1>(c1, albs, S, lam, lr0, f1, t2); }
                    }
                }
#undef AREF
            }
        }
        GRID_BAR(); STOP_AT(3);
        for (int rep_ = 0; rep_ < REPS(5); ++rep_)
        {
            PHASE_IDS();
            unsigned char* ws = (unsigned char*)ldp(ldsA, PT_WS);
            bf16* PROJ = (bf16*)(ws + WS_PROJ);
            pg8::StaticOrder S; S.init(M, DM, G, bx);
            pg8::Gemm g{PROJ + C_MO, (const bf16*)(ws + WS_PM), NP, KMRG}; pg8::EpiMerge E{(const unsigned char*)(PROJ + C_GM), NP * 2, (bf16*)(ws + WS_HY), DM};
            pg8::gemm_phase<pg8::EpiMerge, true, 16>(ldsA + RING_OFF, g, S, E, tid);
        }
        GRID_BAR(); STOP_AT(5);
        {
            PHASE_IDS();
            unsigned char* ws = (unsigned char*)ldp(ldsA, PT_WS);
            pg8::StaticOrder S; S.init(M, DM, G, bx);
            pg8::Gemm g{(const bf16*)(ws + WS_HY), (const bf16*)(ws + WS_WO), DM, DM};
            pg8::EpiRes16 E{(pg8::h16_t*)(ws + WS_XH), DM};
            pg8::gemm_phase<pg8::EpiRes16, false>(ldsA + RING_OFF, g, S, E, tid);
        }
        GRID_BAR(); STOP_AT(6);
        for (int rep_ = 0; rep_ < REPS(7); ++rep_)
        {
            PHASE_IDS();
            unsigned char* ws = (unsigned char*)ldp(ldsA, PT_WS);
            const h16* XH = (const h16*)(ws + WS_XH); const float* g_ffn = LDPF(17) + (size_t)l * DM; bf16* HY = (bf16*)(ws + WS_HY);
            for (int m = gw; m < M; m += 2 * NGW) { f32x4 v0[8], v1[8]; const int m1 = m + NGW; norm_row2<true, false>(XH + (size_t)m * DM, XH + (size_t)m1 * DM, g_ffn, HY + (size_t)m * DM, HY + (size_t)m1 * DM, lane, v0, v1); }
        }
        GRID_BAR(); STOP_AT(7);
        for (int rep_ = 0; rep_ < REPS(8); ++rep_)
        {
            PHASE_IDS();
            unsigned char* ws = (unsigned char*)ldp(ldsA, PT_WS);
            pg8::StaticOrder S; S.init(M, NGU, G, bx);
            pg8::Gemm g{(const bf16*)(ws + WS_HY), (const bf16*)(ws + WS_WGU), DM, DM}; pg8::EpiSwiglu E{(bf16*)(ws + WS_PROJ), DFF};
            pg8::gemm_phase<pg8::EpiSwiglu, true>(ldsA + RING_OFF, g, S, E, tid);
        }
        GRID_BAR(); STOP_AT(8);
        {
            PHASE_IDS();
            unsigned char* ws = (unsigned char*)ldp(ldsA, PT_WS);
            pg8::StaticOrder S; S.init(M, DM, G, bx);
            pg8::Gemm g{(const bf16*)(ws + WS_PROJ), (const bf16*)(ws + WS_WD), DFF, DFF};
            pg8::EpiRes16 E{(pg8::h16_t*)(ws + WS_XH), DM};
            pg8::gemm_phase<pg8::EpiRes16, false>(ldsA + RING_OFF, g, S, E, tid);
        }
        GRID_BAR(); STOP_AT(9);
    }
    {
        PHASE_IDS();
        unsigned char* ws = (unsigned char*)ldp(ldsA, PT_WS);
        float* out = (float*)ldp(ldsA, PT_OUT); const float* g_final = LDPF(21); const h16* XH = (const h16*)(ws + WS_XH);
        for (int m = gw; m < M; m += NGW) {
            const GAS h16x8* xr = (const GAS h16x8*)(XH + (size_t)m * DM) + lane; GAS f32x4* orow = (GAS f32x4*)(out + (size_t)m * DM) + 2 * lane; const GAS f32x4* gr = (const GAS f32x4*)g_final + 2 * lane;
            h16x8 t[4]; f32x4 v[8]; float s = 0.f;
#pragma unroll
            for (int j = 0; j < 4; ++j) t[j] = __builtin_nontemporal_load(xr + 64 * j);
#pragma unroll
            for (int j = 0; j < 4; ++j) { v[2 * j] = (f32x4){(float)t[j][0], (float)t[j][1], (float)t[j][2], (float)t[j][3]}; v[2 * j + 1] = (f32x4){(float)t[j][4], (float)t[j][5], (float)t[j][6], (float)t[j][7]}; }
#pragma unroll
            for (int j = 0; j < 8; ++j) s += (v[j].x * v[j].x + v[j].y * v[j].y) + (v[j].z * v[j].z + v[j].w * v[j].w);
            const float rstd = 1.0f / sqrtf(wave_sum(s) * (1.f / DM) + EPS);
#pragma unroll
            for (int j = 0; j < 4; ++j) { orow[128 * j] = v[2 * j] * rstd * gr[128 * j]; orow[128 * j + 1] = v[2 * j + 1] * rstd * gr[128 * j + 1]; }
        }
    }
#undef GRID_BAR
#undef STOP_AT
}
extern "C" void kernel_launch(void* const* d_in, const int* in_sizes, int n_in, void* d_out, int out_size, void* d_ws, size_t ws_size, hipStream_t stream) {
    static int grid = 0;
    if (grid == 0) {
        if (n_in != 22 || in_sizes[0] != M * DM || out_size != M * DM || ws_size < WS_END) {
            fprintf(stderr, "kernel_launch: shape mismatch (n_in %d, in0 %d, out %d, ws %zu < %zu); nothing launched\n", n_in, n_in > 0 ? in_sizes[0] : -1, out_size, ws_size, (size_t)WS_END); grid = -1; return; }
        int dev = 0, cus = 0, per_cu = 0;
        if (hipGetDevice(&dev) != hipSuccess || hipDeviceGetAttribute(&cus, hipDeviceAttributeMultiprocessorCount, dev) != hipSuccess) { grid = -1; return; }
        if (hipFuncSetAttribute((const void*)hybrid_fwd, hipFuncAttributeMaxDynamicSharedMemorySize, LDS_BYTES) != hipSuccess) { fprintf(stderr, "kernel_launch: hipFuncSetAttribute failed\n"); grid = -1; return; }
        if (hipOccupancyMaxActiveBlocksPerMultiprocessor(&per_cu, (const void*)hybrid_fwd, NWAVES * 64, LDS_BYTES) != hipSuccess || per_cu < 1)
            fprintf(stderr, "kernel_launch: note: occupancy query reports %d workgroups per CU\n", per_cu);
        (void)hipGetLastError();
        if (cus < 256) { fprintf(stderr, "kernel_launch: built for a 256-CU device (got %d)\n", cus); grid = -1; return; }
        grid = 256;
    }
    if (grid < 0) return;
    if (hipMemsetAsync((char*)d_ws + WS_CTL, 0, CTL_ZERO_BYTES, stream) != hipSuccess) return;
    Args a{};
    for (int i = 0; i < 22; ++i) a.in[i] = d_in[i];
    a.out = (float*)d_out; a.ws = (unsigned char*)d_ws;
    a.stop_layer = DBG ? DBG_STOP_LAYER : -1; a.stop_phase = DBG ? DBG_STOP_PHASE : -1;
    hipLaunchKernelGGL(hybrid_fwd, dim3(grid), dim3(NWAVES * 64), LDS_BYTES, stream, a);
#if DBG
    dbg_checks(d_in, (float*)d_out, (unsigned char*)d_ws, stream);
#endif
}
static_assert(attw::LDS_TOTAL <= RING_BYTES, "attention LDS"); static_assert((M / (256 * 8)) % 2 == 0, "rows per wave even");
```

```cpp
#include <hip/hip_runtime.h>
#include <cstdio>
#include <cstdint>
#define DBG 0
#define DBG_STOP_LAYER 0
#define DBG_STOP_PHASE 3
#define PROBE_PHASE -1
#define REPS(k) ((PROBE_PHASE == (k)) ? 2 : 1)
namespace pg8 {
#define PG8_LAS __attribute__((address_space(3)))
typedef unsigned short bf16_t;
typedef short bf16x8 __attribute__((ext_vector_type(8)));
typedef float f32x4 __attribute__((ext_vector_type(4)));
typedef unsigned u32x4 __attribute__((ext_vector_type(4)));
constexpr int BM = 256, BK = 64, HALF = 128, HTB = HALF * BK * 2  , STAGE_BYTES = 8 * HTB, NXCD = 8, WGM = 4;

__host__ __device__ __forceinline__ int lds_byte(int r, int c) { const int st = (r >> 4) * 2 + (c >> 5), rr = r & 15, cc = c & 31, ob = rr * 64 + cc * 2; return st * 1024 + (ob ^ (((ob >> 9) & 1) << 5)); }
__host__ __device__ __forceinline__ void stage_rc(int b, int& R, int& C) { const int st = b / 1024, sb = b % 1024, swz = sb ^ (((sb >> 9) & 1) << 5); R = (st >> 1) * 16 + swz / 64; C = (st & 1) * 32 + (swz % 64) / 2; }
__host__ __device__ __forceinline__ int perm32(int rho) { const int n = rho >> 4, i = rho & 15; return 8 * (i >> 2) + 4 * n + (i & 3); }

struct Unit { int pm, pn; };
struct Gemm { const bf16_t* A; const bf16_t* Bt; int lda; int K; };

struct StaticOrder {
    int nM, nN, nwg, G, c;
    __host__ __device__ void init(int M, int N, int G_, int c_) { nM = M / BM; nN = N / BM; nwg = nM * nN; G = G_; c = c_; }
    __host__ __device__ bool next(int i, Unit& u) const {
        const long L = (long)i * G + c; if (L >= nwg) return false;
        int wgid = (int)L; { const int q = nwg / NXCD, r = nwg % NXCD, xcd = wgid % NXCD, off = wgid / NXCD; wgid = (xcd < r ? xcd * (q + 1) : r * (q + 1) + (xcd - r) * q) + off; }
        const int nig = WGM * nN, gid = wgid / nig, fm = gid * WGM, gsz = (nM - fm) < WGM ? (nM - fm) : WGM;
        u.pm = fm + ((wgid % nig) % gsz); u.pn = (wgid % nig) / gsz; return true;
    }
};

__device__ __forceinline__ unsigned cvt_pk_bf16(float lo, float hi) { unsigned r; asm volatile("v_cvt_pk_bf16_f32 %0, %1, %2" : "=v"(r) : "v"(lo), "v"(hi)); return r; }
__device__ __forceinline__ float bf_lo(unsigned u) { return __uint_as_float(u << 16); }
__device__ __forceinline__ float bf_hi(unsigned u) { return __uint_as_float(u & 0xffff0000u); }
__device__ __forceinline__ float sigm(float x) { return __builtin_amdgcn_rcpf(1.0f + __builtin_amdgcn_exp2f(-1.4426950408889634f * x)); }
__device__ __forceinline__ u32x4 pack8f(f32x4 a, f32x4 b) { u32x4 w; w.x = cvt_pk_bf16(a[0], a[1]); w.y = cvt_pk_bf16(a[2], a[3]); w.z = cvt_pk_bf16(b[0], b[1]); w.w = cvt_pk_bf16(b[2], b[3]); return w; }

struct EpiProj {
    static constexpr bool PERM = true;
    bf16_t* O; int ldc; const float* rope;
    __device__ __forceinline__ void operator()(const f32x4 (&acc)[2][2][4][2], const Unit& u, int wr, int wc, int fr, int fq) const {
        const int row0 = u.pm * BM + wr * 64 + fr, col0 = u.pn * BM + wc * 32 + 8 * fq;
        const int pn = u.pn;
        const bool is_sig = (pn >= 8 && pn < 12) || pn >= 36;
        const bool is_rope = (pn >= 12 && pn < 28) && (wc == 0);
#pragma unroll
        for (int ai = 0; ai < 2; ++ai)
#pragma unroll
            for (int m = 0; m < 4; ++m) {
                const int row = row0 + ai * HALF + m * 16;
                bf16_t* rowp = O + (size_t)row * ldc + col0;
                if (pn >= 36) {
                    u32x4 w;
#pragma unroll
                    for (int bj = 0; bj < 2; ++bj) {
                        const f32x4 v0 = acc[ai][bj][m][0], v1 = acc[ai][bj][m][1]; unsigned q0 = 0u, q1 = 0u;
#pragma unroll
                        for (int e = 0; e < 4; ++e) { q0 = __builtin_amdgcn_cvt_pk_u8_f32(fmaxf(__builtin_rintf(sigm(v0[e]) * 255.f), 1.f), e, q0); q1 = __builtin_amdgcn_cvt_pk_u8_f32(fmaxf(__builtin_rintf(sigm(v1[e]) * 255.f), 1.f), e, q1); }
                        w[2 * bj] = q0; w[2 * bj + 1] = q1;
                    }
                    __builtin_nontemporal_store(w, (u32x4*)((unsigned char*)(O + (size_t)row * ldc + 9216) + (pn - 36) * 256 + wc * 64 + fq * 16));
                    continue;
                }
                f32x4 cs = (f32x4){1.f, 1.f, 1.f, 1.f}, sn = (f32x4){0.f, 0.f, 0.f, 0.f};
                if (is_rope) { cs = *(const f32x4*)(rope + (size_t)row * 32 + 4 * fq); sn = *(const f32x4*)(rope + (size_t)row * 32 + 16 + 4 * fq); }
#pragma unroll
                for (int bj = 0; bj < 2; ++bj) {
                    f32x4 v0 = acc[ai][bj][m][0], v1 = acc[ai][bj][m][1];
                    if (is_sig) {
#pragma unroll
                        for (int e = 0; e < 4; ++e) { v0[e] = sigm(v0[e]); v1[e] = sigm(v1[e]); }
                    }
                    if (is_rope) {
                        f32x4 a0, a1;
                        a0[0] = v0[0] * cs[0] - v0[1] * sn[0]; a0[1] = v0[1] * cs[0] + v0[0] * sn[0];
                        a0[2] = v0[2] * cs[1] - v0[3] * sn[1]; a0[3] = v0[3] * cs[1] + v0[2] * sn[1];
                        a1[0] = v1[0] * cs[2] - v1[1] * sn[2]; a1[1] = v1[1] * cs[2] + v1[0] * sn[2];
                        a1[2] = v1[2] * cs[3] - v1[3] * sn[3]; a1[3] = v1[3] * cs[3] + v1[2] * sn[3];
                        v0 = a0; v1 = a1;
                    }
                    __builtin_nontemporal_store(pack8f(v0, v1), (u32x4*)(rowp + bj * HALF));
                }
            }
    }
};
struct EpiMerge {
    static constexpr bool PERM = true;
    const unsigned char* G8; int ldg8; bf16_t* Y; int ldy;
#define UB(w_, k_) ((float)(((w_) >> (8 * (k_))) & 0xffu))
    __device__ __forceinline__ void hook(f32x4 (&acc)[2][2][4][2], const Unit& u, int wr, int wc, int fr, int fq) const {
        int z_ = 0; asm volatile("" : "+v"(z_));
        const int row0 = u.pm * BM + wr * 64 + fr + z_, boff = u.pn * 256 + wc * 64 + fq * 16;
#pragma unroll
        for (int ai = 0; ai < 2; ++ai)
#pragma unroll
            for (int m = 0; m < 4; ++m) {
                const unsigned char* gp = G8 + (size_t)(row0 + ai * HALF + m * 16) * ldg8 + boff;
                const u32x4 a = *(const u32x4*)gp, b = *(const u32x4*)(gp + 2048);
#pragma unroll
                for (int bj = 0; bj < 2; ++bj) {
                    f32x4& v0 = acc[ai][bj][m][0]; f32x4& v1 = acc[ai][bj][m][1];
                    const unsigned a0 = a[2 * bj], a1 = a[2 * bj + 1], b0 = b[2 * bj], b1 = b[2 * bj + 1];
#pragma unroll
                    for (int e = 0; e < 4; ++e) { v0[e] *= UB(a0, e) * __builtin_amdgcn_rcpf(UB(b0, e)); v1[e] *= UB(a1, e) * __builtin_amdgcn_rcpf(UB(b1, e)); }
                }
                if (m == 3) asm volatile("" ::: "memory");
            }
    }
    __device__ __forceinline__ void operator()(const f32x4 (&acc)[2][2][4][2], const Unit& u, int wr, int wc, int fr, int fq) const {
        const int row0 = u.pm * BM + wr * 64 + fr, col0 = u.pn * BM + wc * 32 + 8 * fq, boff = u.pn * 256 + wc * 64 + fq * 16 + 2048;
#pragma unroll
        for (int ai = 0; ai < 2; ++ai)
#pragma unroll
            for (int m = 0; m < 4; ++m) {
                const int row = row0 + ai * HALF + m * 16;
                const u32x4 g = *(const u32x4*)(G8 + (size_t)row * ldg8 + boff);
#pragma unroll
                for (int bj = 0; bj < 2; ++bj) {
                    const int col = col0 + bj * HALF;
                    const f32x4 v0 = acc[ai][bj][m][0], v1 = acc[ai][bj][m][1];
                    const unsigned g0 = g[2 * bj], g1 = g[2 * bj + 1];
                    f32x4 o0, o1;
#pragma unroll
                    for (int e = 0; e < 4; ++e) { o0[e] = UB(g0, e) * (1.0f / 255.0f) * v0[e]; o1[e] = UB(g1, e) * (1.0f / 255.0f) * v1[e]; }
                    *(u32x4*)(Y + (size_t)row * ldy + col) = pack8f(o0, o1);
                }
                if (m == 3) asm volatile("" ::: "memory");
            }
    }
#undef UB
};
typedef _Float16 h16_t;
typedef _Float16 h16x8 __attribute__((ext_vector_type(8)));
struct EpiRes16 {
    static constexpr bool PERM = true;
    h16_t* X; int ldc;
    __device__ __forceinline__ void operator()(const f32x4 (&acc)[2][2][4][2], const Unit& u, int wr, int wc, int fr, int fq) const {
        const int row0 = u.pm * BM + wr * 64 + fr, col0 = u.pn * BM + wc * 32 + 8 * fq;
        h16x8 r[2][4][2];
#pragma unroll
        for (int ai = 0; ai < 2; ++ai)
#pragma unroll
            for (int m = 0; m < 4; ++m)
#pragma unroll
                for (int bj = 0; bj < 2; ++bj) r[ai][m][bj] = __builtin_nontemporal_load((const h16x8*)(X + (size_t)(row0 + ai * HALF + m * 16) * ldc + col0 + bj * HALF));
        asm volatile("" ::: "memory");
#pragma unroll
        for (int ai = 0; ai < 2; ++ai)
#pragma unroll
            for (int m = 0; m < 4; ++m)
#pragma unroll
                for (int bj = 0; bj < 2; ++bj) { h16x8 o; const h16x8 q = r[ai][m][bj];
#pragma unroll
                    for (int e = 0; e < 4; ++e) { o[e] = (h16_t)((float)q[e] + acc[ai][bj][m][0][e]); o[4 + e] = (h16_t)((float)q[4 + e] + acc[ai][bj][m][1][e]); }
                    *(h16x8*)(X + (size_t)(row0 + ai * HALF + m * 16) * ldc + col0 + bj * HALF) = o; }
    }
};
struct EpiSwiglu {
    static constexpr bool PERM = true;
    bf16_t* H; int ldh;
    __device__ __forceinline__ void operator()(const f32x4 (&acc)[2][2][4][2], const Unit& u, int wr, int wc, int fr, int fq) const {
        const int row0 = u.pm * BM + wr * 64 + fr, col0 = u.pn * HALF + wc * 32 + 8 * fq;
#pragma unroll
        for (int ai = 0; ai < 2; ++ai)
#pragma unroll
            for (int m = 0; m < 4; ++m) {
                const int row = row0 + ai * HALF + m * 16;
                f32x4 o0, o1;
#pragma unroll
                for (int e = 0; e < 4; ++e) { const float g0 = acc[ai][0][m][0][e], g1 = acc[ai][0][m][1][e];
                    o0[e] = g0 * sigm(g0) * acc[ai][1][m][0][e]; o1[e] = g1 * sigm(g1) * acc[ai][1][m][1][e]; }
                __builtin_nontemporal_store(pack8f(o0, o1), (u32x4*)(H + (size_t)row * ldh + col0));
            }
    }
};

template <class Epi, bool ALIGN_EPI, int HOOKT = 0>
__device__ __forceinline__ void gemm_phase(PG8_LAS unsigned char* lds, const Gemm g, const StaticOrder& S, const Epi& E, const int tid) {
    const int wid = __builtin_amdgcn_readfirstlane(tid >> 6), lane = tid & 63, wr = wid >> 2, wc = wid & 3, fr = lane & 15, fq = lane >> 4;
    const int K = g.K, nt = K / BK, lda = g.lda;
    unsigned voffA[2], voffB[2];
#pragma unroll
    for (int i = 0; i < 2; ++i) { int R, C; stage_rc(tid * 16 + i * 8192, R, C); const int Rb = Epi::PERM ? ((R & ~31) + perm32(R & 31)) : R;
        voffA[i] = (unsigned)(R * lda + C) * 2u; voffB[i] = (unsigned)(Rb * K + C) * 2u; }
    const size_t kstep = (size_t)(BK * 2);
    const size_t hstepA = (size_t)HALF * lda * 2, hstepB = (size_t)HALF * K * 2;
    const size_t tstepA = 2 * hstepA, tstepB = 2 * hstepB;
    const unsigned ldsw = (unsigned)wid * 1024u;
    const int aoff = lds_byte(wr * 64 + fr, fq * 8), boff = lds_byte(wc * 32 + fr, fq * 8);
#define PG8_SA(b, h) (((b) * 2 + (h)) * HTB)
#define PG8_SB(b, h) ((4 + (b) * 2 + (h)) * HTB)
#define PG8_STAGE(bufoff, gbase, voff) do { _Pragma("unroll") for (int _i = 0; _i < 2; ++_i) \
        __builtin_amdgcn_global_load_lds((const unsigned*)((const char*)(gbase) + (voff)[_i]), (PG8_LAS unsigned*)(lds + (bufoff) + ldsw + _i * 8192), 16, 0, 0); } while (0)
#define PG8_LDA(dst, b, h) do { _Pragma("unroll") for (int m = 0; m < 4; ++m) _Pragma("unroll") for (int k = 0; k < 2; ++k) dst[m][k] = *(const PG8_LAS bf16x8*)(lds + PG8_SA(b, h) + aoff + m * 2048 + k * 1024); } while (0)
#define PG8_LDB(dst, b, h) do { _Pragma("unroll") for (int n = 0; n < 2; ++n) _Pragma("unroll") for (int k = 0; k < 2; ++k) dst[n][k] = *(const PG8_LAS bf16x8*)(lds + PG8_SB(b, h) + boff + n * 2048 + k * 1024); } while (0)
#define PG8_MMA(ai, bj, At, Bt) do { __builtin_amdgcn_s_setprio(1); _Pragma("unroll") for (int m = 0; m < 4; ++m) _Pragma("unroll") for (int n = 0; n < 2; ++n) _Pragma("unroll") for (int k = 0; k < 2; ++k) \
        acc[ai][bj][m][n] = __builtin_amdgcn_mfma_f32_16x16x32_bf16(Bt[n][k], At[m][k], acc[ai][bj][m][n], 0, 0, 0); __builtin_amdgcn_s_setprio(0); } while (0)
#define PG8_WAIT_V(n) asm volatile("s_waitcnt vmcnt(" #n ")" ::: "memory")
#define PG8_WAIT_L(n) asm volatile("s_waitcnt lgkmcnt(" #n ")" ::: "memory")
#define PG8_BAR __builtin_amdgcn_s_barrier()
#define PG8_SCHED __builtin_amdgcn_sched_barrier(0)
    Unit cur, nxt; int ui = 0;
    if (!S.next(0, cur)) return;
    f32x4 acc[2][2][4][2];
#pragma unroll
    for (int a = 0; a < 2; ++a)
#pragma unroll
        for (int b = 0; b < 2; ++b)
#pragma unroll
            for (int m = 0; m < 4; ++m)
#pragma unroll
                for (int n = 0; n < 2; ++n) acc[a][b][m][n] = (f32x4){0.f, 0.f, 0.f, 0.f};
    bf16x8 At[4][2], B0[2][2], B1[2][2];
    const char* cA = (const char*)g.A + (size_t)cur.pm * tstepA; const char* cB = (const char*)g.Bt + (size_t)cur.pn * tstepB;
    PG8_STAGE(PG8_SB(0, 0), cB, voffB); PG8_STAGE(PG8_SB(0, 1), cB + hstepB, voffB); PG8_STAGE(PG8_SA(0, 0), cA, voffA); PG8_STAGE(PG8_SA(0, 1), cA + hstepA, voffA);
    if (wr == 1) PG8_BAR;
    PG8_WAIT_V(2); PG8_BAR;
    PG8_STAGE(PG8_SB(1, 0), cB + kstep, voffB); PG8_STAGE(PG8_SA(1, 0), cA + kstep, voffA); PG8_STAGE(PG8_SB(1, 1), cB + hstepB + kstep, voffB);
    PG8_WAIT_V(6); PG8_BAR;
    for (;;) {
        const bool has_next = S.next(ui + 1, nxt);
        const char* nA = has_next ? (const char*)g.A + (size_t)nxt.pm * tstepA : cA; const char* nB = has_next ? (const char*)g.Bt + (size_t)nxt.pn * tstepB : cB;
        for (int t = 0; t < nt; t += 2) {
            if constexpr (HOOKT > 0) { if (t == HOOKT) { E.hook(acc, cur, wr, wc, fr, fq); PG8_SCHED; } }
            const bool last = (t == nt - 2);
            const char* a1 = cA + (size_t)(t + 1) * kstep;
            const char* a2 = last ? nA : cA + (size_t)(t + 2) * kstep; const char* b2 = last ? nB : cB + (size_t)(t + 2) * kstep;
            const char* a3 = a2 + kstep; const char* b3 = b2 + kstep;
            PG8_LDB(B0, 0, 0); PG8_LDB(B1, 0, 1); PG8_SCHED; PG8_LDA(At, 0, 0); PG8_STAGE(PG8_SA(1, 1), a1 + hstepA, voffA);
            PG8_WAIT_V(8); PG8_WAIT_L(0); PG8_BAR; PG8_MMA(0, 0, At, B0); PG8_MMA(0, 1, At, B1); PG8_BAR; PG8_SCHED;
            PG8_LDA(At, 0, 1); PG8_STAGE(PG8_SB(0, 0), b2, voffB); PG8_STAGE(PG8_SB(0, 1), b2 + hstepB, voffB); PG8_STAGE(PG8_SA(0, 0), a2, voffA);
            PG8_WAIT_V(8); PG8_WAIT_L(0); PG8_BAR; PG8_MMA(1, 0, At, B0); PG8_MMA(1, 1, At, B1); PG8_BAR; PG8_SCHED;
            PG8_LDB(B0, 1, 0); PG8_LDB(B1, 1, 1); PG8_SCHED; PG8_LDA(At, 1, 0); PG8_STAGE(PG8_SA(0, 1), a2 + hstepA, voffA);
            PG8_WAIT_V(8); PG8_WAIT_L(0); PG8_BAR; PG8_MMA(0, 0, At, B0); PG8_MMA(0, 1, At, B1); PG8_BAR; PG8_SCHED;
            PG8_LDA(At, 1, 1); PG8_STAGE(PG8_SB(1, 0), b3, voffB); PG8_STAGE(PG8_SB(1, 1), b3 + hstepB, voffB); PG8_STAGE(PG8_SA(1, 0), a3, voffA);
            PG8_WAIT_V(8); PG8_WAIT_L(0); PG8_BAR; PG8_MMA(1, 0, At, B0); PG8_MMA(1, 1, At, B1); PG8_BAR; PG8_SCHED;
        }
        if constexpr (ALIGN_EPI) { if (wr == 0) PG8_BAR; }
        E(acc, cur, wr, wc, fr, fq);
        if (!has_next) break;
#pragma unroll
        for (int a = 0; a < 2; ++a)
#pragma unroll
            for (int b = 0; b < 2; ++b)
#pragma unroll
                for (int m = 0; m < 4; ++m)
#pragma unroll
                    for (int n = 0; n < 2; ++n) acc[a][b][m][n] = (f32x4){0.f, 0.f, 0.f, 0.f};
        cur = nxt; cA = nA; cB = nB; ++ui;
        if constexpr (ALIGN_EPI) { if (wr == 1) PG8_BAR; }
    }
    PG8_WAIT_V(0);
    if constexpr (!ALIGN_EPI) { if (wr == 0) PG8_BAR; }
    PG8_BAR;
#undef PG8_SA
#undef PG8_SB
#undef PG8_STAGE
#undef PG8_LDA
#undef PG8_LDB
#undef PG8_MMA
#undef PG8_WAIT_V
#undef PG8_WAIT_L
#undef PG8_BAR
#undef PG8_SCHED
}
}
namespace att {
typedef unsigned short bf16;
typedef short bf16x8 __attribute__((ext_vector_type(8)));
typedef short s16x4 __attribute__((ext_vector_type(4)));
typedef float f32x16 __attribute__((ext_vector_type(16)));
typedef float f32x4 __attribute__((ext_vector_type(4)));
typedef unsigned u32x4 __attribute__((ext_vector_type(4)));
constexpr int D = 128;
constexpr float SCALE = 0.08838834764831845f;
constexpr float THR = 8.f;
constexpr int NW = 8, QBLK = 32, KVBLK = 64, QB = NW * QBLK;
constexpr int SHM_V = KVBLK * D * 2, SHM_K = KVBLK * D * 2;
constexpr int LDS_BYTES = 2 * SHM_V + 2 * SHM_K + NW * 64 * 4;
constexpr int LDS_QIMG = LDS_BYTES + 32, LDS_SSQ = LDS_QIMG + NW * 8192, LDS_TOTAL = LDS_SSQ + NW * 32 * 4;

#define KSWZ(row, colB) ((row) * 256 + ((colB) ^ (((row) & 7) << 4)))
#define SBAR() __builtin_amdgcn_sched_barrier(0)
__device__ __forceinline__ int v_st(int k, int c) { const int kk = (k & ~0xC) | ((k & 4) << 1) | ((k & 8) >> 1); return ((kk >> 3) * 4 + (c >> 5)) * 512 + ((kk & 7) * 32 + (c & 31)) * 2; }
__device__ __forceinline__ int v_rd_base(int lane) { return ((lane & 3) << 3) | (((lane >> 2) & 3) << 6) | (((lane >> 4) & 1) << 5) | (((lane >> 5) & 1) << 8); }
constexpr int v_rd_off(int d0, int ks, int half) { return d0 * 512 + ks * 4096 + half * 2048; }
__device__ __forceinline__ int crow(int r, int hi) { return (r & 3) + 8 * (r >> 2) + 4 * hi; }
__device__ __forceinline__ unsigned cvtpk(float lo, float hi) { unsigned r; asm volatile("v_cvt_pk_bf16_f32 %0, %1, %2" : "=v"(r) : "v"(lo), "v"(hi)); return r; }
__device__ __forceinline__ bf16x8 load8(const bf16* p) { return *reinterpret_cast<const bf16x8*>(p); }
template <bool ZERO>
__device__ __forceinline__ void mask_tile(f32x16& p0, f32x16& p1, int dq) {
    const float NEG = ZERO ? 0.f : -__builtin_inff();
#pragma unroll
    for (int r = 0; r < 16; ++r) {
        const int c = (r & 3) + 8 * (r >> 2);
        if (dq - c < 0) p0[r] = NEG;
        if (dq - c - 32 < 0) p1[r] = NEG;
    }
}
__device__ __forceinline__ void partialSM(f32x16& p0, f32x16& p1, float& m_reg, float& mn, float& alpha) {
    float pmax = p0[0]; for (int r = 1; r < 16; ++r) pmax = fmaxf(pmax, p0[r]); for (int r = 0; r < 16; ++r) pmax = fmaxf(pmax, p1[r]);
    { auto rr = __builtin_amdgcn_permlane32_swap(__float_as_uint(pmax), __float_as_uint(pmax), false, false);
      pmax = fmaxf(__uint_as_float(rr[0]), __uint_as_float(rr[1])); }
    constexpr float C2 = 1.4426950408889634f * SCALE;
    if (__builtin_expect(__all((pmax - m_reg) * SCALE <= THR), 1)) { mn = m_reg; alpha = 1.f; }
    else { mn = fmaxf(m_reg, pmax); alpha = __builtin_amdgcn_exp2f((m_reg - mn) * C2); m_reg = mn; }
    const float mnL = -mn * C2;
    for (int r = 0; r < 16; ++r) p0[r] = fmaf(p0[r], C2, mnL); for (int r = 0; r < 16; ++r) p1[r] = fmaf(p1[r], C2, mnL);
    for (int r = 0; r < 16; ++r) p0[r] = __builtin_amdgcn_exp2f(p0[r]);
}
#define ATT_PK4(P, B_, OUT) do { unsigned a0 = cvtpk(P[B_+0], P[B_+1]), a1 = cvtpk(P[B_+2], P[B_+3]);                          \
        unsigned b0 = cvtpk(P[B_+4], P[B_+5]), b1 = cvtpk(P[B_+6], P[B_+7]);                                             \
        auto r0 = __builtin_amdgcn_permlane32_swap(a0, b0, false, false); auto r1 = __builtin_amdgcn_permlane32_swap(a1, b1, false, false); \
        u32x4 w = {r0[0], r1[0], r0[1], r1[1]}; OUT = *reinterpret_cast<bf16x8*>(&w); } while (0)
__device__ __forceinline__ void finishSM(f32x16& p0, f32x16& p1, float alpha, float& l_reg, bf16x8& pa0, bf16x8& pa1, bf16x8& pa2, bf16x8& pa3) {
    for (int r = 0; r < 16; ++r) p1[r] = __builtin_amdgcn_exp2f(p1[r]);
    float ps = 0; for (int r = 0; r < 16; ++r) ps += p0[r]; for (int r = 0; r < 16; ++r) ps += p1[r];
    { auto rr = __builtin_amdgcn_permlane32_swap(__float_as_uint(ps), __float_as_uint(ps), false, false);
      ps = __uint_as_float(rr[0]) + __uint_as_float(rr[1]); }
    l_reg = l_reg * alpha + ps;
    ATT_PK4(p0, 0, pa0); ATT_PK4(p0, 8, pa1); ATT_PK4(p1, 0, pa2); ATT_PK4(p1, 8, pa3);
}
__device__ __forceinline__ void partialLin(f32x16& p0, f32x16& p1, float f) {
    for (int r = 0; r < 16; ++r) { p0[r] *= f; p1[r] *= f; }
}
__device__ __forceinline__ void finishLin(f32x16& p0, f32x16& p1, float& den, bf16x8& pa0, bf16x8& pa1, bf16x8& pa2, bf16x8& pa3) {
    float ps = 0; for (int r = 0; r < 16; ++r) ps += p0[r]; for (int r = 0; r < 16; ++r) ps += p1[r];
    den += ps;
    ATT_PK4(p0, 0, pa0); ATT_PK4(p0, 8, pa1); ATT_PK4(p1, 0, pa2); ATT_PK4(p1, 8, pa3);
}
template <int KB, bool QL>
__device__ __forceinline__ void qkt(f32x16& p0, f32x16& p1, const char* K_lds, int r32, int hi, const bf16x8* qr, const char* qlds) {
    p0 = f32x16{}; p1 = f32x16{};
    const char* kb[4];
#pragma unroll
    for (int dd = 0; dd < 4; ++dd) kb[dd] = K_lds + KB * SHM_K + KSWZ(r32, (dd * 16 + hi * 8) * 2);
#pragma unroll
    for (int d0 = 0; d0 < 8; ++d0) { const char* a = kb[d0 & 3] + (d0 >> 2) * 128;
        bf16x8 b0 = *reinterpret_cast<const bf16x8*>(a);
        bf16x8 b1 = *reinterpret_cast<const bf16x8*>(a + 32 * 256);
        bf16x8 qf; if constexpr (QL) qf = *reinterpret_cast<const bf16x8*>(qlds + d0 * 1024); else qf = qr[d0];
        p0 = __builtin_amdgcn_mfma_f32_32x32x16_bf16(b0, qf, p0, 0, 0, 0);
        p1 = __builtin_amdgcn_mfma_f32_32x32x16_bf16(b1, qf, p1, 0, 0, 0); }
}
template <int VB>
__device__ __forceinline__ void pv_tile(f32x16* o, int vb0, bf16x8 pa0, bf16x8 pa1, bf16x8 pa2, bf16x8 pa3) {
#define TRRD(dst, off) asm volatile("ds_read_b64_tr_b16 %0, %1 offset:%2" : "=&v"(dst) : "v"(vb0), "i"(off) : "memory")
#define PV_D0(d0) do { s16x4 l0, l1, l2, l3, h0, h1, h2, h3; constexpr int b_ = VB * SHM_V + v_rd_off(d0, 0, 0); \
        TRRD(l0, b_); TRRD(h0, b_ + 2048); TRRD(l1, b_ + 4096); TRRD(h1, b_ + 6144); TRRD(l2, b_ + 8192); TRRD(h2, b_ + 10240); TRRD(l3, b_ + 12288); TRRD(h3, b_ + 14336); \
        asm volatile("s_waitcnt lgkmcnt(0)" ::: "memory"); SBAR();   \
        o[d0] = __builtin_amdgcn_mfma_f32_32x32x16_bf16(pa0, (bf16x8){l0[0], l0[1], l0[2], l0[3], h0[0], h0[1], h0[2], h0[3]}, o[d0], 0, 0, 0);   \
        o[d0] = __builtin_amdgcn_mfma_f32_32x32x16_bf16(pa1, (bf16x8){l1[0], l1[1], l1[2], l1[3], h1[0], h1[1], h1[2], h1[3]}, o[d0], 0, 0, 0);   \
        o[d0] = __builtin_amdgcn_mfma_f32_32x32x16_bf16(pa2, (bf16x8){l2[0], l2[1], l2[2], l2[3], h2[0], h2[1], h2[2], h2[3]}, o[d0], 0, 0, 0);   \
        o[d0] = __builtin_amdgcn_mfma_f32_32x32x16_bf16(pa3, (bf16x8){l3[0], l3[1], l3[2], l3[3], h3[0], h3[1], h3[2], h3[3]}, o[d0], 0, 0, 0); } while (0)
    PV_D0(0); PV_D0(1); PV_D0(2); PV_D0(3);
#undef PV_D0
#undef TRRD
}

struct BlockRef { const bf16* Q; const bf16* K; const bf16* V; float* O; int P0; };
struct LinRef { const float* MT; const float* EMT; const float* REF; };
struct Seam { bf16x8 qr[8]; bf16x8 st_v0, st_v1, st_k0, st_k1; };
struct FinRef { const float* g; bf16* dst; float scale; };

#define ATT_VMW() asm volatile("s_waitcnt vmcnt(0)" ::: "memory")
#define ATT_VMWN(n) asm volatile("s_waitcnt vmcnt(%0)" :: "i"(n) : "memory")
__device__ __forceinline__ bf16x8 load8o(const bf16* base, unsigned voff) { return *reinterpret_cast<const bf16x8*>(reinterpret_cast<const char*>(base) + voff); }
template <class T> __device__ __forceinline__ T* uni(T* p) {
    const unsigned long long u = (unsigned long long)p; const unsigned lo = __builtin_amdgcn_readfirstlane((unsigned)u), hi = __builtin_amdgcn_readfirstlane((unsigned)(u >> 32));
    return (T*)(((unsigned long long)hi << 32) | lo); }
#define ATT_SLOAD(Kp, Vp, k0) do { const bf16* vb_ = uni((Vp) + (size_t)(k0) * LDV); const bf16* kb_ = uni((Kp) + (size_t)(k0) * LDK);                                         \
                                   S.st_v0 = load8o(vb_, offV); S.st_v1 = load8o(vb_, offV + 32u * LDV * 2u);              \
                                   S.st_k0 = load8o(kb_, offK); S.st_k1 = load8o(kb_, offK + 32u * LDK * 2u); } while (0)
#define ATT_SWRITE_K(bf) do { *(bf16x8*)(K_lds + (bf) * SHM_K + kws) = S.st_k0; *(bf16x8*)(K_lds + (bf) * SHM_K + kws + 32 * 256) = S.st_k1; } while (0)
#define ATT_SWRITE_V(bf) do { *(bf16x8*)(V_lds + (bf) * SHM_V + vst0) = S.st_v0; *(bf16x8*)(V_lds + (bf) * SHM_V + vst1) = S.st_v1; } while (0)

template <int LDQ, int LDK, int LDV>
__device__ __forceinline__ void prime(const BlockRef& cur, char* lds, Seam& S, const int tid) {
    const int wid = __builtin_amdgcn_readfirstlane(tid >> 6), lane = tid & 63, r32 = lane & 31, hi = lane >> 5;
    const int sr = tid >> 4, sc = (tid & 15) * 8, kws = KSWZ(sr, sc * 2); char* K_lds = lds + 2 * SHM_V;
    const unsigned offV = (unsigned)(sr * LDV + sc) * 2u, offK = (unsigned)(sr * LDK + sc) * 2u, offQ = (unsigned)(r32 * LDQ + hi * 8) * 2u;
    { const bf16* qb_ = uni(cur.Q + (size_t)(wid * QBLK) * LDQ);
#pragma unroll
    for (int d0 = 0; d0 < 8; ++d0) S.qr[d0] = load8o(qb_, offQ + d0 * 32u); }
    ATT_SLOAD(cur.K, cur.V, 0); ATT_VMW(); ATT_SWRITE_K(0);
    __syncthreads();
}

__device__ __forceinline__ void put_next(char* lds, const BlockRef& nxt, const int tid) {
    if (tid == 0) { volatile unsigned long long* p = (volatile unsigned long long*)(lds + LDS_BYTES); p[0] = (unsigned long long)nxt.Q; p[1] = (unsigned long long)nxt.K; p[2] = (unsigned long long)nxt.V; }
}
__device__ __forceinline__ const bf16* get_next(char* lds, int k) {
    const volatile unsigned* p = (const volatile unsigned*)(lds + LDS_BYTES) + 2 * k; const unsigned lo = p[0], hi = p[1];
    return (const bf16*)(((unsigned long long)(unsigned)__builtin_amdgcn_readfirstlane(hi) << 32) | (unsigned)__builtin_amdgcn_readfirstlane(lo));
}
template <int LDQ, int LDK, int LDV, int LDO, int LDD, int MODE>
__device__ __forceinline__ void block(const BlockRef& cur, char* lds, Seam& S, float lam, const LinRef& lr, const FinRef& fin, const int tid) {
    constexpr bool LIN = (MODE == 2 || MODE == 4), COMB = (MODE == 1 || MODE == 3), FIRST = (MODE == 1 || MODE == 2), SECOND = (MODE == 3 || MODE == 4);
    const int wid = __builtin_amdgcn_readfirstlane(tid >> 6), lane = tid & 63, r32 = lane & 31, hi = lane >> 5;
    const int NT = cur.P0 / KVBLK + QB / KVBLK;
    const int qlo = cur.P0 + wid * QBLK, qm = qlo + r32 - 4 * hi;
    char* V_lds = lds; char* K_lds = lds + 2 * SHM_V;
    float* ws = (float*)(lds + 2 * SHM_V + 2 * SHM_K) + wid * 64; float* li_l = ws, * al_l = ws + 32;
    float m_reg = -1e30f, l_reg = 0; f32x16 o[4] = {};
    const int sr = tid >> 4, sc = (tid & 15) * 8, vst0 = v_st(sr, sc), vst1 = v_st(32 + sr, sc), kws = KSWZ(sr, sc * 2);
    const int vb0 = (int)(uintptr_t)V_lds + v_rd_base(lane);
    const bf16* Kh = cur.K; const bf16* Vh = cur.V;
    const unsigned offV = (unsigned)(sr * LDV + sc) * 2u, offK = (unsigned)(sr * LDK + sc) * 2u, offQ = (unsigned)(r32 * LDQ + hi * 8) * 2u;
    float Mt = 0.f; if constexpr (LIN) Mt = *reinterpret_cast<const float*>(reinterpret_cast<const char*>(uni(lr.MT + qlo)) + (unsigned)r32 * 4u);
#define ATT_RESC(a) do { if constexpr (!LIN) { if (__any((a) < 1.f)) { if (hi == 0) al_l[r32] = (a); asm volatile("s_waitcnt lgkmcnt(0)" ::: "memory");              \
                     for (int d_ = 0; d_ < 4; ++d_) for (int r = 0; r < 16; ++r) o[d_][r] *= al_l[crow(r, hi)]; } } } while (0)
#define ATT_KBASE(t) ((t) * KVBLK)
#define ATT_MASKT(P0_, P1_, t) do { const int kb_ = ATT_KBASE(t); if (kb_ + KVBLK - 1 > qlo) mask_tile<LIN>(P0_, P1_, qm - kb_); } while (0)
#define ATT_PSM(P0_, P1_, mnX, alX, t) do { if constexpr (LIN) { mnX = __builtin_amdgcn_exp2f((lr.REF[t] - Mt) * 1.4426950408889634f); } \
                                            else partialSM(P0_, P1_, m_reg, mnX, alX); } while (0)
#define ATT_FSM(P0_, P1_, alY, mnY) do { if constexpr (LIN) { partialLin(P0_, P1_, mnY); finishLin(P0_, P1_, l_reg, pa0, pa1, pa2, pa3); } else finishSM(P0_, P1_, alY, l_reg, pa0, pa1, pa2, pa3); } while (0)
#define ATT_SEAM_K0() do { ATT_VMW(); ATT_SWRITE_K(0); SBAR(); } while (0)
    f32x16 pA0, pA1, pB0, pB1; float mnA = 0.f, mnB = 0.f, alA = 1.f, alB = 1.f; bf16x8 pa0, pa1, pa2, pa3;
    ATT_SWRITE_V(0); SBAR();
    const char* qlds = lds + LDS_QIMG + wid * 8192 + lane * 16;
    if constexpr (LIN) {
#pragma unroll
        for (int d0 = 0; d0 < 8; ++d0) *reinterpret_cast<bf16x8*>(const_cast<char*>(qlds) + d0 * 1024) = S.qr[d0];
    }
    if (NT > 1) ATT_SLOAD(Kh, Vh, ATT_KBASE(1));
    SBAR(); qkt<0, LIN>(pA0, pA1, K_lds, r32, hi, S.qr, qlds);
    ATT_MASKT(pA0, pA1, 0); ATT_PSM(pA0, pA1, mnA, alA, 0);
    if (NT > 1) { ATT_VMW(); ATT_SWRITE_V(1); ATT_SWRITE_K(1); }
    __syncthreads();
#define ATT_HALF_STEP(PX0, PX1, mnX, alX, PY0, PY1, alY, mnY, t, KB, VB, SB) do {                                                      \
        SBAR(); qkt<KB, LIN>(PX0, PX1, K_lds, r32, hi, S.qr, qlds);                                             \
        ATT_FSM(PY0, PY1, alY, mnY); SBAR();                                                           \
        if ((t) + 1 < NT) { ATT_SLOAD(Kh, Vh, ATT_KBASE((t) + 1)); SBAR(); }                                               \
        pv_tile<VB>(o, vb0, pa0, pa1, pa2, pa3); ATT_MASKT(PX0, PX1, (t)); ATT_PSM(PX0, PX1, mnX, alX, (t));                                        \
        __syncthreads();                                                                                                      \
        if ((t) + 1 < NT) { ATT_VMW(); ATT_SWRITE_V(SB); ATT_SWRITE_K(SB); }                                                                          \
        ATT_RESC(alX); __syncthreads(); } while (0)
    for (int t = 1; t + 1 < NT; t += 2) {
        ATT_HALF_STEP(pB0, pB1, mnB, alB, pA0, pA1, alA, mnA, t, 1, 0, 0);
        ATT_HALF_STEP(pA0, pA1, mnA, alA, pB0, pB1, alB, mnB, t + 1, 0, 1, 1);
    }
    SBAR(); qkt<1, LIN>(pB0, pB1, K_lds, r32, hi, S.qr, qlds); SBAR();
    { const bf16* nK = get_next(lds, 1); const bf16* nV = get_next(lds, 2); ATT_SLOAD(nK, nV, 0); } SBAR();
    ATT_FSM(pA0, pA1, alA, mnA); SBAR();
    pv_tile<0>(o, vb0, pa0, pa1, pa2, pa3);
    ATT_MASKT(pB0, pB1, NT - 1); ATT_PSM(pB0, pB1, mnB, alB, NT - 1); __syncthreads(); ATT_RESC(alB);
    ATT_FSM(pB0, pB1, alB, mnB); SBAR(); pv_tile<1>(o, vb0, pa0, pa1, pa2, pa3);
    SBAR(); ATT_SEAM_K0();
    { const bf16* qb_ = uni(get_next(lds, 0) + (size_t)(wid * QBLK) * LDQ);
#pragma unroll
    for (int d0 = 0; d0 < 8; ++d0) S.qr[d0] = load8o(qb_, offQ + d0 * 32u); }
    SBAR();
    if constexpr (LIN) { auto rr = __builtin_amdgcn_permlane32_swap(__float_as_uint(l_reg), __float_as_uint(l_reg), false, false); l_reg = __uint_as_float(rr[0]) + __uint_as_float(rr[1]); }
    if (hi == 0) li_l[r32] = l_reg; asm volatile("s_waitcnt lgkmcnt(0)" ::: "memory");
    float rli[16];
    const float* emtp = LIN ? reinterpret_cast<const float*>(reinterpret_cast<const char*>(uni(lr.EMT + (cur.P0 + wid * QBLK))) + (unsigned)hi * 16u) : nullptr;
#pragma unroll
    for (int r = 0; r < 16; ++r) {
        const float lv = li_l[crow(r, hi)];
        if constexpr (LIN) { const float em = emtp[(r & 3) + 8 * (r >> 2)]; rli[r] = __builtin_amdgcn_rcpf(fmaxf(fabsf(lv), em)); }
        else rli[r] = __builtin_amdgcn_rcpf(lv);
    }
    char* Ow = reinterpret_cast<char*>(uni(cur.O + (size_t)(wid * QBLK) * LDO));
    const unsigned offO = (unsigned)(4 * hi * LDO + r32) * 4u;
#define ATT_OOFF(r_, d0_) (offO + (unsigned)(((((r_) & 3) + 8 * ((r_) >> 2)) * LDO + (d0_) * 32) * 4))
#pragma unroll
    for (int r = 0; r < 16; ++r) {
#pragma unroll
        for (int d0 = 0; d0 < 4; ++d0) { float v = o[d0][r] * rli[r];
            if constexpr (COMB) { const float prev = *reinterpret_cast<const float*>(Ow + ATT_OOFF(r, d0)); v = prev - lam * v; }
            o[d0][r] = v; } }
    if constexpr (MODE == 0) {
#pragma unroll
        for (int r = 0; r < 16; ++r)
#pragma unroll
            for (int d0 = 0; d0 < 4; ++d0) *reinterpret_cast<float*>(Ow + ATT_OOFF(r, d0)) = o[d0][r];
    } else {
        float* ssq_l = (float*)(lds + LDS_SSQ) + wid * 32;
        float sq[16];
#pragma unroll
        for (int r = 0; r < 16; ++r) { sq[r] = (o[0][r] * o[0][r] + o[1][r] * o[1][r]) + (o[2][r] * o[2][r] + o[3][r] * o[3][r]); }
#define ATT_SQX(ST) do { _Pragma("unroll") for (int r = 0; r < 16; ++r) sq[r] += __uint_as_float((unsigned)__builtin_amdgcn_ds_swizzle((int)__float_as_uint(sq[r]), ((ST) << 10) | 0x1f)); } while (0)
        ATT_SQX(1); ATT_SQX(2); ATT_SQX(4); ATT_SQX(8); ATT_SQX(16);
#undef ATT_SQX
        if constexpr (FIRST) {
#pragma unroll
            for (int r = 0; r < 16; ++r)
#pragma unroll
                for (int d0 = 0; d0 < 4; ++d0) *reinterpret_cast<float*>(Ow + ATT_OOFF(r, d0)) = o[d0][r];
            if (r32 == 0) {
#pragma unroll
                for (int r = 0; r < 16; ++r) ssq_l[crow(r, hi)] = sq[r];
            }
        } else {
            asm volatile("s_waitcnt lgkmcnt(0)" ::: "memory");
#pragma unroll
            for (int r = 0; r < 16; ++r) sq[r] = __builtin_amdgcn_rsqf((sq[r] + ssq_l[crow(r, hi)]) * (1.0f / 256.0f) + 1e-6f) * fin.scale;
            char* Dw = reinterpret_cast<char*>(uni(fin.dst + (size_t)(wid * QBLK) * LDD));
            const unsigned offD = (unsigned)(4 * hi * LDD + r32) * 2u;
#define ATT_DOFF(r_, c_) (offD + (unsigned)(((((r_) & 3) + 8 * ((r_) >> 2)) * LDD + (c_)) * 2))
            const float* gp = reinterpret_cast<const float*>(reinterpret_cast<const char*>(uni(fin.g)) + (unsigned)r32 * 4u);
#pragma unroll
            for (int d0 = 0; d0 < 4; ++d0) { const float g1 = gp[128 + d0 * 32];
#pragma unroll
                for (int r = 0; r < 16; ++r) { float val = o[d0][r] * sq[r] * g1; bf16* dp = reinterpret_cast<bf16*>(Dw + ATT_DOFF(r, 128 + d0 * 32));
                    if constexpr (LIN) val *= __uint_as_float((unsigned)(*dp) << 16);
                    *dp = (bf16)(cvtpk(val, val) & 0xffffu); } }
            const char* Ow0 = Ow - 128 * 4;
#pragma unroll
            for (int d0 = 0; d0 < 4; ++d0) { const float g0 = gp[d0 * 32];
#pragma unroll
                for (int r = 0; r < 16; ++r) { const float x0 = *reinterpret_cast<const float*>(Ow0 + ATT_OOFF(r, d0));
                    float val = x0 * sq[r] * g0; bf16* dp = reinterpret_cast<bf16*>(Dw + ATT_DOFF(r, d0 * 32));
                    if constexpr (LIN) val *= __uint_as_float((unsigned)(*dp) << 16);
                    *dp = (bf16)(cvtpk(val, val) & 0xffffu); } }
#undef ATT_DOFF
        }
    }
#undef ATT_OOFF
    __syncthreads();
#undef ATT_RESC
#undef ATT_KBASE
#undef ATT_MASKT
#undef ATT_PSM
#undef ATT_FSM
#undef ATT_SEAM_K0
#undef ATT_HALF_STEP
}
#undef ATT_VMW
#undef ATT_VMWN
#undef ATT_SLOAD
#undef ATT_SWRITE_K
#undef ATT_SWRITE_V
#undef ATT_PK4
#undef KSWZ
#undef SBAR
}
namespace attw {
using att::bf16; using att::bf16x8; using att::s16x4; using att::f32x16; using att::f32x4; using att::u32x4;
using att::crow; using att::cvtpk; using att::uni; using att::load8o; using att::mask_tile; using att::partialSM; using att::finishSM; using att::partialLin; using att::finishLin; using att::v_rd_base;
using att::BlockRef; using att::LinRef; using att::FinRef;
constexpr int D = 128, DV = 256, NW = 8, QBLK = 32, KVBLK = 64, QB = NW * QBLK;
constexpr int SHM_K = KVBLK * D * 2, SHM_V = KVBLK * DV * 2;
constexpr int QIMG_W = 7 * 1024;
constexpr int OFF_V = 0, OFF_K = 2 * SHM_V, OFF_WS = OFF_K + 2 * SHM_K, OFF_NX = OFF_WS + NW * 64 * 4, OFF_QIMG = OFF_NX + 32, LDS_TOTAL = OFF_QIMG + NW * QIMG_W;
#define KSWZ(row, colB) ((row) * 256 + ((colB) ^ (((row) & 7) << 4)))
#define SBAR() __builtin_amdgcn_sched_barrier(0)
__device__ __forceinline__ int v_st(int k, int c) { const int kk = (k & ~0xC) | ((k & 4) << 1) | ((k & 8) >> 1); return ((kk >> 3) * 8 + (c >> 5)) * 512 + ((kk & 7) * 32 + (c & 31)) * 2; }
constexpr int v_rd_off(int d0, int ks, int half) { return d0 * 512 + ks * 8192 + half * 4096; }
struct Seam { bf16x8 qr[8]; };

template <int KB>
__device__ __forceinline__ void qkt(f32x16& p0, f32x16& p1, const char* K_lds, int r32, int hi, const char* qlds, const bf16x8 q7) {
    typedef __attribute__((address_space(3))) const char* lp;
    p0 = f32x16{}; p1 = f32x16{};
    const unsigned ka = (unsigned)(uintptr_t)(K_lds + KB * SHM_K);
    unsigned kb[4];
#pragma unroll
    for (int dd = 0; dd < 4; ++dd) kb[dd] = ka + (unsigned)KSWZ(r32, (dd * 16 + hi * 8) * 2);
    const unsigned qa = (unsigned)(uintptr_t)qlds;
#define QK_RD(B0, B1, QF, d0) do { \
        asm volatile("ds_read_b128 %0, %1 offset:%2" : "=&v"(B0) : "v"(kb[(d0) & 3]), "i"(((d0) >> 2) * 128) : "memory"); \
        asm volatile("ds_read_b128 %0, %1 offset:%2" : "=&v"(B1) : "v"(kb[(d0) & 3]), "i"(((d0) >> 2) * 128 + 32 * 256) : "memory"); \
        if ((d0) < 7) asm volatile("ds_read_b128 %0, %1 offset:%2" : "=&v"(QF) : "v"(qa), "i"((d0) * 1024) : "memory"); else QF = q7; } while (0)
#define QK_W(n) asm volatile("s_waitcnt lgkmcnt(" #n ")" ::: "memory")
#define QK_MM(B0, B1, QF) do { p0 = __builtin_amdgcn_mfma_f32_32x32x16_bf16(B0, QF, p0, 0, 0, 0); p1 = __builtin_amdgcn_mfma_f32_32x32x16_bf16(B1, QF, p1, 0, 0, 0); } while (0)
    bf16x8 xa0, xa1, xaq, xb0, xb1, xbq;
    QK_RD(xa0, xa1, xaq, 0);
    QK_RD(xb0, xb1, xbq, 1); QK_W(3); SBAR(); QK_MM(xa0, xa1, xaq); SBAR();
    QK_RD(xa0, xa1, xaq, 2); QK_W(3); SBAR(); QK_MM(xb0, xb1, xbq); SBAR();
    QK_RD(xb0, xb1, xbq, 3); QK_W(3); SBAR(); QK_MM(xa0, xa1, xaq); SBAR();
    QK_RD(xa0, xa1, xaq, 4); QK_W(3); SBAR(); QK_MM(xb0, xb1, xbq); SBAR();
    QK_RD(xb0, xb1, xbq, 5); QK_W(3); SBAR(); QK_MM(xa0, xa1, xaq); SBAR();
    QK_RD(xa0, xa1, xaq, 6); QK_W(3); SBAR(); QK_MM(xb0, xb1, xbq); SBAR();
    QK_RD(xb0, xb1, xbq, 7); QK_W(2); SBAR(); QK_MM(xa0, xa1, xaq); SBAR();
    QK_W(0); SBAR(); QK_MM(xb0, xb1, xbq);
#undef QK_RD
#undef QK_W
#undef QK_MM
}
template <int VB>
__device__ __forceinline__ void pv_tile(f32x16* o, int vb0, bf16x8 pa0, bf16x8 pa1, bf16x8 pa2, bf16x8 pa3) {
#define TRRD(dst, off) asm volatile("ds_read_b64_tr_b16 %0, %1 offset:%2" : "=&v"(dst) : "v"(vb0), "i"(off) : "memory")
#define PV_RD(S_, d0) do { constexpr int b_ = VB * SHM_V + v_rd_off(d0, 0, 0); \
        TRRD(S_##0, b_); TRRD(S_##1, b_ + 4096); TRRD(S_##2, b_ + 8192); TRRD(S_##3, b_ + 12288); TRRD(S_##4, b_ + 16384); TRRD(S_##5, b_ + 20480); TRRD(S_##6, b_ + 24576); TRRD(S_##7, b_ + 28672); } while (0)
#define PV_MM(S_, d0) do { \
        o[d0] = __builtin_amdgcn_mfma_f32_32x32x16_bf16((bf16x8){S_##0[0], S_##0[1], S_##0[2], S_##0[3], S_##1[0], S_##1[1], S_##1[2], S_##1[3]}, pa0, o[d0], 0, 0, 0);   \
        o[d0] = __builtin_amdgcn_mfma_f32_32x32x16_bf16((bf16x8){S_##2[0], S_##2[1], S_##2[2], S_##2[3], S_##3[0], S_##3[1], S_##3[2], S_##3[3]}, pa1, o[d0], 0, 0, 0);   \
        o[d0] = __builtin_amdgcn_mfma_f32_32x32x16_bf16((bf16x8){S_##4[0], S_##4[1], S_##4[2], S_##4[3], S_##5[0], S_##5[1], S_##5[2], S_##5[3]}, pa2, o[d0], 0, 0, 0);   \
        o[d0] = __builtin_amdgcn_mfma_f32_32x32x16_bf16((bf16x8){S_##6[0], S_##6[1], S_##6[2], S_##6[3], S_##7[0], S_##7[1], S_##7[2], S_##7[3]}, pa3, o[d0], 0, 0, 0); } while (0)
#define PV_W8() do { asm volatile("s_waitcnt lgkmcnt(8)" ::: "memory"); SBAR(); } while (0)
#define PV_W0() do { asm volatile("s_waitcnt lgkmcnt(0)" ::: "memory"); SBAR(); } while (0)
    s16x4 fa0, fa1, fa2, fa3, fa4, fa5, fa6, fa7, fb0, fb1, fb2, fb3, fb4, fb5, fb6, fb7;
    PV_RD(fa, 0);
    PV_RD(fb, 1); PV_W8(); PV_MM(fa, 0); SBAR();
    PV_RD(fa, 2); PV_W8(); PV_MM(fb, 1); SBAR();
    PV_RD(fb, 3); PV_W8(); PV_MM(fa, 2); SBAR();
    PV_RD(fa, 4); PV_W8(); PV_MM(fb, 3); SBAR();
    PV_RD(fb, 5); PV_W8(); PV_MM(fa, 4); SBAR();
    PV_RD(fa, 6); PV_W8(); PV_MM(fb, 5); SBAR();
    PV_RD(fb, 7); PV_W8(); PV_MM(fa, 6); SBAR();
    PV_W0(); PV_MM(fb, 7);
#undef PV_RD
#undef PV_MM
#undef PV_W8
#undef PV_W0
#undef TRRD
}

#define ATW_VMW() asm volatile("s_waitcnt vmcnt(0)" ::: "memory")
__device__ __forceinline__ void glds16(const void* gsrc, unsigned lds_dst) { unsigned keep;
    asm volatile("s_mov_b32 %0, m0\n\ts_mov_b32 m0, %2\n\ts_nop 0\n\tglobal_load_lds_dwordx4 %1, off\n\ts_mov_b32 m0, %0" : "=&s"(keep) : "v"(gsrc), "s"(lds_dst) : "memory"); }
#define ATW_DMA_SETUP()                                                                                                                   \
    unsigned offKd[2], offVd[4];                                                                                                          \
    _Pragma("unroll") for (int i_ = 0; i_ < 2; ++i_) { const int row_ = 8 * wid + 4 * i_ + (lane >> 4), c_ = (lane & 15) ^ (row_ & 7); offKd[i_] = (unsigned)(row_ * LDK + c_ * 8) * 2u; } \
    _Pragma("unroll") for (int i_ = 0; i_ < 4; ++i_) { const int st_ = 8 * wid + 2 * i_ + (lane >> 5), kk_ = 8 * (st_ >> 3) + ((lane & 31) >> 2);                                          \
        const int k_ = (kk_ & ~0xC) | ((kk_ & 4) << 1) | ((kk_ & 8) >> 1), col_ = (st_ & 7) * 32 + 8 * (lane & 3); offVd[i_] = (unsigned)(k_ * LDV + col_) * 2u; }                          \
    const unsigned ldsKd = (unsigned)__builtin_amdgcn_readfirstlane((int)((unsigned)(uintptr_t)(lds + OFF_K) + (unsigned)wid * 2048u));                                                     \
    const unsigned ldsVd = (unsigned)__builtin_amdgcn_readfirstlane((int)((unsigned)(uintptr_t)(lds + OFF_V) + (unsigned)wid * 4096u))
#define ATW_DMA_K(Kp, k0, buf) do { const char* kb_ = reinterpret_cast<const char*>(uni((Kp) + (size_t)(k0) * LDK));                        \
        glds16(kb_ + offKd[0], ldsKd + (unsigned)(buf) * SHM_K); glds16(kb_ + offKd[1], ldsKd + (unsigned)(buf) * SHM_K + 1024u); } while (0)
#define ATW_DMA_V(Vp, k0, buf) do { const char* vb_ = reinterpret_cast<const char*>(uni((Vp) + (size_t)(k0) * LDV));                        \
        glds16(vb_ + offVd[0], ldsVd + (unsigned)(buf) * SHM_V); glds16(vb_ + offVd[1], ldsVd + (unsigned)(buf) * SHM_V + 1024u);          \
        glds16(vb_ + offVd[2], ldsVd + (unsigned)(buf) * SHM_V + 2048u); glds16(vb_ + offVd[3], ldsVd + (unsigned)(buf) * SHM_V + 3072u); } while (0)
template <int LDQ, int LDK, int LDV>
__device__ __forceinline__ void prime(const BlockRef& cur, char* lds, Seam& S, const int tid) {
    const int wid = __builtin_amdgcn_readfirstlane(tid >> 6), lane = tid & 63, r32 = lane & 31, hi = lane >> 5;
    const unsigned offQ = (unsigned)(r32 * LDQ + hi * 8) * 2u;
    ATW_DMA_SETUP();
    asm volatile("s_waitcnt vmcnt(0) lgkmcnt(0)\n\ts_barrier" ::: "memory");
    ATW_DMA_K(cur.K, 0, 0); ATW_DMA_V(cur.V, 0, 0);
    { const bf16* qb_ = uni(cur.Q + (size_t)(wid * QBLK) * LDQ);
#pragma unroll
    for (int d0 = 0; d0 < 8; ++d0) S.qr[d0] = load8o(qb_, offQ + d0 * 32u); }
}
__device__ __forceinline__ void put_next(char* lds, const BlockRef& nxt, const int tid) {
    if (tid == 0) { volatile unsigned long long* p = (volatile unsigned long long*)(lds + OFF_NX); p[0] = (unsigned long long)nxt.Q; p[1] = (unsigned long long)nxt.K; p[2] = (unsigned long long)nxt.V; }
}
__device__ __forceinline__ const bf16* get_next(char* lds, int k) {
    const volatile unsigned* p = (const volatile unsigned*)(lds + OFF_NX) + 2 * k; const unsigned lo = p[0], hi = p[1];
    return (const bf16*)(((unsigned long long)(unsigned)__builtin_amdgcn_readfirstlane(hi) << 32) | (unsigned)__builtin_amdgcn_readfirstlane(lo));
}

typedef unsigned short h16s;
typedef _Float16 h16x2 __attribute__((ext_vector_type(2)));
__device__ __forceinline__ unsigned pkh(float a, float b) { const h16x2 v = {(_Float16)a, (_Float16)b}; return __builtin_bit_cast(unsigned, v); }
__device__ __forceinline__ float hlo(unsigned w) { return (float)__builtin_bit_cast(h16x2, w).x; }
__device__ __forceinline__ float hhi(unsigned w) { return (float)__builtin_bit_cast(h16x2, w).y; }
template <int LDQ, int LDK, int LDV, int LDO, int LDD, int MODE>
__device__ __forceinline__ void block(const BlockRef& cur, char* lds, Seam& S, float lam, const LinRef& lr, const FinRef& fin, const int tid) {
    constexpr bool LIN = (MODE == 2);
    const int wid = __builtin_amdgcn_readfirstlane(tid >> 6), lane = tid & 63, r32 = lane & 31, hi = lane >> 5;
    const int NT = cur.P0 / KVBLK + QB / KVBLK;
    const int qlo = cur.P0 + wid * QBLK, qm = qlo + r32 - 4 * hi;
    char* V_lds = lds + OFF_V; char* K_lds = lds + OFF_K;
    float* ws = (float*)(lds + OFF_WS) + wid * 64;
    float m_reg = -1e30f, l_reg = 0; f32x16 o[8] = {};
    const int vb0 = (int)(uintptr_t)V_lds + v_rd_base(lane);
    const bf16* Kh = cur.K; const bf16* Vh = cur.V;
    const unsigned offQ = (unsigned)(r32 * LDQ + hi * 8) * 2u;
    ATW_DMA_SETUP();
    float Mt = 0.f;
    if constexpr (LIN) { Mt = *reinterpret_cast<const float*>(reinterpret_cast<const char*>(uni(lr.MT + qlo)) + (unsigned)r32 * 4u);
        ws[lane] = *reinterpret_cast<const float*>(reinterpret_cast<const char*>(uni(lr.REF)) + (unsigned)lane * 4u); }
    f32x16 p0, p1; float mn = 0.f, al = 1.f; bf16x8 pa0, pa1, pa2, pa3;
#define ATW_RESC(a) do { if constexpr (!LIN) { if (__any((a) < 1.f)) { for (int d_ = 0; d_ < 8; ++d_) for (int r = 0; r < 16; ++r) o[d_][r] *= (a); } } } while (0)
#define ATW_MASKT(t) do { const int kb_ = (t) * KVBLK; if (kb_ + KVBLK - 1 > qlo) mask_tile<LIN>(p0, p1, qm - kb_); } while (0)
#define ATW_SM(t) do { ATW_MASKT(t); if constexpr (LIN) { const float f_ = __builtin_amdgcn_exp2f((ws[t] - Mt) * 1.4426950408889634f); partialLin(p0, p1, f_); finishLin(p0, p1, l_reg, pa0, pa1, pa2, pa3); } \
                       else { partialSM(p0, p1, m_reg, mn, al); finishSM(p0, p1, al, l_reg, pa0, pa1, pa2, pa3); } } while (0)
#define ATW_BAR() asm volatile("s_waitcnt lgkmcnt(0)\n\ts_barrier" ::: "memory")
    const char* qlds = lds + OFF_QIMG + wid * QIMG_W + lane * 16;
    ATW_VMW();
#pragma unroll
    for (int d0 = 0; d0 < 7; ++d0) *reinterpret_cast<bf16x8*>(const_cast<char*>(qlds) + d0 * 1024) = S.qr[d0];
    const bf16x8 q7 = S.qr[7];
    SBAR();
    ATW_DMA_K(Kh, KVBLK, 1);
    SBAR(); ATW_BAR();
#define ATW_ISSUE_K(x) do { if ((x) < NT) { ATW_DMA_K(Kh, (x) * KVBLK, (x) & 1); } else { const bf16* nK = get_next(lds, 1); ATW_DMA_K(nK, 0, 0); } } while (0)
#define ATW_ISSUE_V(x) do { if ((x) < NT) { ATW_DMA_V(Vh, (x) * KVBLK, (x) & 1); } else { const bf16* nV = get_next(lds, 2); ATW_DMA_V(nV, 0, 0); } } while (0)
#define ATW_STEP(t, KB, PVB, HEADSTEP) do {                                                                                            \
        SBAR();                                                                                                                       \
        if (!(HEADSTEP)) { pv_tile<PVB>(o, vb0, pa0, pa1, pa2, pa3); SBAR(); }                                                        \
        qkt<KB>(p0, p1, K_lds, r32, hi, qlds, q7); SBAR();                                                                            \
        ATW_SM(t); SBAR();                                                                                                            \
        ATW_VMW(); ATW_BAR();                                                                                                         \
        if ((t) + 2 <= NT) ATW_ISSUE_K((t) + 2);                                                                                      \
        ATW_ISSUE_V((t) + 1); SBAR();                                                                                                 \
        ATW_RESC(al); } while (0)
    ATW_STEP(0, 0, 0, true);
    for (int t = 1; t + 1 < NT; t += 2) {
        ATW_STEP(t, 1, 0, false);
        ATW_STEP(t + 1, 0, 1, false);
    }
    ATW_STEP(NT - 1, 1, 0, false);
    SBAR(); pv_tile<1>(o, vb0, pa0, pa1, pa2, pa3); SBAR();
    const bf16* nq_ = get_next(lds, 0);
    ATW_BAR();
#undef ATW_ISSUE_K
#undef ATW_ISSUE_V
#undef ATW_BAR
    { const bf16* qb_ = uni(nq_ + (size_t)(wid * QBLK) * LDQ);
#pragma unroll
    for (int d0 = 0; d0 < 8; ++d0) S.qr[d0] = load8o(qb_, offQ + d0 * 32u); }
    SBAR();
    if constexpr (LIN) { auto rr = __builtin_amdgcn_permlane32_swap(__float_as_uint(l_reg), __float_as_uint(l_reg), false, false); l_reg = __uint_as_float(rr[0]) + __uint_as_float(rr[1]); }
    float rl;
    if constexpr (LIN) { const float em = *reinterpret_cast<const float*>(reinterpret_cast<const char*>(uni(lr.EMT + (cur.P0 + wid * QBLK))) + (unsigned)r32 * 4u); rl = __builtin_amdgcn_rcpf(fmaxf(fabsf(l_reg), em)); }
    else rl = __builtin_amdgcn_rcpf(l_reg);
    if constexpr (MODE == 0) {
        char* Ow = reinterpret_cast<char*>(uni(reinterpret_cast<h16s*>(cur.O) + (size_t)(wid * QBLK) * LDO));
        const unsigned offO = (unsigned)(r32 * LDO + 8 * hi) * 2u;
#pragma unroll
        for (int d0 = 0; d0 < 8; ++d0)
#pragma unroll
            for (int g0 = 0; g0 < 4; g0 += 2) {
                const unsigned a0 = pkh(o[d0][4 * g0] * rl, o[d0][4 * g0 + 1] * rl), a1 = pkh(o[d0][4 * g0 + 2] * rl, o[d0][4 * g0 + 3] * rl);
                const unsigned b0 = pkh(o[d0][4 * g0 + 4] * rl, o[d0][4 * g0 + 5] * rl), b1 = pkh(o[d0][4 * g0 + 6] * rl, o[d0][4 * g0 + 7] * rl);
                auto r0 = __builtin_amdgcn_permlane32_swap(a0, b0, false, false); auto r1 = __builtin_amdgcn_permlane32_swap(a1, b1, false, false);
                const u32x4 w = {r0[0], r1[0], r0[1], r1[1]};
                *reinterpret_cast<u32x4*>(Ow + (offO + (unsigned)((d0 * 32 + 8 * g0) * 2))) = w;
            }
    } else {
        if constexpr (MODE == 1) {
            const char* Ow = reinterpret_cast<const char*>(uni(reinterpret_cast<const h16s*>(cur.O) + (size_t)(wid * QBLK) * LDO));
            const unsigned offO = (unsigned)(r32 * LDO + 8 * hi) * 2u;
#pragma unroll
            for (int d0 = 0; d0 < 8; ++d0)
#pragma unroll
                for (int g0 = 0; g0 < 4; g0 += 2) { const u32x4 w = *reinterpret_cast<const u32x4*>(Ow + (offO + (unsigned)((d0 * 32 + 8 * g0) * 2)));
                    auto r0 = __builtin_amdgcn_permlane32_swap(w.x, w.z, false, false); auto r1 = __builtin_amdgcn_permlane32_swap(w.y, w.w, false, false);
                    const float pv[8] = {hlo(r0[0]), hhi(r0[0]), hlo(r1[0]), hhi(r1[0]), hlo(r0[1]), hhi(r0[1]), hlo(r1[1]), hhi(r1[1])};
#pragma unroll
                    for (int e = 0; e < 8; ++e) o[d0][4 * g0 + e] = pv[e] - lam * (o[d0][4 * g0 + e] * rl); }
        } else {
#pragma unroll
            for (int d0 = 0; d0 < 8; ++d0)
#pragma unroll
                for (int r = 0; r < 16; ++r) o[d0][r] *= rl;
        }
        float sq = 0.f;
#pragma unroll
        for (int d0 = 0; d0 < 8; ++d0) { float s4[4];
#pragma unroll
            for (int g = 0; g < 4; ++g) s4[g] = (o[d0][4 * g] * o[d0][4 * g] + o[d0][4 * g + 1] * o[d0][4 * g + 1]) + (o[d0][4 * g + 2] * o[d0][4 * g + 2] + o[d0][4 * g + 3] * o[d0][4 * g + 3]);
            sq += (s4[0] + s4[1]) + (s4[2] + s4[3]); }
        { auto rr = __builtin_amdgcn_permlane32_swap(__float_as_uint(sq), __float_as_uint(sq), false, false); sq = __uint_as_float(rr[0]) + __uint_as_float(rr[1]); }
        const float rs = __builtin_amdgcn_rsqf(sq * (1.0f / 256.0f) + 1e-6f) * fin.scale;
        char* Dw = reinterpret_cast<char*>(uni(fin.dst + (size_t)(wid * QBLK) * LDD));
        const unsigned offD = (unsigned)(r32 * LDD) * 2u;
        const char* gp = reinterpret_cast<const char*>(uni(fin.g)) + (unsigned)hi * 16u;
#pragma unroll
        for (int d0 = 0; d0 < 8; ++d0)
#pragma unroll
            for (int g0 = 0; g0 < 4; g0 += 2) {
                const f32x4 ga = *reinterpret_cast<const f32x4*>(gp + (d0 * 32 + 8 * g0) * 4), gb = *reinterpret_cast<const f32x4*>(gp + (d0 * 32 + 8 * g0 + 8) * 4);
                float va[4], vb[4];
#pragma unroll
                for (int e = 0; e < 4; ++e) { va[e] = o[d0][4 * g0 + e] * rs * ga[e]; vb[e] = o[d0][4 * g0 + 4 + e] * rs * gb[e]; }
                if constexpr (LIN) {
                    const uint2 ta = *reinterpret_cast<const uint2*>(Dw + (offD + (unsigned)((d0 * 32 + 8 * g0 + 4 * hi) * 2))), tb = *reinterpret_cast<const uint2*>(Dw + (offD + (unsigned)((d0 * 32 + 8 * g0 + 8 + 4 * hi) * 2)));
                    va[0] *= __uint_as_float(ta.x << 16); va[1] *= __uint_as_float(ta.x & 0xffff0000u); va[2] *= __uint_as_float(ta.y << 16); va[3] *= __uint_as_float(ta.y & 0xffff0000u);
                    vb[0] *= __uint_as_float(tb.x << 16); vb[1] *= __uint_as_float(tb.x & 0xffff0000u); vb[2] *= __uint_as_float(tb.y << 16); vb[3] *= __uint_as_float(tb.y & 0xffff0000u);
                }
                const unsigned a0 = cvtpk(va[0], va[1]), a1 = cvtpk(va[2], va[3]), b0 = cvtpk(vb[0], vb[1]), b1 = cvtpk(vb[2], vb[3]);
                auto r0 = __builtin_amdgcn_permlane32_swap(a0, b0, false, false); auto r1 = __builtin_amdgcn_permlane32_swap(a1, b1, false, false);
                const u32x4 w = {r0[0], r1[0], r0[1], r1[1]};
                *reinterpret_cast<u32x4*>(Dw + (offD + (unsigned)((d0 * 32 + 8 * (g0 + hi)) * 2))) = w;
            }
    }
#undef ATW_RESC
#undef ATW_MASKT
#undef ATW_SM
#undef ATW_STEP
}
#undef ATW_VMW
#undef ATW_DMA_SETUP
#undef ATW_DMA_K
#undef ATW_DMA_V
#undef KSWZ
#undef SBAR
}
constexpr int NWAVES = 8;
constexpr int DM = 2048, NB = 8, SEQ = 4096, DEPTH = 4, M = NB * SEQ;
constexpr int DIN = 13320, NP = 13312, DFF = 5632, NGU = 2 * DFF;
constexpr int KMRG = 3072;
constexpr int C_MQK = 0, C_MV = 1024, C_MO = 2048, C_AQ = 3072, C_AK = 5120, C_AV = 7168, C_GM = 9216, C_GA = 11264;
constexpr float EPS = 1e-6f;
#ifndef DBG
#define DBG 0
#endif

constexpr size_t MiB = 1u << 20;
constexpr size_t WS_CTL = 0, CTL_ZERO_BYTES = 1 * MiB;
constexpr size_t WS_ROPE = 2 * MiB;
constexpr size_t WS_LIF = 6 * MiB;
constexpr size_t WS_MT = 7 * MiB;
constexpr size_t WS_EMT = WS_MT + 512 * 1024;
constexpr size_t WS_KSC = 8 * MiB;
constexpr size_t WS_REF = WS_KSC + 512 * 1024;
constexpr size_t WS_WIN = 16 * MiB, WS_PM = 68 * MiB, WS_PA = 72 * MiB, WS_WO = 80 * MiB, WS_WGU = 88 * MiB, WS_WD = 132 * MiB;
constexpr size_t WS_HY = 154 * MiB;
constexpr size_t WS_QKM = 282 * MiB;
constexpr size_t WS_HT = 346 * MiB;
constexpr size_t WS_XH = WS_HT;
constexpr size_t WS_OST = 474 * MiB;
constexpr size_t WS_PROJ = 730 * MiB;
constexpr size_t WS_END = 1562 * MiB;
static_assert(WS_PROJ + (size_t)M * NP * 2 == WS_END, "ws map");
constexpr int CW_BAR = 4096;

constexpr int RING_OFF = 0, RING_BYTES = 157952;
constexpr int LDSCTL_OFF = RING_BYTES, MISC_OFF = LDSCTL_OFF + 320;
constexpr int LDS_BYTES = 159744;

#define GAS __attribute__((address_space(1)))
#define LAS __attribute__((address_space(3)))
typedef unsigned short bf16;
typedef unsigned v4u __attribute__((ext_vector_type(4)));
typedef unsigned v2u __attribute__((ext_vector_type(2)));
typedef float f32x4 __attribute__((ext_vector_type(4)));
typedef GAS unsigned gu32;
#define LDS_WAIT() asm volatile("s_waitcnt lgkmcnt(0)" ::: "memory")
#define VM_WAIT() asm volatile("s_waitcnt vmcnt(0)" ::: "memory")
__device__ __forceinline__ unsigned f2bf(float f) { unsigned u = __builtin_bit_cast(unsigned, f); return (u + 0x7fffu + ((u >> 16) & 1u)) >> 16; }
__device__ __forceinline__ unsigned pk2(float lo, float hi) { return f2bf(lo) | (f2bf(hi) << 16); }
__device__ __forceinline__ float bflo(unsigned u) { return __uint_as_float(u << 16); }
__device__ __forceinline__ float bfhi(unsigned u) { return __uint_as_float(u & 0xffff0000u); }
__device__ __forceinline__ float bf2f(bf16 h) { return __uint_as_float((unsigned)h << 16); }
#define SWZ_XOR(v, o) __uint_as_float((unsigned)__builtin_amdgcn_ds_swizzle((int)__float_as_uint(v), ((o) << 10) | 0x1f))
__device__ __forceinline__ float xhalf(float v, bool is_max) { auto rr = __builtin_amdgcn_permlane32_swap(__float_as_uint(v), __float_as_uint(v), false, false);
    const float a = __uint_as_float(rr[0]), b = __uint_as_float(rr[1]); return is_max ? fmaxf(a, b) : a + b; }
__device__ __forceinline__ float wave_sum(float v) {
    v += SWZ_XOR(v, 1); v += SWZ_XOR(v, 2); v += SWZ_XOR(v, 4); v += SWZ_XOR(v, 8); v += SWZ_XOR(v, 16);
    return xhalf(v, false);
}
__device__ __forceinline__ float shfl_up_l(float v, int o, int lane) { return __uint_as_float((unsigned)__builtin_amdgcn_ds_bpermute(((lane - o) & 63) << 2, (int)__float_as_uint(v))); }
__device__ __forceinline__ float sigmoidf_(float x) { return 1.0f / (1.0f + __expf(-x)); }

#define XB_TMO      128
#define XB_XCNT(j)  (256  + 64 * (j))
#define XB_XSUB(j)  (1280 + 64 * (j))
#define XB_XGEN(j)  (2304 + 64 * (j))
#define XB_TOP      3328
#define XB_TOPGEN   3392
#define XCD_BAR_WORDS 3456
#define XB_SPIN_CAP (1u << 18)
__device__ __forceinline__ unsigned xb_ld(unsigned* p)              { return __hip_atomic_load(p, __ATOMIC_RELAXED, __HIP_MEMORY_SCOPE_AGENT); }
__device__ __forceinline__ unsigned xb_add(unsigned* p, unsigned v) { return __hip_atomic_fetch_add(p, v, __ATOMIC_RELAXED, __HIP_MEMORY_SCOPE_AGENT); }
__device__ __forceinline__ unsigned xb_xcc_id() { return (unsigned)__builtin_amdgcn_s_getreg((3 << 11) | 20) & 0xFu; }
#define XB_SPIN(cond, bar) do { unsigned _sp = 0; while (cond) { __builtin_amdgcn_s_sleep(1); \
    if ((++_sp & 255u) == 0u) { if (xb_ld(&(bar)[XB_TMO])) break; if (_sp > XB_SPIN_CAP) { atomicAdd(&(bar)[XB_TMO], 1u); break; } } } } while (0)
struct XcdBarrier { unsigned* bar; unsigned x; volatile LAS unsigned* st; };
__device__ __forceinline__ XcdBarrier xcd_barrier_post(unsigned* bar, volatile LAS unsigned* st) {
    XcdBarrier b; b.bar = bar; b.x = xb_xcc_id(); b.st = st;
    if (threadIdx.x == 0) (void)xb_add(&bar[XB_XCNT(b.x)], 1u);
    return b;
}
__device__ __forceinline__ void xcd_barrier_complete(unsigned* bar, unsigned x, unsigned& nloc, unsigned& nx) {
    const unsigned G = gridDim.x * gridDim.y * gridDim.z;
    unsigned sum, cnt, mine, sp = 0u;
    for (;;) {
        sum = 0u; cnt = 0u; mine = 0u;
#pragma unroll
        for (unsigned j = 0; j < 16; ++j) { const unsigned c = xb_ld(&bar[XB_XCNT(j)]); sum += c; cnt += (c > 0u) ? 1u : 0u; mine = (j == x) ? c : mine; }
        if (sum == G) break;
        __builtin_amdgcn_s_sleep(1);
        if ((++sp & 255u) == 0u) { if (xb_ld(&bar[XB_TMO])) break; if (sp > XB_SPIN_CAP) { atomicAdd(&bar[XB_TMO], 1u); break; } }
    }
    nloc = mine > 0u ? mine : 1u; nx = cnt > 0u ? cnt : 1u;
}
__device__ __forceinline__ void xcd_barrier(const XcdBarrier& b) {
    asm volatile("s_waitcnt vmcnt(0)" ::: "memory");
    __syncthreads();
    if (threadIdx.x == 0) {
        unsigned* bar = b.bar;
        __builtin_amdgcn_s_waitcnt(0);
        unsigned nloc = b.st[0], nx = b.st[1];
        if (nloc == 0u) { xcd_barrier_complete(bar, b.x, nloc, nx); b.st[0] = nloc; b.st[1] = nx; }
        const unsigned old = xb_add(&bar[XB_XSUB(b.x)], 1u);
        const unsigned gen = old / nloc;
        if (old + 1u == (gen + 1u) * nloc) {
            __builtin_amdgcn_fence(__ATOMIC_RELEASE, "agent");
            asm volatile("s_waitcnt vmcnt(0)" ::: "memory");
            const unsigned og = xb_add(&bar[XB_TOP], 1u);
            const unsigned tg = og / nx;
            if (og + 1u == (tg + 1u) * nx) xb_add(&bar[XB_TOPGEN], 1u);
            else XB_SPIN(xb_ld(&bar[XB_TOPGEN]) == tg, bar);
            __builtin_amdgcn_fence(__ATOMIC_ACQUIRE, "agent");
            xb_add(&bar[XB_XGEN(b.x)], 1u);
            asm volatile("s_waitcnt vmcnt(0)" ::: "memory");
        } else {
            XB_SPIN(xb_ld(&bar[XB_XGEN(b.x)]) == gen, bar);
            __builtin_amdgcn_fence(__ATOMIC_ACQUIRE, "agent");
            asm volatile("s_waitcnt vmcnt(0)" ::: "memory");
        }
    }
    __syncthreads();
}

__device__ const double ROPE_INV[16] = {1.0, 0.44036660267178046, 0.19392274474868576, 0.08539710028576561, 0.03760603093086393, 0.016560440080994446, 0.007292664737217109, 0.003211445994752591,
    0.001414213562373095, 0.000622772421914596, 0.0002742481756762073, 0.00012076973741146504, 5.318295896944988e-05, 2.341999896140934e-05, 1.031338537721246e-05, 4.5416704806078695e-06};

__device__ __forceinline__ void rope_table_phase(const int* pos, float* rope, int gtid, int gthreads) {
    for (int idx = gtid; idx < M * 16; idx += gthreads) {
        const int row = idx >> 4, i = idx & 15;
        const float angf = (float)pos[row] * (float)ROPE_INV[i];
        const double rev = (double)angf * 0.15915494309189535;
        const float fr = (float)(rev - __builtin_rint(rev));
        rope[(size_t)row * 32 + i] = __builtin_amdgcn_cosf(fr);
        rope[(size_t)row * 32 + 16 + i] = __builtin_amdgcn_sinf(fr);
    }
}

struct TrItem { const float* src; bf16* dst; int ldw, ldk; bool rp; };
__device__ __forceinline__ void tr_load(const TrItem& t, f32x4 (&v)[16]) {
#pragma unroll
    for (int i = 0; i < 16; ++i) v[i] = __builtin_nontemporal_load((const GAS f32x4*)(t.src + (size_t)(4 * i) * t.ldw));
}
__device__ __forceinline__ void tr_finish(const TrItem& t, const f32x4 (&v)[16], LAS float* scr, int lane) {
    const int c = lane & 15, rr = lane >> 4;
#pragma unroll
    for (int i = 0; i < 16; ++i) { LAS float* d = scr + (4 * c) * 65 + 4 * i + rr; d[0] = v[i].x; d[65] = v[i].y; d[130] = v[i].z; d[195] = v[i].w; }
    LDS_WAIT(); asm volatile("" ::: "memory");
    const int c8 = lane & 7;
#pragma unroll
    for (int j = 0; j < 8; ++j) { const int n = 8 * j + (lane >> 3); const int ns = (t.rp && n < 32) ? ((n >> 1) + 16 * (n & 1)) : n; const LAS float* s = scr + ns * 65 + 8 * c8;
        v4u o; o.x = pk2(s[0], s[1]); o.y = pk2(s[2], s[3]); o.z = pk2(s[4], s[5]); o.w = pk2(s[6], s[7]);
        *(GAS v4u*)(t.dst + (size_t)n * t.ldk + 8 * c8) = o; }
    LDS_WAIT(); asm volatile("" ::: "memory");
}

__device__ __forceinline__ void convert_weights_phase(int l, const float* w_in, const float* p_m, const float* p_a, const float* w_out, const float* w_gate, const float* w_up, const float* w_down,
                                                      unsigned char* ws, LAS float* scr, int gw, int ngw, int lane) {
    constexpr int I1 = (DM / 64) * (NP / 64), I2 = (1024 / 64) * (DM / 64), I3 = (DM / 64) * (DM / 64), I4 = I3, I5 = (DM / 64) * (NGU / 64), I6 = (DFF / 64) * (DM / 64);
    constexpr int NIT = I1 + I2 + I3 + I4 + I5 + I6;
#define TR_DECODE(it_, T) do { int r = (it_); const float* W; int ldw, K, nblk, koff = 0; size_t wsoff; int mode;     \
        if (r < I1) { W = w_in + (size_t)l * DM * DIN; ldw = DIN; K = DM; nblk = NP / 64; wsoff = WS_WIN; mode = 1; }                                                          \
        else if ((r -= I1) < I2) { W = p_m + (size_t)l * 1024 * DM; ldw = DM; K = KMRG; nblk = DM / 64; wsoff = WS_PM; mode = 0; }                   \
        else if ((r -= I2) < I3) { W = p_a + (size_t)l * DM * DM; ldw = DM; K = KMRG; koff = 1024; nblk = DM / 64; wsoff = WS_PM; mode = 0; }        \
        else if ((r -= I3) < I4) { W = w_out + (size_t)l * DM * DM; ldw = DM; K = DM; nblk = DM / 64; wsoff = WS_WO; mode = 0; }                                                \
        else if ((r -= I4) < I5) { W = nullptr; ldw = DFF; K = DM; nblk = NGU / 64; wsoff = WS_WGU; mode = 2; }                                                                 \
        else { r -= I5; W = w_down + (size_t)l * DFF * DM; ldw = DM; K = DFF; nblk = DM / 64; wsoff = WS_WD; mode = 0; }                                                        \
        const int kb = r / nblk, nb = r % nblk, n0d = nb * 64; int n0s = n0d; bool rp = false;                                                                                  \
        if (mode == 1) { n0s = n0d < 3072 ? n0d : n0d + 8; rp = (n0d >= C_AQ && n0d < C_AV && (n0d & 127) == 0); }                                                              \
        if (mode == 2) { const int pn = n0d >> 8, r0 = n0d & 255; W = (r0 < 128 ? w_gate : w_up) + (size_t)l * DM * DFF; n0s = pn * 128 + (r0 & 127); }                        \
        T.src = W + (size_t)(kb * 64 + (lane >> 4)) * ldw + n0s + 4 * (lane & 15); T.ldw = ldw; T.ldk = K; T.rp = rp;                                                          \
        T.dst = (bf16*)(ws + wsoff) + (size_t)n0d * K + koff + kb * 64; } while (0)
    TrItem ta, tb; f32x4 va[16], vb[16];
    int it = gw;
    if (it < NIT) { TR_DECODE(it, ta); tr_load(ta, va); }
    while (it < NIT) {
        int itn = it + ngw;
        if (itn < NIT) { TR_DECODE(itn, tb); tr_load(tb, vb); }
        tr_finish(ta, va, scr, lane);
        it = itn; if (it >= NIT) break;
        itn = it + ngw;
        if (itn < NIT) { TR_DECODE(itn, ta); tr_load(ta, va); }
        tr_finish(tb, vb, scr, lane);
        it = itn;
    }
#undef TR_DECODE
}

__device__ __forceinline__ void norm_row(const float* xrow, const float* g, bf16* orow, int lane, f32x4 (&v)[8]) {
    const GAS f32x4* xr = (const GAS f32x4*)xrow + lane; const GAS f32x4* gr = (const GAS f32x4*)g + lane;
    float s = 0.f;
#pragma unroll
    for (int j = 0; j < 8; ++j) { v[j] = __builtin_nontemporal_load(xr + 64 * j); s += (v[j].x * v[j].x + v[j].y * v[j].y) + (v[j].z * v[j].z + v[j].w * v[j].w); }
    const float rstd = 1.0f / sqrtf(wave_sum(s) * (1.f / DM) + EPS);
    GAS unsigned long long* o8 = (GAS unsigned long long*)orow + lane;
#pragma unroll
    for (int j = 0; j < 8; ++j) { const f32x4 gg = gr[64 * j]; v[j] = v[j] * rstd * gg;
        o8[64 * j] = (unsigned long long)pk2(v[j].x, v[j].y) | ((unsigned long long)pk2(v[j].z, v[j].w) << 32); }
}

typedef _Float16 h16;
typedef _Float16 h16x8 __attribute__((ext_vector_type(8)));
template <bool IN16, bool WR16>
__device__ __forceinline__ void norm_row2(const void* xrow0, const void* xrow1, const float* g, bf16* orow0, bf16* orow1, int lane, f32x4 (&v0)[8], f32x4 (&v1)[8], h16* xh0 = nullptr, h16* xh1 = nullptr) {
    const GAS f32x4* gr = (const GAS f32x4*)g + 2 * lane;
    if constexpr (IN16) {
        const GAS h16x8* xr0 = (const GAS h16x8*)xrow0 + lane; const GAS h16x8* xr1 = (const GAS h16x8*)xrow1 + lane;
        h16x8 t0[4], t1[4];
#pragma unroll
        for (int j = 0; j < 4; ++j) { t0[j] = __builtin_nontemporal_load(xr0 + 64 * j); t1[j] = __builtin_nontemporal_load(xr1 + 64 * j); }
#pragma unroll
        for (int j = 0; j < 4; ++j) {
            v0[2 * j] = (f32x4){(float)t0[j][0], (float)t0[j][1], (float)t0[j][2], (float)t0[j][3]}; v0[2 * j + 1] = (f32x4){(float)t0[j][4], (float)t0[j][5], (float)t0[j][6], (float)t0[j][7]};
            v1[2 * j] = (f32x4){(float)t1[j][0], (float)t1[j][1], (float)t1[j][2], (float)t1[j][3]}; v1[2 * j + 1] = (f32x4){(float)t1[j][4], (float)t1[j][5], (float)t1[j][6], (float)t1[j][7]}; }
    } else {
        const GAS f32x4* xr0 = (const GAS f32x4*)xrow0 + 2 * lane; const GAS f32x4* xr1 = (const GAS f32x4*)xrow1 + 2 * lane;
#pragma unroll
        for (int j = 0; j < 4; ++j) { v0[2 * j] = __builtin_nontemporal_load(xr0 + 128 * j); v0[2 * j + 1] = __builtin_nontemporal_load(xr0 + 128 * j + 1);
                                      v1[2 * j] = __builtin_nontemporal_load(xr1 + 128 * j); v1[2 * j + 1] = __builtin_nontemporal_load(xr1 + 128 * j + 1); }
    }
    if constexpr (WR16) {
        GAS h16x8* w0 = (GAS h16x8*)xh0 + lane; GAS h16x8* w1 = (GAS h16x8*)xh1 + lane;
#pragma unroll
        for (int j = 0; j < 4; ++j) {
            w0[64 * j] = (h16x8){(h16)v0[2 * j].x, (h16)v0[2 * j].y, (h16)v0[2 * j].z, (h16)v0[2 * j].w, (h16)v0[2 * j + 1].x, (h16)v0[2 * j + 1].y, (h16)v0[2 * j + 1].z, (h16)v0[2 * j + 1].w};
            w1[64 * j] = (h16x8){(h16)v1[2 * j].x, (h16)v1[2 * j].y, (h16)v1[2 * j].z, (h16)v1[2 * j].w, (h16)v1[2 * j + 1].x, (h16)v1[2 * j + 1].y, (h16)v1[2 * j + 1].z, (h16)v1[2 * j + 1].w}; }
    }
    float s0 = 0.f, s1 = 0.f;
#pragma unroll
    for (int j = 0; j < 8; ++j) { s0 += (v0[j].x * v0[j].x + v0[j].y * v0[j].y) + (v0[j].z * v0[j].z + v0[j].w * v0[j].w); s1 += (v1[j].x * v1[j].x + v1[j].y * v1[j].y) + (v1[j].z * v1[j].z + v1[j].w * v1[j].w); }
    s0 += SWZ_XOR(s0, 1); s1 += SWZ_XOR(s1, 1); s0 += SWZ_XOR(s0, 2); s1 += SWZ_XOR(s1, 2); s0 += SWZ_XOR(s0, 4); s1 += SWZ_XOR(s1, 4);
    s0 += SWZ_XOR(s0, 8); s1 += SWZ_XOR(s1, 8); s0 += SWZ_XOR(s0, 16); s1 += SWZ_XOR(s1, 16); s0 = xhalf(s0, false); s1 = xhalf(s1, false);
    const float r0 = 1.0f / sqrtf(s0 * (1.f / DM) + EPS), r1 = 1.0f / sqrtf(s1 * (1.f / DM) + EPS);
    GAS v4u* o0 = (GAS v4u*)orow0 + lane; GAS v4u* o1 = (GAS v4u*)orow1 + lane;
#pragma unroll
    for (int j = 0; j < 4; ++j) { const f32x4 ga = gr[128 * j], gb = gr[128 * j + 1];
        v0[2 * j] = v0[2 * j] * r0 * ga; v0[2 * j + 1] = v0[2 * j + 1] * r0 * gb; v1[2 * j] = v1[2 * j] * r1 * ga; v1[2 * j + 1] = v1[2 * j + 1] * r1 * gb;
        v4u a, b; a.x = pk2(v0[2 * j].x, v0[2 * j].y); a.y = pk2(v0[2 * j].z, v0[2 * j].w); a.z = pk2(v0[2 * j + 1].x, v0[2 * j + 1].y); a.w = pk2(v0[2 * j + 1].z, v0[2 * j + 1].w);
        b.x = pk2(v1[2 * j].x, v1[2 * j].y); b.y = pk2(v1[2 * j].z, v1[2 * j].w); b.z = pk2(v1[2 * j + 1].x, v1[2 * j + 1].y); b.w = pk2(v1[2 * j + 1].z, v1[2 * j + 1].w);
        o0[64 * j] = a; o1[64 * j] = b; }
}

constexpr int CW_GRP = 16384;
__device__ __forceinline__ void group_barrier(unsigned* ctl, unsigned* gridbar, int g, int members) {
    asm volatile("s_waitcnt vmcnt(0)" ::: "memory");
    __syncthreads();
    if (threadIdx.x == 0) {
        unsigned* cnt = ctl + CW_GRP + 64 * g; unsigned* genw = ctl + CW_GRP + 512 + 64 * g;
        __builtin_amdgcn_fence(__ATOMIC_RELEASE, "agent");
        asm volatile("s_waitcnt vmcnt(0)" ::: "memory");
        const unsigned old = xb_add(cnt, 1u);
        const unsigned gen = old / (unsigned)members;
        if (old + 1u == (gen + 1u) * (unsigned)members) xb_add(genw, 1u);
        else XB_SPIN(xb_ld(genw) == gen, gridbar);
        __builtin_amdgcn_fence(__ATOMIC_ACQUIRE, "agent");
        asm volatile("s_waitcnt vmcnt(0)" ::: "memory");
    }
    __syncthreads();
}

__device__ __forceinline__ void mlstm_scan(int b, int h, const float* LIF, float* KSC, float* MT, float* EMT, float* REF, LAS float* sm, int tid) {
    const int lane = tid & 63, wave = tid >> 6;
    const float* base = LIF + (size_t)(b * SEQ) * 8;
    float li[8], c[8]; float run = 0.f;
#pragma unroll
    for (int j = 0; j < 8; ++j) { const int s = 8 * tid + j; li[j] = base[(size_t)s * 8 + h]; run += base[(size_t)s * 8 + 4 + h]; c[j] = run; }
    float inc = run;
#pragma unroll
    for (int o = 1; o < 64; o <<= 1) { const float vv = shfl_up_l(inc, o, lane); if (lane >= o) inc += vv; }
    if (lane == 63) sm[wave] = inc;
    __syncthreads();
    float woff = 0.f; for (int w = 0; w < wave; ++w) woff += sm[w];
    const float excl = woff + inc - run;
    float a[8], bs[8]; float lmax = -__builtin_inff();
#pragma unroll
    for (int j = 0; j < 8; ++j) { bs[j] = excl + c[j]; a[j] = li[j] - bs[j]; lmax = fmaxf(lmax, a[j]); }
    float tmax = lmax; tmax = fmaxf(tmax, SWZ_XOR(tmax, 1)); tmax = fmaxf(tmax, SWZ_XOR(tmax, 2)); tmax = fmaxf(tmax, SWZ_XOR(tmax, 4));
    float pm = lmax;
#pragma unroll
    for (int o = 1; o < 64; o <<= 1) { const float vv = shfl_up_l(pm, o, lane); if (lane >= o) pm = fmaxf(pm, vv); }
    if (lane == 63) sm[8 + wave] = pm;
    __syncthreads();
    float wpm = -__builtin_inff(); for (int w = 0; w < wave; ++w) wpm = fmaxf(wpm, sm[8 + w]);
    float prevl = shfl_up_l(pm, 1, lane); if (lane == 0) prevl = -__builtin_inff();
    float rmax = fmaxf(0.f, fmaxf(wpm, prevl));
    const size_t o0 = (size_t)(b * 4 + h) * SEQ + 8 * tid;
#pragma unroll
    for (int j = 0; j < 8; ++j) { rmax = fmaxf(rmax, a[j]); MT[o0 + j] = rmax; EMT[o0 + j] = __expf(-(bs[j] + rmax)); KSC[o0 + j] = __expf(a[j] - tmax); }
    if ((tid & 7) == 0) REF[(b * 4 + h) * 64 + (tid >> 3)] = tmax;
    __syncthreads();
}

__device__ __forceinline__ void mprep_unit(int unit, const bf16* PROJ, const float* cw, const float* cb, const float* KSC, bf16* QKM, int lane) {
    const int strip = unit >> 1, half = unit & 1;
    const int m0 = strip * 16, b = m0 / SEQ, s0 = m0 % SEQ, hh = lane >> 4, ch = half * 512 + 8 * lane;
    v4u xr[19];
#pragma unroll
    for (int i = 0; i < 19; ++i) { const int s = s0 - 3 + i; xr[i] = (v4u){0u, 0u, 0u, 0u};
        if (s >= 0) xr[i] = *(const GAS v4u*)(PROJ + (size_t)(b * SEQ + s) * NP + C_MQK + ch); }
    float ksc[16];
#pragma unroll
    for (int i = 0; i < 16; ++i) ksc[i] = half ? KSC[(size_t)(b * 4 + hh) * SEQ + s0 + i] * 0.08838834764831845f : 1.0f;
    float w[4][8], bias[8];
#pragma unroll
    for (int j = 0; j < 4; ++j) { const f32x4 a = *(const GAS f32x4*)(cw + j * 1024 + ch), c2 = *(const GAS f32x4*)(cw + j * 1024 + ch + 4);
        w[j][0] = a.x; w[j][1] = a.y; w[j][2] = a.z; w[j][3] = a.w; w[j][4] = c2.x; w[j][5] = c2.y; w[j][6] = c2.z; w[j][7] = c2.w; }
    { const f32x4 a = *(const GAS f32x4*)(cb + ch), c2 = *(const GAS f32x4*)(cb + ch + 4);
      bias[0] = a.x; bias[1] = a.y; bias[2] = a.z; bias[3] = a.w; bias[4] = c2.x; bias[5] = c2.y; bias[6] = c2.z; bias[7] = c2.w; }
#define XE(i_, e_) (((e_) & 1) ? bfhi(xr[i_][(e_) >> 1]) : bflo(xr[i_][(e_) >> 1]))
#pragma unroll
    for (int i = 0; i < 16; ++i) {
        float y[8];
#pragma unroll
        for (int e = 0; e < 8; ++e) { float t = bias[e] + w[0][e] * XE(i, e) + w[1][e] * XE(i + 1, e) + w[2][e] * XE(i + 2, e) + w[3][e] * XE(i + 3, e); t = t * sigmoidf_(t); y[e] = t * ksc[i]; }
        v4u o; o.x = pk2(y[0], y[1]); o.y = pk2(y[2], y[3]); o.z = pk2(y[4], y[5]); o.w = pk2(y[6], y[7]);
        *(GAS v4u*)(QKM + (size_t)(m0 + i) * 1024 + ch) = o;
    }
#undef XE
}

__device__ __forceinline__ void finish_row(int row, const float* HT, const float* OST, bf16* PROJ, const float* g_mhead, const float* g_sub, float one_m_laminit, int lane) {
    bf16* prow = PROJ + (size_t)row * NP;
#pragma unroll
    for (int hh = 0; hh < 4; ++hh) {
        const f32x4 v = *(const GAS f32x4*)(HT + (size_t)row * 1024 + hh * 256 + 4 * lane);
        const float ss = wave_sum((v.x * v.x + v.y * v.y) + (v.z * v.z + v.w * v.w));
        const float rstd = 1.0f / sqrtf(ss * (1.f / 256.f) + EPS);
        const f32x4 g = *(const GAS f32x4*)(g_mhead + hh * 256 + 4 * lane);
        const v2u so = *(const GAS v2u*)(prow + C_MO + hh * 256 + 4 * lane);
        const float o0 = bflo(so.x) * (v.x * rstd * g.x), o1 = bfhi(so.x) * (v.y * rstd * g.y), o2 = bflo(so.y) * (v.z * rstd * g.z), o3 = bfhi(so.y) * (v.w * rstd * g.w);
        v2u w; w.x = pk2(o0, o1); w.y = pk2(o2, o3);
        *(GAS v2u*)(prow + C_MO + hh * 256 + 4 * lane) = w;
    }
    const f32x4 gs = *(const GAS f32x4*)(g_sub + 4 * lane);
#pragma unroll
    for (int hh = 0; hh < 8; ++hh) {
        const f32x4 v = *(const GAS f32x4*)(OST + (size_t)row * 2048 + hh * 256 + 4 * lane);
        const float ss = wave_sum((v.x * v.x + v.y * v.y) + (v.z * v.z + v.w * v.w));
        const float rstd = 1.0f / sqrtf(ss * (1.f / 256.f) + EPS) * one_m_laminit;
        v2u w; w.x = pk2(v.x * rstd * gs.x, v.y * rstd * gs.y); w.y = pk2(v.z * rstd * gs.z, v.w * rstd * gs.w);
        *(GAS v2u*)(prow + C_AQ + hh * 256 + 4 * lane) = w;
    }
}
struct Args { const void* in[22]; float* out; unsigned char* ws; int stop_layer; int stop_phase; };

constexpr int PT_OFF = MISC_OFF + 128;
constexpr int PT_OUT = 22, PT_WS = 23;
static_assert(PT_OFF + 24 * 8 <= LDS_BYTES, "LDS map");
__device__ __forceinline__ const void* ldp(LAS unsigned char* ldsA, int k) {
    const volatile LAS unsigned* p = (const volatile LAS unsigned*)(ldsA + PT_OFF) + 2 * k; const unsigned lo = p[0], hi = p[1];
    return (const void*)(((unsigned long long)(unsigned)__builtin_amdgcn_readfirstlane(hi) << 32) | (unsigned)__builtin_amdgcn_readfirstlane(lo));
}
#define LDPF(k) ((const float*)ldp(ldsA, (k)))

__global__ void __launch_bounds__(NWAVES * 64, 2) hybrid_fwd(Args args) {
    extern __shared__ __attribute__((aligned(16))) unsigned char lds[];
    LAS unsigned char* ldsA0 = (LAS unsigned char*)lds;
    const int tid0 = threadIdx.x;
    const int wave0 = __builtin_amdgcn_readfirstlane(tid0 >> 6);
    const int G0 = gridDim.x; const int bx0 = blockIdx.x;
    const int vcu0 = (G0 % 8 == 0) ? (bx0 % 8) * (G0 / 8) + bx0 / 8 : bx0;
#define PHASE_IDS() int tid; asm volatile("v_mbcnt_lo_u32_b32 %0, -1, 0\n\tv_mbcnt_hi_u32_b32 %0, -1, %0" : "=v"(tid)); tid += wave0 * 64; int lz_ = 0; asm volatile("" : "+s"(lz_)); \
    const int lane = tid & 63, wave = __builtin_amdgcn_readfirstlane(tid >> 6), G = G0 + lz_, bx = bx0 + lz_, vcu = vcu0 + lz_, NGW = G * NWAVES, gw = vcu * NWAVES + wave; \
    LAS unsigned char* ldsA = ldsA0 + lz_; char* ldsG = (char*)lds + lz_; (void)lane; (void)gw; (void)bx; (void)NGW; (void)ldsG
    for (int u = tid0; u < (LDS_BYTES - LDSCTL_OFF) / 4; u += NWAVES * 64) ((LAS unsigned*)(ldsA0 + LDSCTL_OFF))[u] = 0u;
    __syncthreads();
    if (tid0 < 24) { const unsigned long long v = (tid0 < 22) ? (unsigned long long)args.in[tid0] : (tid0 == 22 ? (unsigned long long)args.out : (unsigned long long)args.ws);
        ((volatile LAS unsigned long long*)(ldsA0 + PT_OFF))[tid0] = v; }
    __syncthreads();
    { XcdBarrier b0_ = xcd_barrier_post((unsigned*)((unsigned char*)ldp(ldsA0, PT_WS) + WS_CTL) + CW_BAR, (volatile LAS unsigned*)(ldsA0 + MISC_OFF) + 8); (void)b0_; }
#define GRID_BAR() do { int lzb_ = 0; asm volatile("" : "+s"(lzb_)); XcdBarrier b_; b_.bar = (unsigned*)((unsigned char*)ldp(ldsA0 + lzb_, PT_WS) + WS_CTL) + CW_BAR; b_.x = xb_xcc_id(); \
        b_.st = (volatile LAS unsigned*)(ldsA0 + lzb_ + MISC_OFF) + 8; xcd_barrier(b_); } while (0)
#define GROUP_BAR() do { int lzg_ = 0; asm volatile("" : "+s"(lzg_)); unsigned* ctl_ = (unsigned*)((unsigned char*)ldp(ldsA0 + lzg_, PT_WS) + WS_CTL); \
        group_barrier(ctl_, ctl_ + CW_BAR, (int)((blockIdx.x + lzg_) % 8u), (int)(gridDim.x / 8u)); } while (0)
    const int stop_layer = args.stop_layer, stop_phase = args.stop_phase;

    { PHASE_IDS(); unsigned char* ws = (unsigned char*)ldp(ldsA, PT_WS); rope_table_phase((const int*)ldp(ldsA, 1), (float*)(ws + WS_ROPE), gw * 64 + lane, NGW * 64); }

#define STAGGER(us8) do { if ((us8) > 0) { const unsigned long long t0_ = __builtin_amdgcn_s_memrealtime(); const unsigned long long dt_ = (unsigned long long)((bx & 7) * (us8) * 100 / 8); \
        while (__builtin_amdgcn_s_memrealtime() - t0_ < dt_) __builtin_amdgcn_s_sleep(16); } } while (0)
#define STOP_AT(ph) do { if (DBG && l == stop_layer && stop_phase == (ph)) return; } while (0)
    for (int l = 0; l < DEPTH; ++l) {
        for (int rep_ = 0; rep_ < REPS(0); ++rep_)
        {
            PHASE_IDS();
            unsigned char* ws = (unsigned char*)ldp(ldsA, PT_WS);
            const float* w_in = LDPF(3);
            convert_weights_phase(l, w_in, LDPF(14), LDPF(15), LDPF(16), LDPF(18), LDPF(19), LDPF(20), ws, (LAS float*)(ldsA + RING_OFF + wave * 16640), gw, NGW, lane);
            __syncthreads();
            LAS float* wgT = (LAS float*)(ldsA + RING_OFF);
            for (int k = tid; k < DM; k += NWAVES * 64) {
                const float* src = w_in + (size_t)l * DM * DIN + (size_t)k * DIN + 3072;
                const f32x4 a = *(const GAS f32x4*)src, b2 = *(const GAS f32x4*)(src + 4);
                const int kp = (k & ~511) + 256 * ((k >> 2) & 1) + 4 * ((k >> 3) & 63) + (k & 3);
                wgT[0 * DM + kp] = a.x; wgT[1 * DM + kp] = a.y; wgT[2 * DM + kp] = a.z; wgT[3 * DM + kp] = a.w;
                wgT[4 * DM + kp] = b2.x; wgT[5 * DM + kp] = b2.y; wgT[6 * DM + kp] = b2.z; wgT[7 * DM + kp] = b2.w;
            }
            __syncthreads();
            const float* x_in = LDPF(0); h16* XH = (h16*)(ws + WS_XH);
            const float* g_mix = LDPF(2) + (size_t)l * DM; const float* i_bias = LDPF(6) + l * 4; const float* f_bias = LDPF(7) + l * 4;
            bf16* HY = (bf16*)(ws + WS_HY); float* LIF = (float*)(ws + WS_LIF);
            for (int m = gw; m < M; m += 2 * NGW) {
                f32x4 v0[8], v1[8]; const int m1 = m + NGW;
                if (l == 0) norm_row2<false, true>(x_in + (size_t)m * DM, x_in + (size_t)m1 * DM, g_mix, HY + (size_t)m * DM, HY + (size_t)m1 * DM, lane, v0, v1, XH + (size_t)m * DM, XH + (size_t)m1 * DM);
                else norm_row2<true, false>(XH + (size_t)m * DM, XH + (size_t)m1 * DM, g_mix, HY + (size_t)m * DM, HY + (size_t)m1 * DM, lane, v0, v1);
                float ga0[8], ga1[8];
#pragma unroll
                for (int c = 0; c < 8; ++c) { float s0 = 0.f, s1 = 0.f;
#pragma unroll
                    for (int j = 0; j < 8; ++j) { const f32x4 wv = *(const LAS f32x4*)(wgT + c * DM + 256 * j + 4 * lane);
                        s0 += (v0[j].x * wv.x + v0[j].y * wv.y) + (v0[j].z * wv.z + v0[j].w * wv.w); s1 += (v1[j].x * wv.x + v1[j].y * wv.y) + (v1[j].z * wv.z + v1[j].w * wv.w); }
                    ga0[c] = wave_sum(s0); ga1[c] = wave_sum(s1); }
                if (lane < 16) {
                    const int c8 = lane & 7; const bool second = lane >= 8;
                    float val = 0.f;
#pragma unroll
                    for (int c = 0; c < 8; ++c) if (c8 == c) val = second ? ga1[c] : ga0[c];
                    if (c8 < 4) val += i_bias[c8];
                    else { const float z = val + f_bias[c8 - 4]; const float e = __expf(-fabsf(z)), u = 1.0f + e, d = u - 1.0f; val = fminf(z, 0.f) - ((d == 0.f) ? e : __logf(u) * (e / d)); }
                    LIF[(size_t)(second ? m1 : m) * 8 + c8] = val;
                }
            }
        }
        GRID_BAR(); STOP_AT(0);
        for (int rep_ = 0; rep_ < REPS(1); ++rep_)
        {
            PHASE_IDS();
            unsigned char* ws = (unsigned char*)ldp(ldsA, PT_WS);
            {
                float* LIF = (float*)(ws + WS_LIF); float* MT = (float*)(ws + WS_MT); float* EMT = (float*)(ws + WS_EMT); float* KSC = (float*)(ws + WS_KSC); float* REF = (float*)(ws + WS_REF);
                for (int id = vcu; id < NB * 4; id += G) mlstm_scan(id >> 2, id & 3, LIF, KSC, MT, EMT, REF, (LAS float*)(ldsA + RING_OFF), tid);
            }
            pg8::Gemm g{(const bf16*)(ws + WS_HY), (const bf16*)(ws + WS_WIN), DM, DM}; pg8::StaticOrder S; S.init(M, NP, G, bx);
            pg8::EpiProj E{(bf16*)(ws + WS_PROJ), NP, (const float*)(ws + WS_ROPE)};
            pg8::gemm_phase<pg8::EpiProj, true>(ldsA + RING_OFF, g, S, E, tid);
        }
        GRID_BAR(); STOP_AT(1);
        for (int rep_ = 0; rep_ < REPS(2); ++rep_)
        {
            PHASE_IDS();
            unsigned char* ws = (unsigned char*)ldp(ldsA, PT_WS);
            const float* cw = LDPF(4) + (size_t)l * 4 * 1024; const float* cb = LDPF(5) + (size_t)l * 1024;
            for (int st = gw; st < M / 8; st += NGW) mprep_unit(st, (const bf16*)(ws + WS_PROJ), cw, cb, (const float*)(ws + WS_KSC), (bf16*)(ws + WS_QKM), lane);
        }
        GRID_BAR(); STOP_AT(2);
        for (int rep_ = 0; rep_ < 1; ++rep_)
        {
            PHASE_IDS();
            unsigned char* ws = (unsigned char*)ldp(ldsA, PT_WS);
            char* albs = ldsG + RING_OFF;
            attw::Seam S;
            bf16* PROJ = (bf16*)(ws + WS_PROJ);
            {
                constexpr int NIT = NB * 4 * 8; int nitems = 0; for (int id = vcu; id < NIT; id += G) ++nitems;
                const int nblk = 2 * nitems;
                bf16* QKM = (bf16*)(ws + WS_QKM);
                const float* MT = (const float*)(ws + WS_MT); const float* EMT = (const float*)(ws + WS_EMT); const float* REF = (const float*)(ws + WS_REF);
                const float* gmh = LDPF(8) + (size_t)l * 1024;
#define MREF(s_, R, L, F) do { const int id_ = ((s_) >> 1) * G + vcu, bh_ = id_ >> 3, p_ = id_ & 7, qb_ = ((s_) & 1) ? p_ : 15 - p_, b_ = bh_ >> 2, hm_ = bh_ & 3; \
                    R.Q = QKM + (size_t)(b_ * SEQ + qb_ * 256) * 1024 + hm_ * 128; R.K = QKM + (size_t)(b_ * SEQ) * 1024 + 512 + hm_ * 128; \
                    R.V = PROJ + (size_t)(b_ * SEQ) * NP + C_MV + hm_ * 256; R.O = nullptr; R.P0 = qb_ * 256; \
                    L.MT = MT + (size_t)bh_ * SEQ; L.EMT = EMT + (size_t)bh_ * SEQ; L.REF = REF + bh_ * 64; \
                    F.g = gmh + hm_ * 256; F.dst = PROJ + (size_t)(b_ * SEQ + qb_ * 256) * NP + C_MO + hm_ * 256; F.scale = 1.0f; } while (0)
                if (nblk > 0) {
                    { att::BlockRef cur; att::LinRef lc; att::FinRef fc; MREF(0, cur, lc, fc); attw::prime<1024, 1024, NP>(cur, albs, S, tid); }
                    for (int s = 0; s < nblk; ++s) {
                        { att::BlockRef nxt; att::LinRef ln; att::FinRef fn; const int sn = (s + 1 < nblk) ? s + 1 : s; MREF(sn, nxt, ln, fn); attw::put_next(albs, nxt, tid); }
                        { att::BlockRef cur; att::LinRef lc; att::FinRef fc; MREF(s, cur, lc, fc); int t2 = tid; asm volatile("" : "+v"(t2)); attw::block<1024, 1024, NP, 1024, NP, 2>(cur, albs, S, 0.f, lc, fc, t2); }
                    }
                }
#undef MREF
            }
        }
        {
            PHASE_IDS();
            unsigned char* ws = (unsigned char*)ldp(ldsA, PT_WS);
            char* albs = ldsG + RING_OFF;
            attw::Seam S;
            bf16* PROJ = (bf16*)(ws + WS_PROJ);
            {
                float lam; const float oml = 1.0f - (0.8f - 0.6f * __expf(-0.3f * (float)l));
                { const float* lq1 = LDPF(9) + l * 128; const float* lk1 = LDPF(10) + l * 128; const float* lq2 = LDPF(11) + l * 128; const float* lk2 = LDPF(12) + l * 128;
                  const float a1 = lq1[lane] * lk1[lane] + lq1[64 + lane] * lk1[64 + lane];
                  const float a2 = lq2[lane] * lk2[lane] + lq2[64 + lane] * lk2[64 + lane];
                  lam = __expf(wave_sum(a1)) - __expf(wave_sum(a2)) + (1.0f - oml); }
                constexpr int NIT = NB * 8 * 8; int nitems = 0; for (int id = vcu; id < NIT; id += G) ++nitems;
                const int nblk = 4 * nitems;
                float* OST = (float*)(ws + WS_OST);
                const float* gsub = LDPF(13) + (size_t)l * 256;
                att::LinRef lr0{nullptr, nullptr, nullptr};
#define AREF(s_, R, F) do { const int id_ = ((s_) >> 2) * G + vcu, bh_ = id_ >> 3, p_ = id_ & 7, c_ = (s_) & 1, qb_ = ((s_) & 2) ? p_ : 15 - p_, b_ = bh_ >> 3, h_ = bh_ & 7; \
                    R.Q = PROJ + (size_t)(b_ * SEQ + qb_ * 256) * NP + C_AQ + h_ * 256 + c_ * 128; R.K = PROJ + (size_t)(b_ * SEQ) * NP + C_AK + h_ * 256 + c_ * 128; \
                    R.V = PROJ + (size_t)(b_ * SEQ) * NP + C_AV + h_ * 256; R.O = reinterpret_cast<float*>(reinterpret_cast<unsigned short*>(OST) + (size_t)(b_ * SEQ + qb_ * 256) * 2048 + h_ * 256); R.P0 = qb_ * 256; \
                    F.g = gsub; F.dst = PROJ + (size_t)(b_ * SEQ + qb_ * 256) * NP + C_AQ + h_ * 256; F.scale = oml; } while (0)
                if (nblk > 0) {
                    { att::BlockRef c0; att::FinRef f0; AREF(0, c0, f0); attw::prime<NP, NP, NP>(c0, albs, S, tid); }
                    for (int s = 0; s < nblk; s += 2) {
                        { att::BlockRef nx; att::FinRef fx; AREF(s + 1, nx, fx); attw::put_next(albs, nx, tid); }
                        { att::BlockRef c0; att::FinRef f0; AREF(s, c0, f0); int t2 = tid; asm volatile("" : "+v"(t2)); attw::block<NP, NP, NP, 2048, NP, 0>(c0, albs, S, lam, lr0, f0, t2); }
                        { att::BlockRef nx; att::FinRef fx; const int sn = (s + 2 < nblk) ? s + 2 : s + 1; AREF(sn, nx, fx); attw::put_next(albs, nx, tid); }
                        { att::BlockRef c1; att::FinRef f1; AREF(s + 1, c1, f1); int t2 = tid; asm volatile("" : "+v"(t2)); attw::block<NP, NP, NP, 2048, NP, 1>(c1, albs, S, lam, lr0, f1, t2); }
                    }
                }
#undef AREF
            }
        }
        GRID_BAR(); STOP_AT(3);
        for (int rep_ = 0; rep_ < REPS(5); ++rep_)
        {
            PHASE_IDS();
            unsigned char* ws = (unsigned char*)ldp(ldsA, PT_WS);
            bf16* PROJ = (bf16*)(ws + WS_PROJ);
            pg8::StaticOrder S; S.init(M, DM, G, bx);
            pg8::Gemm g{PROJ + C_MO, (const bf16*)(ws + WS_PM), NP, KMRG}; pg8::EpiMerge E{(const unsigned char*)(PROJ + C_GM), NP * 2, (bf16*)(ws + WS_HY), DM};
            pg8::gemm_phase<pg8::EpiMerge, true, 16>(ldsA + RING_OFF, g, S, E, tid);
        }
        GROUP_BAR(); STOP_AT(5);
        {
            PHASE_IDS();
            unsigned char* ws = (unsigned char*)ldp(ldsA, PT_WS);
            pg8::StaticOrder S; S.init(M, DM, G, bx);
            pg8::Gemm g{(const bf16*)(ws + WS_HY), (const bf16*)(ws + WS_WO), DM, DM};
            pg8::EpiRes16 E{(pg8::h16_t*)(ws + WS_XH), DM};
            pg8::gemm_phase<pg8::EpiRes16, false>(ldsA + RING_OFF, g, S, E, tid);
        }
        GRID_BAR(); STOP_AT(6);
        for (int rep_ = 0; rep_ < REPS(7); ++rep_)
        {
            PHASE_IDS();
            unsigned char* ws = (unsigned char*)ldp(ldsA, PT_WS);
            const h16* XH = (const h16*)(ws + WS_XH); const float* g_ffn = LDPF(17) + (size_t)l * DM; bf16* HY = (bf16*)(ws + WS_HY);
            for (int m = gw; m < M; m += 2 * NGW) { f32x4 v0[8], v1[8]; const int m1 = m + NGW; norm_row2<true, false>(XH + (size_t)m * DM, XH + (size_t)m1 * DM, g_ffn, HY + (size_t)m * DM, HY + (size_t)m1 * DM, lane, v0, v1); }
        }
        GRID_BAR(); STOP_AT(7);
        for (int rep_ = 0; rep_ < REPS(8); ++rep_)
        {
            PHASE_IDS();
            unsigned char* ws = (unsigned char*)ldp(ldsA, PT_WS);
            pg8::StaticOrder S; S.init(M, NGU, G, bx);
            pg8::Gemm g{(const bf16*)(ws + WS_HY), (const bf16*)(ws + WS_WGU), DM, DM}; pg8::EpiSwiglu E{(bf16*)(ws + WS_PROJ), DFF};
            pg8::gemm_phase<pg8::EpiSwiglu, true>(ldsA + RING_OFF, g, S, E, tid);
        }
        GROUP_BAR(); STOP_AT(8);
        {
            PHASE_IDS();
            unsigned char* ws = (unsigned char*)ldp(ldsA, PT_WS);
            pg8::StaticOrder S; S.init(M, DM, G, bx);
            pg8::Gemm g{(const bf16*)(ws + WS_PROJ), (const bf16*)(ws + WS_WD), DFF, DFF};
            pg8::EpiRes16 E{(pg8::h16_t*)(ws + WS_XH), DM};
            pg8::gemm_phase<pg8::EpiRes16, false>(ldsA + RING_OFF, g, S, E, tid);
        }
        GRID_BAR(); STOP_AT(9);
    }
    {
        PHASE_IDS();
        unsigned char* ws = (unsigned char*)ldp(ldsA, PT_WS);
        float* out = (float*)ldp(ldsA, PT_OUT); const float* g_final = LDPF(21); const h16* XH = (const h16*)(ws + WS_XH);
        for (int m = gw; m < M; m += NGW) {
            const GAS h16x8* xr = (const GAS h16x8*)(XH + (size_t)m * DM) + lane; GAS f32x4* orow = (GAS f32x4*)(out + (size_t)m * DM) + 2 * lane; const GAS f32x4* gr = (const GAS f32x4*)g_final + 2 * lane;
            h16x8 t[4]; f32x4 v[8]; float s = 0.f;
#pragma unroll
            for (int j = 0; j < 4; ++j) t[j] = __builtin_nontemporal_load(xr + 64 * j);
#pragma unroll
            for (int j = 0; j < 4; ++j) { v[2 * j] = (f32x4){(float)t[j][0], (float)t[j][1], (float)t[j][2], (float)t[j][3]}; v[2 * j + 1] = (f32x4){(float)t[j][4], (float)t[j][5], (float)t[j][6], (float)t[j][7]}; }
#pragma unroll
            for (int j = 0; j < 8; ++j) s += (v[j].x * v[j].x + v[j].y * v[j].y) + (v[j].z * v[j].z + v[j].w * v[j].w);
            const float rstd = 1.0f / sqrtf(wave_sum(s) * (1.f / DM) + EPS);
#pragma unroll
            for (int j = 0; j < 4; ++j) { orow[128 * j] = v[2 * j] * rstd * gr[128 * j]; orow[128 * j + 1] = v[2 * j + 1] * rstd * gr[128 * j + 1]; }
        }
    }
#undef GRID_BAR
#undef STOP_AT
}
extern "C" void kernel_launch(void* const* d_in, const int* in_sizes, int n_in, void* d_out, int out_size, void* d_ws, size_t ws_size, hipStream_t stream) {
    static int grid = 0;
    if (grid == 0) {
        if (n_in != 22 || in_sizes[0] != M * DM || out_size != M * DM || ws_size < WS_END) {
            fprintf(stderr, "kernel_launch: shape mismatch (n_in %d, in0 %d, out %d, ws %zu < %zu); nothing launched\n", n_in, n_in > 0 ? in_sizes[0] : -1, out_size, ws_size, (size_t)WS_END); grid = -1; return; }
        int dev = 0, cus = 0, per_cu = 0;
        if (hipGetDevice(&dev) != hipSuccess || hipDeviceGetAttribute(&cus, hipDeviceAttributeMultiprocessorCount, dev) != hipSuccess) { grid = -1; return; }
        if (hipFuncSetAttribute((const void*)hybrid_fwd, hipFuncAttributeMaxDynamicSharedMemorySize, LDS_BYTES) != hipSuccess) { fprintf(stderr, "kernel_launch: hipFuncSetAttribute failed\n"); grid = -1; return; }
        if (hipOccupancyMaxActiveBlocksPerMultiprocessor(&per_cu, (const void*)hybrid_fwd, NWAVES * 64, LDS_BYTES) != hipSuccess || per_cu < 1)
            fprintf(stderr, "kernel_launch: note: occupancy query reports %d workgroups per CU\n", per_cu);
        (void)hipGetLastError();
        if (cus < 256) { fprintf(stderr, "kernel_launch: built for a 256-CU device (got %d)\n", cus); grid = -1; return; }
        grid = 256;
    }
    if (grid < 0) return;
    if (hipMemsetAsync((char*)d_ws + WS_CTL, 0, CTL_ZERO_BYTES, stream) != hipSuccess) return;
    Args a{};
    for (int i = 0; i < 22; ++i) a.in[i] = d_in[i];
    a.out = (float*)d_out; a.ws = (unsigned char*)d_ws;
    a.stop_layer = DBG ? DBG_STOP_LAYER : -1; a.stop_phase = DBG ? DBG_STOP_PHASE : -1;
    hipLaunchKernelGGL(hybrid_fwd, dim3(grid), dim3(NWAVES * 64), LDS_BYTES, stream, a);
#if DBG
    dbg_checks(d_in, (float*)d_out, (unsigned char*)d_ws, stream);
#endif
}
static_assert(attw::LDS_TOTAL <= RING_BYTES, "attention LDS"); static_assert((M / (256 * 8)) % 2 == 0, "rows per wave even");
```
